# Optimizing an MI355X kernel written in HIP

```python
import jax
import jax.numpy as jnp
from jax import lax
import numpy as np


D_MODEL = 2048
BATCH = 1
SEQ = 8192
DEPTH = 2

CTX_LEN = 256
GRID_W = 64
Q_BLOCK = 128
ROPE_BASE = 10000.0
EPS = 1e-6
N_BRANCH = 4
BRANCH_W = 1024
CONV_W = 1024
CONV_K = 3
GQA_HEADS = 8
GQA_KV_HEADS = 2
GQA_GROUP = GQA_HEADS // GQA_KV_HEADS
GQA_HEAD_DIM = 128
GQA_KV_W = GQA_KV_HEADS * GQA_HEAD_DIM
MLA_HEADS = 8
MLA_Q_RANK = 512
MLA_KV_RANK = 512
MLA_NOPE = 128
MLA_ROPE = 64
MLA_V = 128
SGU_W = 1024
SGU_GROUPS = 8
SGU_CHUNK = 128
D_FF = 4 * D_MODEL

KV_COLS = 2 * GQA_KV_W + MLA_KV_RANK + MLA_ROPE
Q_COLS = GQA_HEADS * GQA_HEAD_DIM + MLA_Q_RANK
A_COLS = 3 * CONV_W
D_COLS = 2 * SGU_W
G_COLS = N_BRANCH * D_MODEL
IN_COLS = KV_COLS + Q_COLS + A_COLS + D_COLS + G_COLS
IN_SPLITS = (KV_COLS, KV_COLS + Q_COLS, KV_COLS + Q_COLS + A_COLS, KV_COLS + Q_COLS + A_COLS + D_COLS)
KV_SPLITS = (GQA_KV_W, 2 * GQA_KV_W, 2 * GQA_KV_W + MLA_KV_RANK)
Q_SPLITS = (GQA_HEADS * GQA_HEAD_DIM,)

kernel_name = 'hybrid_parallel_dit_block'


def rms_norm(x, g):
    xf = x.astype(jnp.float32)
    y = xf * lax.rsqrt(jnp.mean(xf * xf, axis=-1, keepdims=True) + EPS)
    return (y * g.astype(jnp.float32)).astype(x.dtype)


def layer_norm(x, g, b):
    xf = x.astype(jnp.float32)
    mu = jnp.mean(xf, axis=-1, keepdims=True)
    xc = xf - mu
    y = xc * lax.rsqrt(jnp.mean(xc * xc, axis=-1, keepdims=True) + EPS)
    return (y * g.astype(jnp.float32) + b.astype(jnp.float32)).astype(x.dtype)


def modulate(x, g, shift, scale):
    return rms_norm(x, g) * (1 + scale) + shift


def adaln(cond, w, b):
    m = jax.nn.silu(cond) @ w + b
    if m.ndim == 2:
        m = m[:, None, :]
    return jnp.split(m, 6, axis=-1)


def axial_angles(n_tok, rot_dim):
    n_rows = n_tok // GRID_W
    row = jnp.repeat(jnp.arange(n_rows), GRID_W).astype(jnp.float32)
    col = jnp.tile(jnp.arange(GRID_W), n_rows).astype(jnp.float32)
    axis_dim = rot_dim // 2
    inv = ROPE_BASE ** (-jnp.arange(0, axis_dim, 2, dtype=jnp.float32) / axis_dim)
    return row[:, None] * inv, col[:, None] * inv


def rope_axis(x, ang):
    cos = jnp.cos(ang)[None, :, None, :].astype(x.dtype)
    sin = jnp.sin(ang)[None, :, None, :].astype(x.dtype)
    x1, x2 = jnp.split(x, 2, axis=-1)
    return jnp.concatenate([x1 * cos - x2 * sin, x1 * sin + x2 * cos], axis=-1)


def axial_rope(x, ang_row, ang_col):
    x_row, x_col = jnp.split(x, 2, axis=-1)
    return jnp.concatenate([rope_axis(x_row, ang_row), rope_axis(x_col, ang_col)], axis=-1)


def block_attention(q, k, v):
    B, S = q.shape[0], q.shape[1]
    n_blk = S // Q_BLOCK
    scale = q.shape[-1] ** -0.5
    qb = q.reshape((B, n_blk, Q_BLOCK) + q.shape[2:]).swapaxes(0, 1)

    def one_block(q_blk):
        s = jnp.einsum('bqhgd,bthd->bhgqt', q_blk, k).astype(jnp.float32) * scale
        p = jax.nn.softmax(s, axis=-1).astype(v.dtype)
        return jnp.einsum('bhgqt,bthe->bqhge', p, v)

    out = lax.map(one_block, qb)
    return out.swapaxes(0, 1).reshape((B, S) + out.shape[3:])


def short_conv(x, w):
    S = x.shape[1]
    pad = CONV_K // 2
    xp = jnp.pad(x, ((0, 0), (pad, pad), (0, 0)))
    out = xp[:, 0:S] * w[0]
    for tap in range(1, CONV_K):
        out = out + xp[:, tap:tap + S] * w[tap]
    return out


def spatial_gating(u, v, ln_g, ln_b, w_s, b_s):
    B, S, _ = v.shape
    n_chunk = S // SGU_CHUNK
    v = layer_norm(v, ln_g, ln_b)
    vc = v.reshape(B, n_chunk, SGU_CHUNK, SGU_GROUPS, SGU_W // SGU_GROUPS)
    mixed = jnp.einsum('gpq,bnqgc->bnpgc', w_s, vc) + b_s.T[:, :, None]
    return u * mixed.reshape(B, S, SGU_W)


def attn_kv(p_kv, lp, rope_b, rope_c):
    B, S, _ = p_kv.shape
    k_b, v_b, c_kv, k_r = jnp.split(p_kv, KV_SPLITS, axis=-1)
    k_b = rms_norm(k_b.reshape(B, S, GQA_KV_HEADS, GQA_HEAD_DIM), lp['k_norm_g'])
    v_b = v_b.reshape(B, S, GQA_KV_HEADS, GQA_HEAD_DIM)
    c_kv = rms_norm(c_kv, lp['mla_kv_norm_g'])
    kv = (c_kv @ lp['w_ukv']).reshape(B, S, MLA_HEADS, MLA_NOPE + MLA_V)
    k_nope, v_c = jnp.split(kv, (MLA_NOPE,), axis=-1)
    k_r = k_r[:, :, None, :]
    if rope_b is not None:
        k_b = axial_rope(k_b, *rope_b)
        k_r = axial_rope(k_r, *rope_c)
    k_c = jnp.concatenate([k_nope, jnp.broadcast_to(k_r, (B, S, MLA_HEADS, MLA_ROPE))], axis=-1)
    return k_b, v_b, k_c, v_c


def attn_q(p_q, lp, rope_b, rope_c):
    B, S, _ = p_q.shape
    q_b, c_q = jnp.split(p_q, Q_SPLITS, axis=-1)
    q_b = rms_norm(q_b.reshape(B, S, GQA_HEADS, GQA_HEAD_DIM), lp['q_norm_g'])
    c_q = rms_norm(c_q, lp['mla_q_norm_g'])
    q_c = (c_q @ lp['w_uq']).reshape(B, S, MLA_HEADS, MLA_NOPE + MLA_ROPE)
    q_nope, q_rope = jnp.split(q_c, (MLA_NOPE,), axis=-1)
    if rope_b is not None:
        q_b = axial_rope(q_b, *rope_b)
        q_rope = axial_rope(q_rope, *rope_c)
    q_b = q_b.reshape(B, S, GQA_KV_HEADS, GQA_GROUP, GQA_HEAD_DIM)
    q_c = jnp.concatenate([q_nope, q_rope], axis=-1)[:, :, :, None, :]
    return q_b, q_c


def token_mixer(h, lp, rope_b, rope_c, ctx_kv):
    B, S, _ = h.shape
    p = h @ lp['w_in']
    p_kv, p_q, p_a, p_d, p_g = jnp.split(p, IN_SPLITS, axis=-1)
    kv_self = attn_kv(p_kv, lp, rope_b, rope_c)
    if ctx_kv is None:
        k_b, v_b, k_c, v_c = kv_self
    else:
        k_b, v_b, k_c, v_c = [jnp.concatenate([kc, ks], axis=1) for kc, ks in zip(ctx_kv, kv_self)]
    q_b, q_c = attn_q(p_q, lp, rope_b, rope_c)
    y_b = block_attention(q_b, k_b, v_b).reshape(B, S, BRANCH_W)
    y_c = block_attention(q_c, k_c, v_c).reshape(B, S, BRANCH_W)
    gate_b, gate_c, x_a = jnp.split(p_a, 3, axis=-1)
    y_a = gate_b * short_conv(gate_c * x_a, lp['conv_w'])
    u, v = jnp.split(jax.nn.gelu(p_d), 2, axis=-1)
    y_d = spatial_gating(u, v, lp['sgu_ln_g'], lp['sgu_ln_b'], lp['sgu_w_s'], lp['sgu_b_s'])
    gates = jax.nn.sigmoid(p_g + lp['b_gate']).reshape(B, S, N_BRANCH, D_MODEL)
    ys = jnp.stack([y_a, y_b, y_c, y_d], axis=2)
    branch = jnp.einsum('bsie,ied->bsid', ys, lp['w_branch'])
    merged = jnp.sum(gates * branch, axis=2)
    return merged @ lp['w_out'], kv_self


def ffn(h, w1, w2):
    return jnp.square(jax.nn.relu(h @ w1)) @ w2


def setup_inputs(seed: int = 0) -> dict:
    key = jax.random.key(seed)
    ks = jax.random.split(key, 26)

    def nrm(i, shape, scale):
        return jax.random.normal(ks[i], shape, jnp.float32) * scale

    def gain(i, shape):
        return 1.0 + 0.02 * jax.random.normal(ks[i], shape, jnp.float32)

    L = DEPTH
    return {
        'x': nrm(0, (BATCH, SEQ, D_MODEL), 1.0),
        'c': nrm(1, (BATCH, D_MODEL), 1.0),
        'ctx': nrm(2, (BATCH, CTX_LEN, D_MODEL), 1.0),
        'c_ctx': nrm(3, (D_MODEL,), 1.0),
        'w_ada': nrm(4, (L, D_MODEL, 6 * D_MODEL), D_MODEL ** -0.5),
        'b_ada': nrm(5, (L, 6 * D_MODEL), 0.02),
        'norm_mix_g': gain(6, (L, D_MODEL)),
        'w_in': nrm(7, (L, D_MODEL, IN_COLS), D_MODEL ** -0.5),
        'b_gate': nrm(8, (L, G_COLS), 0.02),
        'conv_w': nrm(9, (L, CONV_K, CONV_W), CONV_K ** -0.5),
        'q_norm_g': gain(10, (L, GQA_HEAD_DIM)),
        'k_norm_g': gain(11, (L, GQA_HEAD_DIM)),
        'mla_q_norm_g': gain(12, (L, MLA_Q_RANK)),
        'mla_kv_norm_g': gain(13, (L, MLA_KV_RANK)),
        'w_uq': nrm(14, (L, MLA_Q_RANK, MLA_HEADS * (MLA_NOPE + MLA_ROPE)), MLA_Q_RANK ** -0.5),
        'w_ukv': nrm(15, (L, MLA_KV_RANK, MLA_HEADS * (MLA_NOPE + MLA_V)), MLA_KV_RANK ** -0.5),
        'sgu_ln_g': gain(16, (L, SGU_W)),
        'sgu_ln_b': nrm(17, (L, SGU_W), 0.02),
        'sgu_w_s': nrm(18, (L, SGU_GROUPS, SGU_CHUNK, SGU_CHUNK), SGU_CHUNK ** -0.5),
        'sgu_b_s': nrm(19, (L, SGU_GROUPS, SGU_CHUNK), 0.02),
        'w_branch': nrm(20, (L, N_BRANCH, BRANCH_W, D_MODEL), BRANCH_W ** -0.5),
        'w_out': nrm(21, (L, D_MODEL, D_MODEL), D_MODEL ** -0.5),
        'norm_ffn_g': gain(22, (L, D_MODEL)),
        'w_ff1': nrm(23, (L, D_MODEL, D_FF), D_MODEL ** -0.5),
        'w_ff2': nrm(24, (L, D_FF, D_MODEL), D_FF ** -0.5),
        'final_norm_g': gain(25, (D_MODEL,)),
    }


def reference(x, c, ctx, c_ctx, w_ada, b_ada, norm_mix_g, w_in, b_gate, conv_w, q_norm_g, k_norm_g,
              mla_q_norm_g, mla_kv_norm_g, w_uq, w_ukv, sgu_ln_g, sgu_ln_b, sgu_w_s, sgu_b_s,
              w_branch, w_out, norm_ffn_g, w_ff1, w_ff2, final_norm_g):
    S = x.shape[1]
    rope_b = axial_angles(S, GQA_HEAD_DIM)
    rope_c = axial_angles(S, MLA_ROPE)
    z = ctx
    for l in range(DEPTH):
        lp = {
            'w_in': w_in[l], 'b_gate': b_gate[l], 'conv_w': conv_w[l],
            'q_norm_g': q_norm_g[l], 'k_norm_g': k_norm_g[l],
            'mla_q_norm_g': mla_q_norm_g[l], 'mla_kv_norm_g': mla_kv_norm_g[l],
            'w_uq': w_uq[l], 'w_ukv': w_ukv[l],
            'sgu_ln_g': sgu_ln_g[l], 'sgu_ln_b': sgu_ln_b[l], 'sgu_w_s': sgu_w_s[l], 'sgu_b_s': sgu_b_s[l],
            'w_branch': w_branch[l], 'w_out': w_out[l],
        }
        sh1, sc1, g1, sh2, sc2, g2 = adaln(c, w_ada[l], b_ada[l])
        csh1, csc1, cg1, csh2, csc2, cg2 = adaln(c_ctx, w_ada[l], b_ada[l])
        hz = modulate(z, norm_mix_g[l], csh1, csc1)
        last = l == DEPTH - 1
        if last:
            ctx_kv = attn_kv(hz @ w_in[l][:, :KV_COLS], lp, None, None)
        else:
            mz, ctx_kv = token_mixer(hz, lp, None, None, None)
        hx = modulate(x, norm_mix_g[l], sh1, sc1)
        mx, _ = token_mixer(hx, lp, rope_b, rope_c, ctx_kv)
        x = x + g1 * mx
        x = x + g2 * ffn(modulate(x, norm_ffn_g[l], sh2, sc2), w_ff1[l], w_ff2[l])
        if not last:
            z = z + cg1 * mz
            z = z + cg2 * ffn(modulate(z, norm_ffn_g[l], csh2, csc2), w_ff1[l], w_ff2[l])
    return rms_norm(x, final_norm_g)
```

```cpp
#include <hip/hip_runtime.h>
#include <hip/hip_cooperative_groups.h>
#include <cstdio>
#include <cstdint>
namespace cg = cooperative_groups;
#ifndef PHM
#define PHM 0xFFFF
#endif
#ifndef EN192
#define EN192 1
#endif
#ifndef EN128
#define EN128 1
#endif

#define LAS __attribute__((address_space(3)))
typedef unsigned short bf16_t;
typedef short bf16x8 __attribute__((ext_vector_type(8)));
typedef short s16x4 __attribute__((ext_vector_type(4)));
typedef float f32x4 __attribute__((ext_vector_type(4)));
typedef float f32x16 __attribute__((ext_vector_type(16)));
typedef unsigned u32x4 __attribute__((ext_vector_type(4)));
typedef unsigned u32x2 __attribute__((ext_vector_type(2)));

constexpr int DM = 2048, SEQ = 8192, CTXL = 256, TALL = SEQ + CTXL;
constexpr int NIN = 15936, NINP = 16128;
constexpr int P_KB = 0, P_VB = 256, P_CKV = 512, P_KR = 1024, P_QB = 1280, P_CQ = 2304, P_GB = 2816, P_GC = 3840, P_XA = 4864,
              P_U = 5888, P_V = 6912, P_G = 7936;
constexpr int DFF = 8192;
constexpr float EPS = 1e-6f;
constexpr int NWAVES = 8, NTHR = 512;

constexpr size_t MiB = 1u << 20;
constexpr size_t WS_MOD = 0;
constexpr size_t WS_TABB = 256 * 1024;
constexpr size_t WS_TABC = 320 * 1024;
constexpr size_t WS_STATS = 512 * 1024;
constexpr size_t WS_W0 = 1 * MiB, W_LSTRIDE = 155 * MiB;
constexpr size_t WO_IN = 0, WO_UQ = 63 * MiB, WO_UKV = WO_UQ + 3 * MiB / 2, WO_BR = WO_UKV + 2 * MiB, WO_OUT = WO_BR + 16 * MiB,
                 WO_F1 = WO_OUT + 8 * MiB, WO_F2 = WO_F1 + 32 * MiB, WO_SG = WO_F2 + 32 * MiB;
constexpr size_t WS_H = 311 * MiB, WS_P = 344 * MiB, WS_KB = 604 * MiB, WS_KR = 609 * MiB, WS_QB = 611 * MiB, WS_CKVN = 628 * MiB,
                 WS_CQN = 637 * MiB, WS_QC = 646 * MiB, WS_KVU = 671 * MiB, WS_YS = 704 * MiB, WS_MRG = 770 * MiB, WS_MG = 836 * MiB,
                 WS_XS = 869 * MiB, WS_ZSLAB = 935 * MiB, WS_END = 967 * MiB;
constexpr size_t YS_STRIDE = (size_t)TALL * 1024;
static_assert(WO_SG + 2 * 8 * 128 * 128 <= W_LSTRIDE, "weights map");

constexpr int LDS_BYTES = 132 * 1024;

__device__ __forceinline__ float bf2f(bf16_t v) { return __uint_as_float(((unsigned)v) << 16); }
__device__ __forceinline__ float bf2f_s(short v) { return __uint_as_float(((unsigned)(unsigned short)v) << 16); }
__device__ __forceinline__ unsigned f2bf(float f) { unsigned u = __float_as_uint(f); return (u + 0x7fffu + ((u >> 16) & 1u)) >> 16; }
__device__ __forceinline__ unsigned pk2(float lo, float hi) { return f2bf(lo) | (f2bf(hi) << 16); }
__device__ __forceinline__ unsigned cvt_pk_bf16(float lo, float hi) { unsigned r; asm volatile("v_cvt_pk_bf16_f32 %0, %1, %2" : "=v"(r) : "v"(lo), "v"(hi)); return r; }
__device__ __forceinline__ float wave_sum(float v) {
#pragma unroll
    for (int o = 1; o < 64; o <<= 1) v += __shfl_xor(v, o);
    return v;
}
__device__ __forceinline__ float half_sum(float v) {
#pragma unroll
    for (int o = 1; o < 32; o <<= 1) v += __shfl_xor(v, o);
    return v;
}

namespace pg8 {
constexpr int BM = 256, BK = 64, HALF = 128, HTB = HALF * BK * 2, STAGE_BYTES = 8 * HTB, NXCD = 8, WGM = 8;
__host__ __device__ __forceinline__ int lds_byte(int r, int c) { const int st = (r >> 4) * 2 + (c >> 5), rr = r & 15, cc = c & 31, ob = rr * 64 + cc * 2; return st * 1024 + (ob ^ (((ob >> 9) & 1) << 5)); }
__host__ __device__ __forceinline__ void stage_rc(int b, int& R, int& C) { const int st = b / 1024, sb = b % 1024, swz = sb ^ (((sb >> 9) & 1) << 5); R = (st >> 1) * 16 + swz / 64; C = (st & 1) * 32 + (swz % 64) / 2; }
__host__ __device__ __forceinline__ int perm32(int rho) { const int n = rho >> 4, i = rho & 15; return 8 * (i >> 2) + 4 * n + (i & 3); }
struct Unit { int pm, pn, z; };

struct SchedWide {
    const bf16_t* A; const bf16_t* Bt; int K, nM, nN, nwg, xpm, xn, G, c;
    __device__ bool next(int i, Unit& u) const {
        long L = (long)i * G + c;
        if (L < nwg) {
            int wgid = (int)L; { const int q = nwg / NXCD, r = nwg % NXCD, xcd = wgid % NXCD, off = wgid / NXCD; wgid = (xcd < r ? xcd * (q + 1) : r * (q + 1) + (xcd - r) * q) + off; }
            const int nig = WGM * nN, gid = wgid / nig, fm = gid * WGM, gsz = (nM - fm) < WGM ? (nM - fm) : WGM;
            u.pm = fm + ((wgid % nig) % gsz); u.pn = (wgid % nig) / gsz; u.z = 0; return true;
        }
        L -= nwg; if (L < xn) { u.pm = xpm; u.pn = (int)L; u.z = 0; return true; }
        return false;
    }
    __device__ __forceinline__ int nt(const Unit&) const { return K / BK; }
    __device__ __forceinline__ const char* aptr(const Unit& u) const { return (const char*)A + (size_t)u.pm * BM * K * 2; }
    __device__ __forceinline__ const char* bptr(const Unit& u) const { return (const char*)Bt + (size_t)u.pn * BM * K * 2; }
};
struct SchedNarrow {
    const bf16_t* A; const bf16_t* Bt; int K, nM, ntiles, G, c;
    __device__ bool next(int i, Unit& u) const { const int t = i * G + c; if (t >= ntiles) return false; u.pm = t % nM; u.pn = t / nM; u.z = 0; return true; }
    __device__ __forceinline__ int nt(const Unit&) const { return K / BK; }
    __device__ __forceinline__ const char* aptr(const Unit& u) const { return (const char*)A + (size_t)u.pm * BM * K * 2; }
    __device__ __forceinline__ const char* bptr(const Unit& u) const { return (const char*)Bt + (size_t)u.pn * BM * K * 2; }
};
struct SchedNarrowZ {
    const bf16_t* A; const bf16_t* Bt; int K, nM, ntiles, G, c, nz, ksl;
    __device__ bool next(int i, Unit& u) const {
        int t = i * G + c;
        if (t < ntiles) { u.pm = t % nM; u.pn = t / nM; u.z = 0; return true; }
        t -= ntiles; if (t >= nz) return false;
        u.pm = 32; u.pn = t & 7; u.z = 1 + (t >> 3); return true;
    }
    __device__ __forceinline__ int nt(const Unit& u) const { return (u.z ? ksl : K) / BK; }
    __device__ __forceinline__ const char* aptr(const Unit& u) const { return (const char*)A + (size_t)u.pm * BM * K * 2 + (u.z ? (size_t)(u.z - 1) * ksl * 2 : (size_t)0); }
    __device__ __forceinline__ const char* bptr(const Unit& u) const { return (const char*)Bt + (size_t)u.pn * BM * K * 2 + (u.z ? (size_t)(u.z - 1) * ksl * 2 : (size_t)0); }
};
struct SchedBranch {
    const bf16_t* A; const bf16_t* Bt; int K, nM, ntiles, G, c; size_t strideA, strideB;
    __device__ bool next(int i, Unit& u) const { const int t = (i >> 2) * G + c; if (t >= ntiles) return false; u.pm = t % nM; u.pn = t / nM; u.z = i & 3; return true; }
    __device__ __forceinline__ int nt(const Unit&) const { return K / BK; }
    __device__ __forceinline__ const char* aptr(const Unit& u) const { return (const char*)(A + (size_t)u.z * strideA) + (size_t)u.pm * BM * K * 2; }
    __device__ __forceinline__ const char* bptr(const Unit& u) const { return (const char*)(Bt + (size_t)u.z * strideB) + (size_t)u.pn * BM * K * 2; }
};
struct SchedDual {
    const bf16_t* A0; const bf16_t* B0; const bf16_t* A1; const bf16_t* B1; int K, nM0, n0, nM1, n1, G, c;
    __device__ bool next(int i, Unit& u) const {
        int L = i * G + c;
        if (L < n0) { u.z = 0; u.pm = L % nM0; u.pn = L / nM0; return true; }
        L -= n0; if (L >= n1) return false;
        u.z = 1; u.pm = L % nM1; u.pn = L / nM1; return true;
    }
    __device__ __forceinline__ int nt(const Unit&) const { return K / BK; }
    __device__ __forceinline__ const char* aptr(const Unit& u) const { return (const char*)(u.z ? A1 : A0) + (size_t)u.pm * BM * K * 2; }
    __device__ __forceinline__ const char* bptr(const Unit& u) const { return (const char*)(u.z ? B1 : B0) + (size_t)u.pn * BM * K * 2; }
};

__device__ __forceinline__ float gelu_tanh(float x) { const float t = 1.5957691216057308f * (x + 0.044715f * x * x * x); return x / (1.f + __expf(-t)); }
__device__ __forceinline__ float sigmoidf(float x) { return 1.f / (1.f + __expf(-x)); }

struct EpiAct {
    static constexpr bool PERM = true;
    bf16_t* O0; int ld0; bf16_t* O1; int ld1; const float* bias; int bias_col0; int gelu_lo, sig_lo; int fixed_act;
    __device__ __forceinline__ void operator()(const f32x4 (&acc)[2][2][4][2], const Unit& u, int wr, int wc, int fr, int fq) const {
        bf16_t* base = u.z ? O1 : O0; const int ldc = u.z ? ld1 : ld0;
        const int act = fixed_act >= 0 ? fixed_act : (u.pn >= sig_lo ? 2 : (u.pn >= gelu_lo ? 1 : 0));
        const int row0 = u.pm * BM + wr * 64 + fr, col0 = u.pn * BM + wc * 32 + 8 * fq;
#pragma unroll
        for (int bj = 0; bj < 2; ++bj) {
            f32x4 b0 = (f32x4){0.f, 0.f, 0.f, 0.f}, b1 = b0;
            if (act == 2) { b0 = *(const f32x4*)(bias + (col0 + bj * HALF - bias_col0)); b1 = *(const f32x4*)(bias + (col0 + bj * HALF - bias_col0 + 4)); }
#pragma unroll
            for (int ai = 0; ai < 2; ++ai)
#pragma unroll
                for (int m = 0; m < 4; ++m) {
                    f32x4 v0 = acc[ai][bj][m][0], v1 = acc[ai][bj][m][1];
                    if (act == 1) {
#pragma unroll
                        for (int j = 0; j < 4; ++j) { v0[j] = gelu_tanh(v0[j]); v1[j] = gelu_tanh(v1[j]); }
                    } else if (act == 2) {
#pragma unroll
                        for (int j = 0; j < 4; ++j) { v0[j] = sigmoidf(v0[j] + b0[j]); v1[j] = sigmoidf(v1[j] + b1[j]); }
                    } else if (act == 3) {
#pragma unroll
                        for (int j = 0; j < 4; ++j) { float a = fmaxf(v0[j], 0.f), b = fmaxf(v1[j], 0.f); v0[j] = a * a; v1[j] = b * b; }
                    }
                    u32x4 w; w.x = cvt_pk_bf16(v0[0], v0[1]); w.y = cvt_pk_bf16(v0[2], v0[3]); w.z = cvt_pk_bf16(v1[0], v1[1]); w.w = cvt_pk_bf16(v1[2], v1[3]);
                    *(u32x4*)(base + (size_t)(row0 + ai * HALF + m * 16) * ldc + col0 + bj * HALF) = w;
                }
        }
    }
};
struct EpiGate {
    static constexpr bool PERM = true;
    const bf16_t* P; float* MRG; bf16_t* MG;
    __device__ __forceinline__ void operator()(const f32x4 (&acc)[2][2][4][2], const Unit& u, int wr, int wc, int fr, int fq) const {
        const int row0 = u.pm * BM + wr * 64 + fr, col0 = u.pn * BM + wc * 32 + 8 * fq; const int z = u.z;
#pragma unroll
        for (int ai = 0; ai < 2; ++ai)
#pragma unroll
            for (int m = 0; m < 4; ++m) {
                const size_t row = (size_t)(row0 + ai * HALF + m * 16);
#pragma unroll
                for (int bj = 0; bj < 2; ++bj) {
                    const int col = col0 + bj * HALF;
                    const bf16x8 g = *(const bf16x8*)(P + row * NINP + P_G + z * DM + col);
                    f32x4 v0 = acc[ai][bj][m][0], v1 = acc[ai][bj][m][1];
#pragma unroll
                    for (int j = 0; j < 4; ++j) { v0[j] *= bf2f_s(g[j]); v1[j] *= bf2f_s(g[4 + j]); }
                    float* mp = MRG + row * DM + col;
                    if (z > 0) { v0 += *(const f32x4*)mp; v1 += *(const f32x4*)(mp + 4); }
                    if (z < 3) { *(f32x4*)mp = v0; *(f32x4*)(mp + 4) = v1; }
                    else { u32x4 w; w.x = cvt_pk_bf16(v0[0], v0[1]); w.y = cvt_pk_bf16(v0[2], v0[3]); w.z = cvt_pk_bf16(v1[0], v1[1]); w.w = cvt_pk_bf16(v1[2], v1[3]);
                           *(u32x4*)(MG + row * DM + col) = w; }
                }
            }
    }
};
struct EpiRes {
    static constexpr bool PERM = false;
    const float* basex; const float* basez; float* out; const float* gx; const float* gz; int zpm; float* slab;
    __device__ __forceinline__ void operator()(const f32x4 (&acc)[2][2][4][2], const Unit& u, int wr, int wc, int fr, int fq) const {
        if (u.z) {
            float* o = slab + (size_t)(u.z - 1) * BM * DM; const int col0 = u.pn * BM + wc * 32 + 4 * fq;
#pragma unroll
            for (int bj = 0; bj < 2; ++bj)
#pragma unroll
                for (int n = 0; n < 2; ++n)
#pragma unroll
                    for (int ai = 0; ai < 2; ++ai)
#pragma unroll
                        for (int m = 0; m < 4; ++m) *(f32x4*)(o + (size_t)(ai * HALF + wr * 64 + m * 16 + fr) * DM + col0 + bj * HALF + n * 16) = acc[ai][bj][m][n];
            return;
        }
        const bool isz = (u.pm == zpm);
        const float* base = isz ? basez : basex + (size_t)u.pm * BM * DM; const float* gv = isz ? gz : gx;
        float* o = out + (size_t)u.pm * BM * DM;
        const int col0 = u.pn * BM + wc * 32 + 4 * fq;
#pragma unroll
        for (int bj = 0; bj < 2; ++bj)
#pragma unroll
            for (int n = 0; n < 2; ++n) {
                const int col = col0 + bj * HALF + n * 16; const f32x4 g4 = *(const f32x4*)(gv + col);
#pragma unroll
                for (int ai = 0; ai < 2; ++ai)
#pragma unroll
                    for (int m = 0; m < 4; ++m) {
                        const size_t off = (size_t)(ai * HALF + wr * 64 + m * 16 + fr) * DM + col;
                        const f32x4 bs = *(const f32x4*)(base + off);
                        *(f32x4*)(o + off) = bs + g4 * acc[ai][bj][m][n];
                    }
            }
    }
};

template <class Epi, class Sched, bool ALIGN_EPI = false, bool SP2 = false>
__device__ __forceinline__ void gemm_phase(LAS unsigned char* lds, const int K, const Sched& S, const Epi& E) {
    int tid_ = threadIdx.x; asm volatile("" : "+v"(tid_));
    const int tid = tid_, wid = __builtin_amdgcn_readfirstlane(tid >> 6), lane = tid & 63, wr = wid >> 2, wc = wid & 3, fr = lane & 15, fq = lane >> 4;
    unsigned voffA[2], voffB[2];
#pragma unroll
    for (int i = 0; i < 2; ++i) { int R, C; stage_rc(tid * 16 + i * 8192, R, C); const int Rb = Epi::PERM ? ((R & ~31) + perm32(R & 31)) : R;
        voffA[i] = (unsigned)(R * K + C) * 2u; voffB[i] = (unsigned)(Rb * K + C) * 2u; }
    const size_t kstep = (size_t)(BK * 2);
    const size_t hstep = (size_t)HALF * K * 2;
    const unsigned ldsw = (unsigned)wid * 1024u;
    const int aoff = lds_byte(wr * 64 + fr, fq * 8), boff = lds_byte(wc * 32 + fr, fq * 8);
#define PG8_SA(b, h) (((b) * 2 + (h)) * HTB)
#define PG8_SB(b, h) ((4 + (b) * 2 + (h)) * HTB)
#define PG8_STAGE(bufoff, gbase, voff) do { _Pragma("unroll") for (int _i = 0; _i < 2; ++_i) \
        __builtin_amdgcn_global_load_lds((const unsigned*)((const char*)(gbase) + (voff)[_i]), (LAS unsigned*)(lds + (bufoff) + ldsw + _i * 8192), 16, 0, 0); } while (0)
#define PG8_LDA(dst, b, h) do { _Pragma("unroll") for (int m = 0; m < 4; ++m) _Pragma("unroll") for (int k = 0; k < 2; ++k) dst[m][k] = *(const LAS bf16x8*)(lds + PG8_SA(b, h) + aoff + m * 2048 + k * 1024); } while (0)
#define PG8_LDB(dst, b, h) do { _Pragma("unroll") for (int n = 0; n < 2; ++n) _Pragma("unroll") for (int k = 0; k < 2; ++k) dst[n][k] = *(const LAS bf16x8*)(lds + PG8_SB(b, h) + boff + n * 2048 + k * 1024); } while (0)
#define PG8_MMA(ai, bj, At, Bt) do { __builtin_amdgcn_s_setprio(1); _Pragma("unroll") for (int m = 0; m < 4; ++m) _Pragma("unroll") for (int n = 0; n < 2; ++n) _Pragma("unroll") for (int k = 0; k < 2; ++k) \
        acc[ai][bj][m][n] = __builtin_amdgcn_mfma_f32_16x16x32_bf16(Bt[n][k], At[m][k], acc[ai][bj][m][n], 0, 0, 0); __builtin_amdgcn_s_setprio(0); } while (0)
#define PG8_WAIT_V(n) asm volatile("s_waitcnt vmcnt(" #n ")" ::: "memory")
#define PG8_WAIT_L(n) asm volatile("s_waitcnt lgkmcnt(" #n ")" ::: "memory")
#define PG8_BAR __builtin_amdgcn_s_barrier()
#define PG8_SCHED __builtin_amdgcn_sched_barrier(0)
    Unit cur, nxt; int ui = 0;
    if (!S.next(0, cur)) return;
    int nt = S.nt(cur);
    f32x4 acc[2][2][4][2];
#pragma unroll
    for (int a = 0; a < 2; ++a)
#pragma unroll
        for (int b = 0; b < 2; ++b)
#pragma unroll
            for (int m = 0; m < 4; ++m)
#pragma unroll
                for (int n = 0; n < 2; ++n) acc[a][b][m][n] = (f32x4){0.f, 0.f, 0.f, 0.f};
    bf16x8 At[4][2], B0[2][2], B1[2][2];
    const char* cA = S.aptr(cur); const char* cB = S.bptr(cur);
    if constexpr (SP2) {
        PG8_STAGE(PG8_SB(0, 0), cB, voffB); PG8_STAGE(PG8_SB(0, 1), cB + hstep, voffB); PG8_STAGE(PG8_SA(0, 0), cA, voffA); PG8_STAGE(PG8_SA(0, 1), cA + hstep, voffA);
        if (wr == 1) PG8_BAR;
        PG8_WAIT_V(2); PG8_BAR;
        PG8_STAGE(PG8_SB(1, 0), cB + kstep, voffB); PG8_STAGE(PG8_SA(1, 0), cA + kstep, voffA); PG8_STAGE(PG8_SB(1, 1), cB + hstep + kstep, voffB);
        PG8_WAIT_V(6); PG8_BAR;
    } else {
        PG8_STAGE(PG8_SB(0, 0), cB, voffB); PG8_STAGE(PG8_SA(0, 0), cA, voffA); PG8_STAGE(PG8_SB(0, 1), cB + hstep, voffB); PG8_STAGE(PG8_SA(0, 1), cA + hstep, voffA);
        if (wr == 1) PG8_BAR;
        PG8_WAIT_V(4); PG8_BAR;
        PG8_STAGE(PG8_SB(1, 0), cB + kstep, voffB); PG8_STAGE(PG8_SA(1, 0), cA + kstep, voffA); PG8_STAGE(PG8_SB(1, 1), cB + hstep + kstep, voffB);
        PG8_WAIT_V(6); PG8_BAR;
    }
    for (;;) {
        const bool has_next = S.next(ui + 1, nxt);
        const char* nA = has_next ? S.aptr(nxt) : cA; const char* nB = has_next ? S.bptr(nxt) : cB;
        for (int t = 0; t < nt; t += 2) {
            const bool last = (t == nt - 2);
            const char* a1 = cA + (size_t)(t + 1) * kstep;
            const char* a2 = last ? nA : cA + (size_t)(t + 2) * kstep; const char* b2 = last ? nB : cB + (size_t)(t + 2) * kstep;
            const char* a3 = a2 + kstep; const char* b3 = b2 + kstep;
            if constexpr (SP2) {
            PG8_LDB(B0, 0, 0); PG8_LDB(B1, 0, 1); PG8_SCHED; PG8_LDA(At, 0, 0); PG8_STAGE(PG8_SA(1, 1), a1 + hstep, voffA);
            PG8_WAIT_V(8); PG8_WAIT_L(0); PG8_BAR; PG8_MMA(0, 0, At, B0); PG8_MMA(0, 1, At, B1); PG8_BAR; PG8_SCHED;
            PG8_LDA(At, 0, 1); PG8_STAGE(PG8_SB(0, 0), b2, voffB); PG8_STAGE(PG8_SB(0, 1), b2 + hstep, voffB); PG8_STAGE(PG8_SA(0, 0), a2, voffA);
            PG8_WAIT_V(8); PG8_WAIT_L(0); PG8_BAR; PG8_MMA(1, 0, At, B0); PG8_MMA(1, 1, At, B1); PG8_BAR; PG8_SCHED;
            PG8_LDB(B0, 1, 0); PG8_LDB(B1, 1, 1); PG8_SCHED; PG8_LDA(At, 1, 0); PG8_STAGE(PG8_SA(0, 1), a2 + hstep, voffA);
            PG8_WAIT_V(8); PG8_WAIT_L(0); PG8_BAR; PG8_MMA(0, 0, At, B0); PG8_MMA(0, 1, At, B1); PG8_BAR; PG8_SCHED;
            PG8_LDA(At, 1, 1); PG8_STAGE(PG8_SB(1, 0), b3, voffB); PG8_STAGE(PG8_SB(1, 1), b3 + hstep, voffB); PG8_STAGE(PG8_SA(1, 0), a3, voffA);
            PG8_WAIT_V(8); PG8_WAIT_L(0); PG8_BAR; PG8_MMA(1, 0, At, B0); PG8_MMA(1, 1, At, B1); PG8_BAR; PG8_SCHED;
            } else {
            PG8_LDB(B0, 0, 0); PG8_SCHED; PG8_LDA(At, 0, 0); PG8_STAGE(PG8_SA(1, 1), a1 + hstep, voffA);
            PG8_WAIT_L(8); PG8_BAR; PG8_WAIT_L(0); PG8_MMA(0, 0, At, B0); PG8_BAR; PG8_SCHED;
            PG8_LDB(B1, 0, 1); PG8_STAGE(PG8_SB(0, 0), b2, voffB);
            PG8_BAR; PG8_WAIT_L(0); PG8_MMA(0, 1, At, B1); PG8_BAR;
            PG8_LDA(At, 0, 1); PG8_STAGE(PG8_SA(0, 0), a2, voffA);
            PG8_BAR; PG8_WAIT_L(0); PG8_MMA(1, 0, At, B0); PG8_BAR; PG8_SCHED;
            PG8_STAGE(PG8_SB(0, 1), b2 + hstep, voffB);
            PG8_WAIT_V(6); PG8_BAR; PG8_MMA(1, 1, At, B1); PG8_BAR;
            PG8_LDB(B0, 1, 0); PG8_SCHED; PG8_LDA(At, 1, 0); PG8_STAGE(PG8_SA(0, 1), a2 + hstep, voffA);
            PG8_WAIT_L(8); PG8_BAR; PG8_WAIT_L(0); PG8_MMA(0, 0, At, B0); PG8_BAR; PG8_SCHED;
            PG8_LDB(B1, 1, 1); PG8_STAGE(PG8_SB(1, 0), b3, voffB);
            PG8_BAR; PG8_WAIT_L(0); PG8_MMA(0, 1, At, B1); PG8_BAR;
            PG8_LDA(At, 1, 1); PG8_STAGE(PG8_SA(1, 0), a3, voffA);
            PG8_BAR; PG8_WAIT_L(0); PG8_MMA(1, 0, At, B0); PG8_BAR; PG8_SCHED;
            PG8_STAGE(PG8_SB(1, 1), b3 + hstep, voffB);
            PG8_WAIT_V(6); PG8_BAR; PG8_MMA(1, 1, At, B1); PG8_BAR;
            }
        }
        if constexpr (ALIGN_EPI) { if (wr == 0) PG8_BAR; }
        E(acc, cur, wr, wc, fr, fq);
        if (!has_next) break;
#pragma unroll
        for (int a = 0; a < 2; ++a)
#pragma unroll
            for (int b = 0; b < 2; ++b)
#pragma unroll
                for (int m = 0; m < 4; ++m)
#pragma unroll
                    for (int n = 0; n < 2; ++n) acc[a][b][m][n] = (f32x4){0.f, 0.f, 0.f, 0.f};
        cur = nxt; cA = nA; cB = nB; ++ui; nt = S.nt(cur);
        if constexpr (ALIGN_EPI) { if (wr == 1) PG8_BAR; }
    }
    PG8_WAIT_V(0);
    if constexpr (!ALIGN_EPI) { if (wr == 0) PG8_BAR; }
    PG8_BAR;
#undef PG8_SA
#undef PG8_SB
#undef PG8_STAGE
#undef PG8_LDA
#undef PG8_LDB
#undef PG8_MMA
#undef PG8_WAIT_V
#undef PG8_WAIT_L
#undef PG8_BAR
#undef PG8_SCHED
}
}

namespace att {
constexpr int NW = 8, QBLK = 32, KVBLK = 64;
constexpr float THR = 8.f;
constexpr size_t SHM_V = KVBLK * 128 * 2;
#define SBAR() __builtin_amdgcn_sched_barrier(0)
__device__ __forceinline__ int crow(int r, int hi) { return (r & 3) + 8 * (r >> 2) + 4 * hi; }
__device__ __forceinline__ unsigned cvtpk(float lo, float hi) { unsigned r; asm volatile("v_cvt_pk_bf16_f32 %0, %1, %2" : "=v"(r) : "v"(lo), "v"(hi)); return r; }

template <int DQ> __device__ __forceinline__ void partialSM(f32x16& p0, f32x16& p1, float& m_reg, float& mn, float& alpha) {
  constexpr float SCALE = (DQ == 128) ? 0.088388347648318440f : 0.072168783648703220f;
  constexpr float C = SCALE * 1.4426950408889634f;
  float pmax = p0[0];
#pragma unroll
  for (int r = 1; r < 16; ++r) pmax = fmaxf(pmax, p0[r]);
#pragma unroll
  for (int r = 0; r < 16; ++r) pmax = fmaxf(pmax, p1[r]);
  { auto rr = __builtin_amdgcn_permlane32_swap(__float_as_uint(pmax), __float_as_uint(pmax), false, false);
    pmax = fmaxf(__uint_as_float(rr[0]), __uint_as_float(rr[1])); }
  if (__builtin_expect(__all(pmax - m_reg <= THR / SCALE), 1)) { mn = m_reg; alpha = 1.f; }
  else { mn = fmaxf(m_reg, pmax); alpha = __builtin_amdgcn_exp2f((m_reg - mn) * C); m_reg = mn; }
  float mnC = -mn * C;
#pragma unroll
  for (int r = 0; r < 16; ++r) p0[r] = fmaf(p0[r], C, mnC);
#pragma unroll
  for (int r = 0; r < 16; ++r) p1[r] = fmaf(p1[r], C, mnC);
#pragma unroll
  for (int r = 0; r < 16; ++r) p0[r] = __builtin_amdgcn_exp2f(p0[r]);
}
__device__ __forceinline__ void finishSM(f32x16& p0, f32x16& p1, float alpha, float& l_reg, bf16x8& pa0, bf16x8& pa1, bf16x8& pa2, bf16x8& pa3) {
#pragma unroll
  for (int r = 0; r < 16; ++r) p1[r] = __builtin_amdgcn_exp2f(p1[r]);
  float ps = 0;
#pragma unroll
  for (int r = 0; r < 16; ++r) ps += p0[r];
#pragma unroll
  for (int r = 0; r < 16; ++r) ps += p1[r];
  { auto rr = __builtin_amdgcn_permlane32_swap(__float_as_uint(ps), __float_as_uint(ps), false, false);
    ps = __uint_as_float(rr[0]) + __uint_as_float(rr[1]); }
  l_reg = l_reg * alpha + ps;
#define PK4(P, BASE, OUT) do { unsigned a0 = cvtpk(P[BASE + 0], P[BASE + 1]), a1 = cvtpk(P[BASE + 2], P[BASE + 3]);   \
    unsigned b0 = cvtpk(P[BASE + 4], P[BASE + 5]), b1 = cvtpk(P[BASE + 6], P[BASE + 7]);                              \
    auto r0 = __builtin_amdgcn_permlane32_swap(a0, b0, false, false); auto r1 = __builtin_amdgcn_permlane32_swap(a1, b1, false, false); \
    u32x4 w = {r0[0], r1[0], r0[1], r1[1]}; OUT = *reinterpret_cast<bf16x8*>(&w); } while (0)
  PK4(p0, 0, pa0); PK4(p0, 8, pa1); PK4(p1, 0, pa2); PK4(p1, 8, pa3);
#undef PK4
}
template <int DQ> __device__ __forceinline__ int kswz(int row, int colB) { return row * (DQ * 2) + (colB ^ ((row & 7) << 4)); }
template <int DQ> __device__ __forceinline__ void qkt(f32x16& p0, f32x16& p1, const char* Ks, const bf16x8* qr, const char* qx, const int (&kb)[4]) {
  p0 = f32x16{}; p1 = f32x16{};
#pragma unroll
  for (int d0 = 0; d0 < DQ / 16; ++d0) {
    bf16x8 b0 = *reinterpret_cast<const bf16x8*>(Ks + kb[d0 & 3] + (d0 >> 2) * 128);
    bf16x8 b1 = *reinterpret_cast<const bf16x8*>(Ks + kb[d0 & 3] + (d0 >> 2) * 128 + 32 * DQ * 2);
    bf16x8 q; if (d0 < 8) q = qr[d0]; else q = *reinterpret_cast<const bf16x8*>(qx + (d0 - 8) * 1024);
    p0 = __builtin_amdgcn_mfma_f32_32x32x16_bf16(b0, q, p0, 0, 0, 0);
    p1 = __builtin_amdgcn_mfma_f32_32x32x16_bf16(b1, q, p1, 0, 0, 0); }
}
__device__ __forceinline__ int v_st(int k, int c) { const int kk = (k & ~0xC) | ((k & 4) << 1) | ((k & 8) >> 1); return ((kk >> 3) * 4 + (c >> 5)) * 512 + ((kk & 7) * 32 + (c & 31)) * 2; }
__device__ __forceinline__ int v_rd_base(int lane) { return ((lane & 3) << 3) | (((lane >> 2) & 3) << 6) | (((lane >> 4) & 1) << 5) | (((lane >> 5) & 1) << 8); }
constexpr int v_rd_off(int d0, int ks, int half) { return d0 * 512 + ks * 4096 + half * 2048; }
template <int OFF> __device__ __forceinline__ s16x4 tr_read(int vb) {
  s16x4 r; asm volatile("ds_read_b64_tr_b16 %0, %1 offset:%2" : "=&v"(r) : "v"(vb), "i"(OFF) : "memory"); return r;
}
template <int D0> __device__ __forceinline__ void pv_one(f32x16& od, int vb, bf16x8 pa0, bf16x8 pa1, bf16x8 pa2, bf16x8 pa3) {
  const s16x4 l0 = tr_read<v_rd_off(D0, 0, 0)>(vb), h0 = tr_read<v_rd_off(D0, 0, 1)>(vb), l1 = tr_read<v_rd_off(D0, 1, 0)>(vb), h1 = tr_read<v_rd_off(D0, 1, 1)>(vb);
  const s16x4 l2 = tr_read<v_rd_off(D0, 2, 0)>(vb), h2 = tr_read<v_rd_off(D0, 2, 1)>(vb), l3 = tr_read<v_rd_off(D0, 3, 0)>(vb), h3 = tr_read<v_rd_off(D0, 3, 1)>(vb);
  asm volatile("s_waitcnt lgkmcnt(0)" ::: "memory"); SBAR();
#define PK(L, H) (bf16x8){L[0], L[1], L[2], L[3], H[0], H[1], H[2], H[3]}
  od = __builtin_amdgcn_mfma_f32_32x32x16_bf16(pa0, PK(l0, h0), od, 0, 0, 0);
  od = __builtin_amdgcn_mfma_f32_32x32x16_bf16(pa1, PK(l1, h1), od, 0, 0, 0);
  od = __builtin_amdgcn_mfma_f32_32x32x16_bf16(pa2, PK(l2, h2), od, 0, 0, 0);
  od = __builtin_amdgcn_mfma_f32_32x32x16_bf16(pa3, PK(l3, h3), od, 0, 0, 0);
#undef PK
}
__device__ __forceinline__ void pv_d0(f32x16* o, int vb, bf16x8 pa0, bf16x8 pa1, bf16x8 pa2, bf16x8 pa3) {
  pv_one<0>(o[0], vb, pa0, pa1, pa2, pa3); pv_one<1>(o[1], vb, pa0, pa1, pa2, pa3); pv_one<2>(o[2], vb, pa0, pa1, pa2, pa3); pv_one<3>(o[3], vb, pa0, pa1, pa2, pa3);
}

template <int DQ, int ldq, int ldk0, int ldk1, int ldv, int ldo>
__device__ __forceinline__ void attn_body(const bf16_t* __restrict__ Qb, const bf16_t* __restrict__ K0, const bf16_t* __restrict__ K1,
                                          const bf16_t* __restrict__ Vh, bf16_t* __restrict__ Ob, int seq, char* lds, bool ropeq, int qpos0, const float2* __restrict__ tabC) {
  constexpr size_t SHM_K = KVBLK * DQ * 2;
  int tid_ = threadIdx.x; asm volatile("" : "+v"(tid_));
  const int tid = tid_, wid = tid >> 6, lane = tid & 63, r32 = lane & 31, hi = lane >> 5;
  char* V_lds = lds; char* K_lds = lds + 2 * SHM_V;
  float* ws = (float*)(lds + 2 * SHM_V + 2 * SHM_K) + wid * 64; float* li_l = ws; float* al_l = ws + 32;
  float m_reg = -1e30f, l_reg = 0; f32x16 o[4] = {}; bf16x8 qr[8];
  const bf16_t* Qw = Qb + (long)(wid * QBLK + r32) * ldq + hi * 8;
#pragma unroll
  for (int d0 = 0; d0 < 8; ++d0) qr[d0] = *reinterpret_cast<const bf16x8*>(Qw + d0 * 16);
  char* qx = lds + 2 * SHM_V + 2 * SHM_K + 2048 + wid * 4096 + lane * 16;
  if constexpr (DQ == 192) {
    const int t = qpos0 + wid * QBLK + r32;
#pragma unroll
    for (int ax = 0; ax < 2; ++ax) {
      const int pos = ax ? (t & 63) : (t >> 6); const float2* tb = tabC + pos * 16 + hi * 8;
      bf16x8 a = *reinterpret_cast<const bf16x8*>(Qw + (8 + 2 * ax) * 16), b = *reinterpret_cast<const bf16x8*>(Qw + (9 + 2 * ax) * 16);
      if (ropeq) {
#pragma unroll
        for (int j = 0; j < 8; ++j) { const float2 cs = tb[j]; const float x1 = bf2f_s(a[j]), x2 = bf2f_s(b[j]);
          a[j] = (short)f2bf(x1 * cs.x - x2 * cs.y); b[j] = (short)f2bf(x1 * cs.y + x2 * cs.x); }
      }
      *reinterpret_cast<bf16x8*>(qx + (2 * ax) * 1024) = a; *reinterpret_cast<bf16x8*>(qx + (2 * ax + 1) * 1024) = b;
    }
  }
  int kb[4];
#pragma unroll
  for (int m = 0; m < 4; ++m) kb[m] = kswz<DQ>(r32, m * 32 + hi * 16);
  const int sr = tid >> 4, sc = (tid & 15) * 8, vst0 = v_st(sr, sc), vst1 = v_st(32 + sr, sc);
  const int sr2 = tid >> 3, sc2 = (tid & 7) * 8;
  const int vb0 = (int)(uintptr_t)V_lds + v_rd_base(lane);
  struct { bf16x8 vs0, vs1, ks0, ks1, ks2; } sr_[1];
#define SLOAD(i, k0) do { sr_[i].vs0 = *(const bf16x8*)(&Vh[(long)((k0) + sr) * ldv + sc]); sr_[i].vs1 = *(const bf16x8*)(&Vh[(long)((k0) + 32 + sr) * ldv + sc]); \
    sr_[i].ks0 = *(const bf16x8*)(&K0[(long)((k0) + sr) * ldk0 + sc]); sr_[i].ks1 = *(const bf16x8*)(&K0[(long)((k0) + 32 + sr) * ldk0 + sc]); \
    if constexpr (DQ == 192) sr_[i].ks2 = *(const bf16x8*)(&K1[(long)((k0) + sr2) * ldk1 + sc2]); } while (0)
#define SWRITE(b, i) do { *(bf16x8*)(V_lds + (b) * SHM_V + vst0) = sr_[i].vs0;          \
    *(bf16x8*)(V_lds + (b) * SHM_V + vst1) = sr_[i].vs1; int kc = sc * 2;               \
    *(bf16x8*)(K_lds + (b) * SHM_K + kswz<DQ>(sr, kc)) = sr_[i].ks0;                       \
    *(bf16x8*)(K_lds + (b) * SHM_K + kswz<DQ>(32 + sr, kc)) = sr_[i].ks1;                  \
    if constexpr (DQ == 192) *(bf16x8*)(K_lds + (b) * SHM_K + kswz<DQ>(sr2, 256 + sc2 * 2)) = sr_[i].ks2; } while (0)
#define SWAIT() asm volatile("s_waitcnt vmcnt(0)" ::: "memory")
#define RESC(a) do { if (__any((a) < 1.f)) { if (hi == 0) al_l[r32] = (a); asm volatile("s_waitcnt lgkmcnt(0)" ::: "memory"); \
    _Pragma("unroll") for (int d = 0; d < 4; ++d) _Pragma("unroll") for (int r = 0; r < 16; ++r) o[d][r] *= al_l[crow(r, hi)]; } } while (0)
  f32x16 pA0, pA1, pB0, pB1; float mnA, mnB, alA, alB; bf16x8 pa0, pa1, pa2, pa3; const int NT = seq / KVBLK;
  SLOAD(0, 0); SWAIT(); SWRITE(0, 0); __syncthreads();
  qkt<DQ>(pA0, pA1, K_lds, qr, qx, kb); partialSM<DQ>(pA0, pA1, m_reg, mnA, alA);
  SLOAD(0, KVBLK);
  SWAIT(); SWRITE(1, 0); __syncthreads();
  for (int j = 1; j + 1 < NT; j += 2) {
    SBAR(); qkt<DQ>(pB0, pB1, K_lds + SHM_K, qr, qx, kb);
    finishSM(pA0, pA1, alA, l_reg, pa0, pa1, pa2, pa3); SBAR();
    SLOAD(0, (j + 1) * KVBLK); SBAR();
    pv_d0(o, vb0, pa0, pa1, pa2, pa3); partialSM<DQ>(pB0, pB1, m_reg, mnB, alB);
    __syncthreads(); SWAIT(); SWRITE(0, 0);
    RESC(alB); __syncthreads();
    SBAR(); qkt<DQ>(pA0, pA1, K_lds, qr, qx, kb);
    finishSM(pB0, pB1, alB, l_reg, pa0, pa1, pa2, pa3); SBAR();
    SLOAD(0, (j + 2) * KVBLK); SBAR();
    pv_d0(o, vb0 + (int)SHM_V, pa0, pa1, pa2, pa3); partialSM<DQ>(pA0, pA1, m_reg, mnA, alA);
    __syncthreads(); SWAIT(); SWRITE(1, 0);
    RESC(alA); __syncthreads();
  }
  SBAR(); qkt<DQ>(pB0, pB1, K_lds + SHM_K, qr, qx, kb);
  finishSM(pA0, pA1, alA, l_reg, pa0, pa1, pa2, pa3); SBAR();
  pv_d0(o, vb0, pa0, pa1, pa2, pa3); partialSM<DQ>(pB0, pB1, m_reg, mnB, alB);
  __syncthreads(); RESC(alB);
  finishSM(pB0, pB1, alB, l_reg, pa0, pa1, pa2, pa3); SBAR();
  pv_d0(o, vb0 + (int)SHM_V, pa0, pa1, pa2, pa3);
  if (hi == 0) li_l[r32] = l_reg; asm volatile("s_waitcnt lgkmcnt(0)" ::: "memory");
  float rli[16];
#pragma unroll
  for (int r = 0; r < 16; ++r) rli[r] = __builtin_amdgcn_rcpf(li_l[crow(r, hi)]);
  bf16_t* Ow = Ob + (long)(wid * QBLK) * ldo;
#pragma unroll
  for (int r = 0; r < 16; ++r) { int orow = crow(r, hi);
#pragma unroll
    for (int d0 = 0; d0 < 4; ++d0) Ow[(long)orow * ldo + d0 * 32 + r32] = (bf16_t)f2bf(o[d0][r] * rli[r]); }
  __syncthreads();
#undef SLOAD
#undef SWRITE
#undef SWAIT
#undef RESC
}
#undef SBAR
}

struct Params { const float* in[26]; float* out; unsigned char* ws; };
enum { I_X = 0, I_C, I_CTX, I_CCTX, I_WADA, I_BADA, I_NMIXG, I_WIN, I_BGATE, I_CONVW, I_QNG, I_KNG, I_MQNG, I_MKVNG, I_WUQ, I_WUKV, I_SLNG, I_SLNB,
       I_SWS, I_SBS, I_WBR, I_WOUT, I_NFFNG, I_WFF1, I_WFF2, I_FNG };

__device__ __forceinline__ void transpose_item(const float* W, int K, int N, bf16_t* WT, bool padmode, LAS float* scr, int item, int lane) {
    const int nblk = N / 64, kb = item / nblk, nb = item % nblk, k0 = 64 * kb, n0 = 64 * nb;
    const int lr = lane >> 4, lc = (lane & 15) * 4;
    f32x4 v[16];
#pragma unroll
    for (int i = 0; i < 16; ++i) v[i] = *(const f32x4*)(W + (size_t)(k0 + 4 * i + lr) * N + n0 + lc);
#pragma unroll
    for (int i = 0; i < 16; ++i) { LAS float* d = scr + (4 * i + lr) * 65 + lc; d[0] = v[i][0]; d[1] = v[i][1]; d[2] = v[i][2]; d[3] = v[i][3]; }
    asm volatile("s_waitcnt lgkmcnt(0)" ::: "memory");
    const int c = lane & 7; const int roff = (padmode && n0 >= 1088) ? 192 : 0;
#pragma unroll
    for (int j = 0; j < 8; ++j) { const int n = (lane >> 3) + 8 * j; const LAS float* s = scr + (8 * c) * 65 + n;
        u32x4 o; o.x = pk2(s[0 * 65], s[1 * 65]); o.y = pk2(s[2 * 65], s[3 * 65]); o.z = pk2(s[4 * 65], s[5 * 65]); o.w = pk2(s[6 * 65], s[7 * 65]);
        *(u32x4*)(WT + (size_t)(roff + n0 + n) * K + k0 + 8 * c) = o; }
    asm volatile("s_waitcnt lgkmcnt(0)" ::: "memory");
}

typedef const Params __attribute__((address_space(4))) KParams;
__global__ void __launch_bounds__(NTHR, 2) mega_fwd(Params p_arg) {
    extern __shared__ __attribute__((aligned(16))) unsigned char lds_raw[];
    cg::grid_group grid = cg::this_grid();
    LAS unsigned char* lds = (LAS unsigned char*)lds_raw;
    const int tid0 = threadIdx.x, wave = __builtin_amdgcn_readfirstlane(tid0 >> 6);
    const int G = gridDim.x;
#define PHASE_IDS() int tid = tid0; asm volatile("" : "+v"(tid)); const int lane = tid & 63; (void)lane
    const int NGW = G * NWAVES;
#define WS_PTRS() KParams* pk_ = (KParams*)__builtin_amdgcn_kernarg_segment_ptr(); asm volatile("" : "+s"(pk_)); KParams& p = *pk_;   \
    unsigned char* ws = p.ws; asm volatile("" : "+s"(ws)); int bx_ = blockIdx.x; asm volatile("" : "+s"(bx_)); const int bx = bx_, gw = bx * NWAVES + wave; (void)gw; \
    float* MOD = (float*)(ws + WS_MOD); float2* tabB = (float2*)(ws + WS_TABB); float2* tabC = (float2*)(ws + WS_TABC); float2* stats = (float2*)(ws + WS_STATS); \
    bf16_t* H = (bf16_t*)(ws + WS_H); bf16_t* P = (bf16_t*)(ws + WS_P); bf16_t* U = (bf16_t*)(ws + WS_P); \
    bf16_t* KB = (bf16_t*)(ws + WS_KB); bf16_t* KR = (bf16_t*)(ws + WS_KR); bf16_t* QB = (bf16_t*)(ws + WS_QB); \
    bf16_t* CKVN = (bf16_t*)(ws + WS_CKVN); bf16_t* CQN = (bf16_t*)(ws + WS_CQN); bf16_t* QC = (bf16_t*)(ws + WS_QC); bf16_t* KVU = (bf16_t*)(ws + WS_KVU); \
    bf16_t* YS = (bf16_t*)(ws + WS_YS); float* MRG = (float*)(ws + WS_MRG); bf16_t* MG = (bf16_t*)(ws + WS_MG); float* XS = (float*)(ws + WS_XS); float* ZSLAB = (float*)(ws + WS_ZSLAB); \
    (void)MOD; (void)tabB; (void)tabC; (void)stats; (void)H; (void)P; (void)U; (void)KB; (void)KR; (void)QB; (void)CKVN; (void)CQN; (void)QC; (void)KVU; (void)YS; (void)MRG; (void)MG; (void)XS; (void)ZSLAB
#define LAYER_PTRS() unsigned char* wl = ws + WS_W0 + l * W_LSTRIDE; \
    const bf16_t* Win_t = (const bf16_t*)(wl + WO_IN); const bf16_t* Wuq_t = (const bf16_t*)(wl + WO_UQ); const bf16_t* Wukv_t = (const bf16_t*)(wl + WO_UKV); \
    const bf16_t* Wbr_t = (const bf16_t*)(wl + WO_BR); const bf16_t* Wout_t = (const bf16_t*)(wl + WO_OUT); const bf16_t* W1_t = (const bf16_t*)(wl + WO_F1); \
    const bf16_t* W2_t = (const bf16_t*)(wl + WO_F2); const bf16_t* Wsg = (const bf16_t*)(wl + WO_SG); \
    const float* modx = MOD + (size_t)(l * 2 + 0) * 12288; const float* modz = MOD + (size_t)(l * 2 + 1) * 12288; \
    const float* xsrc = l0 ? p.in[I_X] : XS; const float* zsrc = l0 ? p.in[I_CTX] : XS + (size_t)SEQ * DM; \
    (void)Win_t; (void)Wuq_t; (void)Wukv_t; (void)Wbr_t; (void)Wout_t; (void)W1_t; (void)W2_t; (void)Wsg; (void)modx; (void)modz; (void)xsrc; (void)zsrc

#if (PHM & 1)
    {
        PHASE_IDS(); WS_PTRS();
#if (PHM & 4096)
        LAS float* sl = (LAS float*)lds;
        LAS float* red = (LAS float*)(lds + 16384);
        if (bx < 192) {
            for (int i = tid; i < 4096; i += NTHR) { const int cond = i >> 11, k = i & 2047; const float v = (cond ? p.in[I_CCTX] : p.in[I_C])[k]; sl[i] = v / (1.f + __expf(-v)); }
            __syncthreads();
        }
        for (int item = bx; item < 192; item += G) {
            typedef float f32x2 __attribute__((ext_vector_type(2)));
            const int l = item / 96, n0 = (item % 96) * 128;
            const float* wp = p.in[I_WADA] + (size_t)l * DM * 12288 + n0 + lane * 2;
            f32x2 a0 = (f32x2){0.f, 0.f}, a1 = a0;
#pragma unroll 16
            for (int kk = 0; kk < 256; ++kk) { const int k = wave * 256 + kk; const f32x2 wv = *(const f32x2*)(wp + (size_t)k * 12288); a0 += wv * sl[k]; a1 += wv * sl[2048 + k]; }
            *(LAS f32x2*)(red + (wave * 2 + 0) * 128 + lane * 2) = a0; *(LAS f32x2*)(red + (wave * 2 + 1) * 128 + lane * 2) = a1;
            __syncthreads();
            if (tid < 256) { const int cond = tid >> 7, col = tid & 127; float s = p.in[I_BADA][(size_t)l * 12288 + n0 + col];
#pragma unroll
              for (int w = 0; w < 8; ++w) s += red[(w * 2 + cond) * 128 + col];
              MOD[(size_t)(l * 2 + cond) * 12288 + n0 + col] = s; }
            __syncthreads();
        }
#endif
#if (PHM & 8192)
        for (int idx = bx * NTHR + tid; idx < 128 * 48; idx += G * NTHR) {
            const int pos = idx / 48, j = idx % 48;
            if (j < 32) { const float inv = powf(10000.0f, -(float)(2 * j) / 64.0f); const float ang = (float)pos * inv; tabB[pos * 32 + j] = make_float2(cosf(ang), sinf(ang)); }
            else { const int i = j - 32; const float inv = powf(10000.0f, -(float)(2 * i) / 32.0f); const float ang = (float)pos * inv; tabC[pos * 16 + i] = make_float2(cosf(ang), sinf(ang)); }
        }
#endif
#if (PHM & 16384)
        for (int idx = bx * NTHR + tid; idx < 2 * 131072 / 4; idx += G * NTHR) {
            const int l = idx / 32768, r = idx % 32768; const f32x4 v = *(const f32x4*)(p.in[I_SWS] + (size_t)idx * 4);
            u32x2 o; o.x = pk2(v[0], v[1]); o.y = pk2(v[2], v[3]);
            *(u32x2*)((bf16_t*)(ws + WS_W0 + l * W_LSTRIDE + WO_SG) + (size_t)r * 4) = o;
        }
#endif
        __syncthreads();
#if (PHM & 32768)
        LAS float* scr = (LAS float*)(lds + wave * 16640);
        constexpr int PER_L = 7968 + 192 + 256 + 2048 + 1024 + 4096 + 4096;
        for (int it = gw; it < 2 * PER_L; it += NGW) {
            const int l = it / PER_L; int r = it % PER_L; unsigned char* wl = ws + WS_W0 + l * W_LSTRIDE;
            if (r < 7968) { transpose_item(p.in[I_WIN] + (size_t)l * DM * NIN, DM, NIN, (bf16_t*)(wl + WO_IN), true, scr, r, lane); continue; } r -= 7968;
            if (r < 192) { transpose_item(p.in[I_WUQ] + (size_t)l * 512 * 1536, 512, 1536, (bf16_t*)(wl + WO_UQ), false, scr, r, lane); continue; } r -= 192;
            if (r < 256) { transpose_item(p.in[I_WUKV] + (size_t)l * 512 * 2048, 512, 2048, (bf16_t*)(wl + WO_UKV), false, scr, r, lane); continue; } r -= 256;
            if (r < 2048) { const int br = r >> 9; transpose_item(p.in[I_WBR] + (size_t)(l * 4 + br) * 1024 * DM, 1024, DM, (bf16_t*)(wl + WO_BR) + (size_t)br * DM * 1024, false, scr, r & 511, lane); continue; } r -= 2048;
            if (r < 1024) { transpose_item(p.in[I_WOUT] + (size_t)l * DM * DM, DM, DM, (bf16_t*)(wl + WO_OUT), false, scr, r, lane); continue; } r -= 1024;
            if (r < 4096) { transpose_item(p.in[I_WFF1] + (size_t)l * DM * DFF, DM, DFF, (bf16_t*)(wl + WO_F1), false, scr, r, lane); continue; } r -= 4096;
            transpose_item(p.in[I_WFF2] + (size_t)l * DFF * DM, DFF, DM, (bf16_t*)(wl + WO_F2), false, scr, r, lane);
        }
#endif
    }
    #endif
        grid.sync();

    for (int l = 0; l < 2; ++l) {
        const bool l0 = (l == 0);
        const int TQ = l0 ? TALL : SEQ;
        const int nMq = TQ / 256;

#if (PHM & 2)
        {
        WS_PTRS(); LAYER_PTRS();
        PHASE_IDS();
            const float* gmix = p.in[I_NMIXG] + (size_t)l * DM;
            for (int row = gw; row < TALL; row += NGW) {
                const bool isz = row >= SEQ; const float* src = isz ? zsrc + (size_t)(row - SEQ) * DM : xsrc + (size_t)row * DM; const float* md = isz ? modz : modx;
                f32x4 v[8]; float ss = 0.f;
#pragma unroll
                for (int j = 0; j < 8; ++j) v[j] = *(const f32x4*)(src + (lane + 64 * j) * 4);
                if (isz && !l0) {
                    const float* g2z = MOD + (size_t)12288 + 5 * 2048;
#pragma unroll
                    for (int j = 0; j < 8; ++j) { const int c = (lane + 64 * j) * 4; f32x4 s = (f32x4){0.f, 0.f, 0.f, 0.f};
                        for (int ks = 0; ks < 16; ++ks) s += *(const f32x4*)(ZSLAB + ((size_t)ks * 256 + (row - SEQ)) * DM + c);
                        v[j] += *(const f32x4*)(g2z + c) * s; }
                }
#pragma unroll
                for (int j = 0; j < 8; ++j) ss += v[j][0] * v[j][0] + v[j][1] * v[j][1] + v[j][2] * v[j][2] + v[j][3] * v[j][3];
                const float r = rsqrtf(wave_sum(ss) * (1.f / DM) + EPS);
#pragma unroll
                for (int j = 0; j < 8; ++j) { const int c = (lane + 64 * j) * 4; const f32x4 g = *(const f32x4*)(gmix + c), sh = *(const f32x4*)(md + c), sc = *(const f32x4*)(md + 2048 + c);
                    f32x4 h = (v[j] * r * g) * (sc + 1.f) + sh; u32x2 o; o.x = pk2(h[0], h[1]); o.y = pk2(h[2], h[3]); *(u32x2*)(H + (size_t)row * DM + c) = o; }
            }
        }
        #endif
        grid.sync();

#if (PHM & 4)
        {
        WS_PTRS(); LAYER_PTRS();
            pg8::SchedWide S{H, Win_t, DM, nMq, NINP / 256, nMq * (NINP / 256), 32, l0 ? 0 : 5, G, bx};
            pg8::EpiAct E{P, NINP, P, NINP, p.in[I_BGATE] + (size_t)l * 8192, P_G, P_U / 256, P_G / 256, -1};
            pg8::gemm_phase<pg8::EpiAct, pg8::SchedWide, true, true>(lds, DM, S, E);
        }
        #endif
        grid.sync();

#if (PHM & 8)
        {
        WS_PTRS(); LAYER_PTRS();
        PHASE_IDS();
            const float* kng = p.in[I_KNG] + l * 128; const float* qng = p.in[I_QNG] + l * 128;
            const float* mqg = p.in[I_MQNG] + l * 512; const float* mkg = p.in[I_MKVNG] + l * 512; const float* cw = p.in[I_CONVW] + (size_t)l * 3 * 1024;
            for (int t = gw; t < TALL; t += NGW) {
                const bool isz = t >= SEQ, full = l0 || !isz; const bf16_t* pr = P + (size_t)t * NINP;
                const int li = lane & 31, hh = lane >> 5;
                const float2 csr = tabB[(t >> 6) * 32 + li], csc = tabB[(t & 63) * 32 + li];
                { const bf16_t* s = pr + P_KB + hh * 128 + li; float y0 = bf2f(s[0]), y1 = bf2f(s[32]), y2 = bf2f(s[64]), y3 = bf2f(s[96]);
                  const float r = rsqrtf(half_sum(y0 * y0 + y1 * y1 + y2 * y2 + y3 * y3) * (1.f / 128.f) + EPS);
                  y0 *= r * kng[li]; y1 *= r * kng[32 + li]; y2 *= r * kng[64 + li]; y3 *= r * kng[96 + li];
                  if (!isz) { const float a0 = y0 * csr.x - y1 * csr.y, a1 = y0 * csr.y + y1 * csr.x, a2 = y2 * csc.x - y3 * csc.y, a3 = y2 * csc.y + y3 * csc.x; y0 = a0; y1 = a1; y2 = a2; y3 = a3; }
                  bf16_t* d = KB + (size_t)t * 256 + hh * 128 + li; d[0] = (bf16_t)f2bf(y0); d[32] = (bf16_t)f2bf(y1); d[64] = (bf16_t)f2bf(y2); d[96] = (bf16_t)f2bf(y3); }
                { const bf16x8 v = *(const bf16x8*)(pr + P_CKV + lane * 8); float f[8], ss = 0.f;
#pragma unroll
                  for (int j = 0; j < 8; ++j) { f[j] = bf2f_s(v[j]); ss += f[j] * f[j]; }
                  const float r = rsqrtf(wave_sum(ss) * (1.f / 512.f) + EPS); u32x4 o;
                  o.x = pk2(f[0] * r * mkg[lane * 8 + 0], f[1] * r * mkg[lane * 8 + 1]); o.y = pk2(f[2] * r * mkg[lane * 8 + 2], f[3] * r * mkg[lane * 8 + 3]);
                  o.z = pk2(f[4] * r * mkg[lane * 8 + 4], f[5] * r * mkg[lane * 8 + 5]); o.w = pk2(f[6] * r * mkg[lane * 8 + 6], f[7] * r * mkg[lane * 8 + 7]);
                  *(u32x4*)(CKVN + (size_t)t * 512 + lane * 8) = o; }
                if (lane < 32) { const int ax = lane >> 4, i = lane & 15; const bf16_t* s = pr + P_KR + ax * 32 + i; float x1 = bf2f(s[0]), x2 = bf2f(s[16]);
                  if (!isz) { const float2 cs = tabC[(ax ? (t & 63) : (t >> 6)) * 16 + i]; const float a = x1 * cs.x - x2 * cs.y, b = x1 * cs.y + x2 * cs.x; x1 = a; x2 = b; }
                  bf16_t* d = KR + (size_t)t * 64 + ax * 32 + i; d[0] = (bf16_t)f2bf(x1); d[16] = (bf16_t)f2bf(x2); }
                if (full) {
#pragma unroll
                    for (int it = 0; it < 4; ++it) { const int hd = it * 2 + hh; const bf16_t* s = pr + P_QB + hd * 128 + li; float y0 = bf2f(s[0]), y1 = bf2f(s[32]), y2 = bf2f(s[64]), y3 = bf2f(s[96]);
                      const float r = rsqrtf(half_sum(y0 * y0 + y1 * y1 + y2 * y2 + y3 * y3) * (1.f / 128.f) + EPS);
                      y0 *= r * qng[li]; y1 *= r * qng[32 + li]; y2 *= r * qng[64 + li]; y3 *= r * qng[96 + li];
                      if (!isz) { const float a0 = y0 * csr.x - y1 * csr.y, a1 = y0 * csr.y + y1 * csr.x, a2 = y2 * csc.x - y3 * csc.y, a3 = y2 * csc.y + y3 * csc.x; y0 = a0; y1 = a1; y2 = a2; y3 = a3; }
                      bf16_t* d = QB + (size_t)t * 1024 + hd * 128 + li; d[0] = (bf16_t)f2bf(y0); d[32] = (bf16_t)f2bf(y1); d[64] = (bf16_t)f2bf(y2); d[96] = (bf16_t)f2bf(y3); }
                    { const bf16x8 v = *(const bf16x8*)(pr + P_CQ + lane * 8); float f[8], ss = 0.f;
#pragma unroll
                      for (int j = 0; j < 8; ++j) { f[j] = bf2f_s(v[j]); ss += f[j] * f[j]; }
                      const float r = rsqrtf(wave_sum(ss) * (1.f / 512.f) + EPS); u32x4 o;
                      o.x = pk2(f[0] * r * mqg[lane * 8 + 0], f[1] * r * mqg[lane * 8 + 1]); o.y = pk2(f[2] * r * mqg[lane * 8 + 2], f[3] * r * mqg[lane * 8 + 3]);
                      o.z = pk2(f[4] * r * mqg[lane * 8 + 4], f[5] * r * mqg[lane * 8 + 5]); o.w = pk2(f[6] * r * mqg[lane * 8 + 6], f[7] * r * mqg[lane * 8 + 7]);
                      *(u32x4*)(CQN + (size_t)t * 512 + lane * 8) = o; }
                    { const int tlo = isz ? SEQ : 0, thi = isz ? TALL : SEQ; const bool hp = t > tlo, hn = t + 1 < thi;
#pragma unroll
                      for (int q = 0; q < 2; ++q) { const int c = lane * 16 + q * 8;
                        const bf16x8 gb = *(const bf16x8*)(pr + P_GB + c), gc = *(const bf16x8*)(pr + P_GC + c), xa = *(const bf16x8*)(pr + P_XA + c);
                        bf16x8 gcp = gc, xap = xa, gcn = gc, xan = xa;
                        if (hp) { gcp = *(const bf16x8*)(pr - NINP + P_GC + c); xap = *(const bf16x8*)(pr - NINP + P_XA + c); }
                        if (hn) { gcn = *(const bf16x8*)(pr + NINP + P_GC + c); xan = *(const bf16x8*)(pr + NINP + P_XA + c); }
                        float y[8];
#pragma unroll
                        for (int j = 0; j < 8; ++j) { const float uc = bf2f_s(gc[j]) * bf2f_s(xa[j]); const float up = hp ? bf2f_s(gcp[j]) * bf2f_s(xap[j]) : 0.f; const float un = hn ? bf2f_s(gcn[j]) * bf2f_s(xan[j]) : 0.f;
                          y[j] = bf2f_s(gb[j]) * (cw[c + j] * up + cw[1024 + c + j] * uc + cw[2048 + c + j] * un); }
                        u32x4 o; o.x = pk2(y[0], y[1]); o.y = pk2(y[2], y[3]); o.z = pk2(y[4], y[5]); o.w = pk2(y[6], y[7]);
                        *(u32x4*)(YS + (size_t)t * 1024 + c) = o; } }
                    { const bf16x8 v0 = *(const bf16x8*)(pr + P_V + lane * 16), v1 = *(const bf16x8*)(pr + P_V + lane * 16 + 8); float f[16], s = 0.f;
#pragma unroll
                      for (int j = 0; j < 8; ++j) { f[j] = bf2f_s(v0[j]); f[8 + j] = bf2f_s(v1[j]); s += f[j] + f[8 + j]; }
                      const float mean = wave_sum(s) * (1.f / 1024.f); float q = 0.f;
#pragma unroll
                      for (int j = 0; j < 16; ++j) { const float d = f[j] - mean; q += d * d; }
                      const float rstd = rsqrtf(wave_sum(q) * (1.f / 1024.f) + EPS);
                      if (lane == 0) stats[t] = make_float2(mean, rstd); }
                }
            }
        }
        #endif
        grid.sync();

#if (PHM & 16)
        {
        WS_PTRS(); LAYER_PTRS();
            pg8::SchedDual S{CQN, Wuq_t, CKVN, Wukv_t, 512, nMq, nMq * 6, TALL / 256, (TALL / 256) * 8, G, bx};
            pg8::EpiAct E{QC, 1536, KVU, 2048, nullptr, 0, 1 << 30, 1 << 30, 0};
            pg8::gemm_phase<pg8::EpiAct, pg8::SchedDual, true, true>(lds, 512, S, E);
            __syncthreads();
        PHASE_IDS();
            const float* lng = p.in[I_SLNG] + l * 1024; const float* lnb = p.in[I_SLNB] + l * 1024; const float* bs = p.in[I_SBS] + l * 1024;
            LAS bf16_t* VnT = (LAS bf16_t*)lds;
            const int r32 = lane & 31, hi = lane >> 5;
            for (int item = bx; item < (TQ / 128) * 8; item += G) {
                const int ch = item >> 3, g = item & 7, t0 = ch * 128;
                { const int q = tid >> 2, cs = (tid & 3) * 32; const float2 st = stats[t0 + q]; const bf16_t* src = P + (size_t)(t0 + q) * NINP + P_V + g * 128 + cs;
#pragma unroll
                  for (int k4 = 0; k4 < 4; ++k4) { const bf16x8 v = *(const bf16x8*)(src + k4 * 8);
#pragma unroll
                    for (int j = 0; j < 8; ++j) { const int c = cs + k4 * 8 + j; const float f = (bf2f_s(v[j]) - st.x) * st.y * lng[g * 128 + c] + lnb[g * 128 + c]; VnT[c * 136 + q] = (bf16_t)f2bf(f); } } }
                __syncthreads();
                const int pb = wave >> 1, cb0 = (wave & 1) * 2;
                f32x16 acc0 = {}, acc1 = {};
                const bf16_t* Ap = Wsg + (size_t)g * 16384 + (pb * 32 + r32) * 128 + hi * 8;
#pragma unroll
                for (int ks = 0; ks < 8; ++ks) { const bf16x8 a = *(const bf16x8*)(Ap + ks * 16);
                    const bf16x8 b0 = *(const LAS bf16x8*)(VnT + ((cb0 * 32 + r32) * 136 + ks * 16 + hi * 8)), b1 = *(const LAS bf16x8*)(VnT + (((cb0 + 1) * 32 + r32) * 136 + ks * 16 + hi * 8));
                    acc0 = __builtin_amdgcn_mfma_f32_32x32x16_bf16(a, b0, acc0, 0, 0, 0); acc1 = __builtin_amdgcn_mfma_f32_32x32x16_bf16(a, b1, acc1, 0, 0, 0); }
#pragma unroll
                for (int r = 0; r < 16; ++r) { const int pp = pb * 32 + att::crow(r, hi); const int t = t0 + pp; const float bias = bs[g * 128 + pp];
                    const int c0 = g * 128 + cb0 * 32 + r32; const bf16_t* up = P + (size_t)t * NINP + P_U; bf16_t* yp = YS + 3 * YS_STRIDE + (size_t)t * 1024;
                    yp[c0] = (bf16_t)f2bf(bf2f(up[c0]) * (acc0[r] + bias)); yp[c0 + 32] = (bf16_t)f2bf(bf2f(up[c0 + 32]) * (acc1[r] + bias)); }
                __syncthreads();
            }
        }
        #endif
        grid.sync();

#if (PHM & 32)
        {
        WS_PTRS(); LAYER_PTRS();
            const int h = bx & 7, qb = bx >> 3;
            const int nun = (l0 && bx < 8) ? 2 : 1;
#if EN192
            for (int ui = 0; ui < nun; ++ui) {
                const bool zu = ui == 1; const size_t r0 = zu ? (size_t)SEQ : (size_t)qb * 256; const size_t k0 = zu ? (size_t)SEQ : 0; const int seq = zu ? CTXL : TALL;
                att::attn_body<192, 1536, 2048, 64, 2048, 1024>(QC + r0 * 1536 + h * 192, KVU + k0 * 2048 + h * 256, KR + k0 * 64, KVU + k0 * 2048 + h * 256 + 128,
                                    YS + 2 * YS_STRIDE + r0 * 1024 + h * 128, seq, (char*)lds_raw, !zu, (int)r0, tabC);
            }
#endif
#if EN128
            for (int ui = 0; ui < nun; ++ui) {
                const bool zu = ui == 1; const size_t r0 = zu ? (size_t)SEQ : (size_t)qb * 256; const size_t k0 = zu ? (size_t)SEQ : 0; const int seq = zu ? CTXL : TALL;
                att::attn_body<128, 1024, 256, 64, NINP, 1024>(QB + r0 * 1024 + h * 128, KB + k0 * 256 + (h >> 2) * 128, nullptr, P + k0 * NINP + P_VB + (h >> 2) * 128,
                                    YS + 1 * YS_STRIDE + r0 * 1024 + h * 128, seq, (char*)lds_raw, false, 0, tabC);
            }
#endif
        }
        #endif
        grid.sync();

#if (PHM & 64)
        {
        WS_PTRS(); LAYER_PTRS();
            pg8::SchedBranch S{YS, Wbr_t, 1024, nMq, nMq * 8, G, bx, YS_STRIDE, (size_t)DM * 1024};
            pg8::EpiGate E{P, MRG, MG};
            pg8::gemm_phase<pg8::EpiGate, pg8::SchedBranch, true, true>(lds, 1024, S, E);
        }
        #endif
        grid.sync();

#if (PHM & 128)
        {
        WS_PTRS(); LAYER_PTRS();
            pg8::SchedNarrowZ S{MG, Wout_t, DM, 32, 256, G, bx, l0 ? 8 * 8 : 0, 256};
            pg8::EpiRes E{xsrc, zsrc, XS, modx + 2 * 2048, modz + 2 * 2048, 32, ZSLAB};
            pg8::gemm_phase<pg8::EpiRes, pg8::SchedNarrowZ, true, true>(lds, DM, S, E);
        }
        #endif
        grid.sync();

#if (PHM & 256)
        {
        WS_PTRS(); LAYER_PTRS();
        PHASE_IDS();
            const float* gffn = p.in[I_NFFNG] + (size_t)l * DM;
            for (int row = gw; row < TQ; row += NGW) {
                const bool isz = row >= SEQ; const float* src = isz ? zsrc + (size_t)(row - SEQ) * DM : XS + (size_t)row * DM; const float* md = isz ? modz : modx;
                f32x4 v[8]; float ss = 0.f;
#pragma unroll
                for (int j = 0; j < 8; ++j) v[j] = *(const f32x4*)(src + (lane + 64 * j) * 4);
                if (isz) {
#pragma unroll
                    for (int j = 0; j < 8; ++j) { const int c = (lane + 64 * j) * 4; f32x4 s = (f32x4){0.f, 0.f, 0.f, 0.f};
                        for (int ks = 0; ks < 8; ++ks) s += *(const f32x4*)(ZSLAB + ((size_t)ks * 256 + (row - SEQ)) * DM + c);
                        v[j] += *(const f32x4*)(modz + 2 * 2048 + c) * s; *(f32x4*)(XS + (size_t)row * DM + c) = v[j]; }
                }
#pragma unroll
                for (int j = 0; j < 8; ++j) ss += v[j][0] * v[j][0] + v[j][1] * v[j][1] + v[j][2] * v[j][2] + v[j][3] * v[j][3];
                const float r = rsqrtf(wave_sum(ss) * (1.f / DM) + EPS);
#pragma unroll
                for (int j = 0; j < 8; ++j) { const int c = (lane + 64 * j) * 4; const f32x4 g = *(const f32x4*)(gffn + c), sh = *(const f32x4*)(md + 3 * 2048 + c), sc = *(const f32x4*)(md + 4 * 2048 + c);
                    f32x4 h = (v[j] * r * g) * (sc + 1.f) + sh; u32x2 o; o.x = pk2(h[0], h[1]); o.y = pk2(h[2], h[3]); *(u32x2*)(H + (size_t)row * DM + c) = o; }
            }
        }
        #endif
        grid.sync();

#if (PHM & 512)
        {
        WS_PTRS(); LAYER_PTRS();
            pg8::SchedWide S{H, W1_t, DM, nMq, DFF / 256, nMq * (DFF / 256), 0, 0, G, bx};
            pg8::EpiAct E{U, DFF, U, DFF, nullptr, 0, 1 << 30, 1 << 30, 3};
            pg8::gemm_phase<pg8::EpiAct, pg8::SchedWide, true, true>(lds, DM, S, E);
        }
        #endif
        grid.sync();

#if (PHM & 1024)
        {
        WS_PTRS(); LAYER_PTRS();
            pg8::SchedNarrowZ S{U, W2_t, DFF, 32, 256, G, bx, l0 ? 8 * 16 : 0, 512};
            pg8::EpiRes E{XS, XS + (size_t)SEQ * DM, XS, modx + 5 * 2048, modz + 5 * 2048, 32, ZSLAB};
            pg8::gemm_phase<pg8::EpiRes, pg8::SchedNarrowZ, true, true>(lds, DFF, S, E);
        }
        #endif
        grid.sync();
    }

    {
        WS_PTRS();
        PHASE_IDS();
        const float* gf = p.in[I_FNG];
        for (int row = gw; row < SEQ; row += NGW) {
            const float* src = XS + (size_t)row * DM; f32x4 v[8]; float ss = 0.f;
#pragma unroll
            for (int j = 0; j < 8; ++j) { v[j] = *(const f32x4*)(src + (lane + 64 * j) * 4); ss += v[j][0] * v[j][0] + v[j][1] * v[j][1] + v[j][2] * v[j][2] + v[j][3] * v[j][3]; }
            const float r = rsqrtf(wave_sum(ss) * (1.f / DM) + EPS);
#pragma unroll
            for (int j = 0; j < 8; ++j) { const int c = (lane + 64 * j) * 4; const f32x4 g = *(const f32x4*)(gf + c); *(f32x4*)(p.out + (size_t)row * DM + c) = v[j] * r * g; }
        }
    }
}

extern "C" void kernel_launch(void* const* d_in, const int* in_sizes, int n_in, void* d_out, int out_size, void* d_ws, size_t ws_size, hipStream_t stream) {
    static int grid = 0;
    if (grid == 0) {
        if (n_in != 26 || out_size != SEQ * DM || ws_size < WS_END) { fprintf(stderr, "kernel_launch: unexpected shapes (n_in %d out %d ws %zu, need ws >= %zu)\n", n_in, out_size, ws_size, (size_t)WS_END); grid = -1; return; }
        int dev = 0, cus = 0, per_cu = 0;
        hipGetDevice(&dev); hipDeviceGetAttribute(&cus, hipDeviceAttributeMultiprocessorCount, dev);
        if (hipFuncSetAttribute((const void*)mega_fwd, hipFuncAttributeMaxDynamicSharedMemorySize, LDS_BYTES) != hipSuccess) { fprintf(stderr, "kernel_launch: hipFuncSetAttribute failed\n"); grid = -1; return; }
        hipOccupancyMaxActiveBlocksPerMultiprocessor(&per_cu, (const void*)mega_fwd, NTHR, LDS_BYTES);
        (void)hipGetLastError();
        if (per_cu < 1) fprintf(stderr, "kernel_launch: occupancy query says %d blocks per CU\n", per_cu);
        grid = 256;
        if (cus != 256) fprintf(stderr, "kernel_launch: device has %d CUs; this kernel is built for a 256-workgroup grid\n", cus);
    }
    if (grid < 0) return;
    Params p{};
    for (int i = 0; i < 26; ++i) p.in[i] = (const float*)d_in[i];
    p.out = (float*)d_out; p.ws = (unsigned char*)d_ws;
    void* args[] = {&p};
    hipError_t e = hipLaunchCooperativeKernel((const void*)mega_fwd, dim3(grid), dim3(NTHR), args, LDS_BYTES, stream);
    if (e != hipSuccess) fprintf(stderr, "kernel_launch: cooperative launch failed: %s\n", hipGetErrorString(e));
}
```

```cpp
#include <hip/hip_runtime.h>
#include <hip/hip_cooperative_groups.h>
#include <cstdio>
#include <cstdint>
namespace cg = cooperative_groups;
#ifndef PHM
#define PHM 0xFFFF
#endif
#ifndef REP_F
#define REP_F 1
#endif
#ifndef REP_B
#define REP_B 1
#endif
#ifndef REP_J
#define REP_J 1
#endif
#ifndef REP_P0
#define REP_P0 1
#endif
#ifndef REP_SYNC
#define REP_SYNC 1
#endif
#ifndef REP_EW
#define REP_EW 1
#endif
#ifndef EN192
#define EN192 1
#endif
#ifndef EN128
#define EN128 1
#endif

#define LAS __attribute__((address_space(3)))
typedef unsigned short bf16_t;
typedef short bf16x8 __attribute__((ext_vector_type(8)));
typedef short s16x4 __attribute__((ext_vector_type(4)));
typedef float f32x4 __attribute__((ext_vector_type(4)));
typedef float f32x16 __attribute__((ext_vector_type(16)));
typedef unsigned u32x4 __attribute__((ext_vector_type(4)));
typedef unsigned u32x2 __attribute__((ext_vector_type(2)));

constexpr int DM = 2048, SEQ = 8192, CTXL = 256, TALL = SEQ + CTXL;
constexpr int NIN = 15936, NINP = 16128;
constexpr int P_KB = 0, P_VB = 256, P_CKV = 512, P_KR = 1024, P_QB = 1280, P_CQ = 2304, P_GB = 2816, P_GC = 3840, P_XA = 4864,
              P_U = 5888, P_V = 6912, P_G = 7936;
constexpr int DFF = 8192;
constexpr float EPS = 1e-6f;
constexpr int NWAVES = 8, NTHR = 512;

constexpr size_t MiB = 1u << 20;
constexpr size_t WS_MOD = 0;
constexpr size_t WS_TABB = 256 * 1024;
constexpr size_t WS_TABC = 320 * 1024;
constexpr size_t WS_STATS = 512 * 1024;
constexpr size_t WS_BAR = 768 * 1024;
constexpr int LDS_BARST = 134144;
constexpr size_t WS_W0 = 1 * MiB, W_LSTRIDE = 155 * MiB;
constexpr size_t WO_IN = 0, WO_UQ = 63 * MiB, WO_UKV = WO_UQ + 3 * MiB / 2, WO_BR = WO_UKV + 2 * MiB, WO_OUT = WO_BR + 16 * MiB,
                 WO_F1 = WO_OUT + 8 * MiB, WO_F2 = WO_F1 + 32 * MiB, WO_SG = WO_F2 + 32 * MiB;
constexpr size_t WS_H = 311 * MiB, WS_P = 344 * MiB, WS_KB = 604 * MiB, WS_KR = 609 * MiB, WS_QB = 611 * MiB, WS_CKVN = 628 * MiB,
                 WS_CQN = 637 * MiB, WS_QC = 646 * MiB, WS_KVU = 671 * MiB, WS_YS = 704 * MiB, WS_MRG = 770 * MiB, WS_MG = 836 * MiB,
                 WS_XS = 869 * MiB, WS_ZSLAB = 935 * MiB, WS_END = 967 * MiB;
constexpr size_t YS_STRIDE = (size_t)TALL * 1024;
static_assert(WO_SG + 2 * 8 * 128 * 128 <= W_LSTRIDE, "weights map");

constexpr int LDS_BYTES = 132 * 1024;

__device__ __forceinline__ float bf2f(bf16_t v) { return __uint_as_float(((unsigned)v) << 16); }
__device__ __forceinline__ float bf2f_s(short v) { return __uint_as_float(((unsigned)(unsigned short)v) << 16); }
__device__ __forceinline__ unsigned f2bf(float f) { unsigned u = __float_as_uint(f); return (u + 0x7fffu + ((u >> 16) & 1u)) >> 16; }
__device__ __forceinline__ unsigned pk2(float lo, float hi) { return f2bf(lo) | (f2bf(hi) << 16); }
__device__ __forceinline__ unsigned cvt_pk_bf16(float lo, float hi) { unsigned r; asm volatile("v_cvt_pk_bf16_f32 %0, %1, %2" : "=v"(r) : "v"(lo), "v"(hi)); return r; }
__device__ __forceinline__ float wave_sum(float v) {
#pragma unroll
    for (int o = 1; o < 64; o <<= 1) v += __shfl_xor(v, o);
    return v;
}
__device__ __forceinline__ float half_sum(float v) {
#pragma unroll
    for (int o = 1; o < 32; o <<= 1) v += __shfl_xor(v, o);
    return v;
}

namespace pg8 {
constexpr int BM = 256, BK = 64, HALF = 128, HTB = HALF * BK * 2, STAGE_BYTES = 8 * HTB, NXCD = 8, WGM = 8;
__host__ __device__ __forceinline__ int lds_byte(int r, int c) { const int st = (r >> 4) * 2 + (c >> 5), rr = r & 15, cc = c & 31, ob = rr * 64 + cc * 2; return st * 1024 + (ob ^ (((ob >> 9) & 1) << 5)); }
__host__ __device__ __forceinline__ void stage_rc(int b, int& R, int& C) { const int st = b / 1024, sb = b % 1024, swz = sb ^ (((sb >> 9) & 1) << 5); R = (st >> 1) * 16 + swz / 64; C = (st & 1) * 32 + (swz % 64) / 2; }
__host__ __device__ __forceinline__ int perm32(int rho) { const int n = rho >> 4, i = rho & 15; return 8 * (i >> 2) + 4 * n + (i & 3); }
struct Unit { int pm, pn, z; };

struct SchedWide {
    const bf16_t* A; const bf16_t* Bt; int K, nM, nN, nwg, xpm, xn, G, c;
    __device__ bool next(int i, Unit& u) const {
        long L = (long)i * G + c;
        if (L < nwg) {
            int wgid = (int)L; { const int q = nwg / NXCD, r = nwg % NXCD, xcd = wgid % NXCD, off = wgid / NXCD; wgid = (xcd < r ? xcd * (q + 1) : r * (q + 1) + (xcd - r) * q) + off; }
            const int nig = WGM * nN, gid = wgid / nig, fm = gid * WGM, gsz = (nM - fm) < WGM ? (nM - fm) : WGM;
            u.pm = fm + ((wgid % nig) % gsz); u.pn = (wgid % nig) / gsz; u.z = 0; return true;
        }
        L -= nwg; if (L < xn) { u.pm = xpm; u.pn = (int)L; u.z = 0; return true; }
        return false;
    }
    __device__ __forceinline__ int nt(const Unit&) const { return K / BK; }
    __device__ __forceinline__ const char* aptr(const Unit& u) const { return (const char*)A + (size_t)u.pm * BM * K * 2; }
    __device__ __forceinline__ const char* bptr(const Unit& u) const { return (const char*)Bt + (size_t)u.pn * BM * K * 2; }
};
struct SchedNarrow {
    const bf16_t* A; const bf16_t* Bt; int K, nM, ntiles, G, c;
    __device__ bool next(int i, Unit& u) const { const int t = i * G + c; if (t >= ntiles) return false; u.pm = t % nM; u.pn = t / nM; u.z = 0; return true; }
    __device__ __forceinline__ int nt(const Unit&) const { return K / BK; }
    __device__ __forceinline__ const char* aptr(const Unit& u) const { return (const char*)A + (size_t)u.pm * BM * K * 2; }
    __device__ __forceinline__ const char* bptr(const Unit& u) const { return (const char*)Bt + (size_t)u.pn * BM * K * 2; }
};
struct SchedNarrowZ {
    const bf16_t* A; const bf16_t* Bt; int K, nM, ntiles, G, c, nz, ksl;
    __device__ bool next(int i, Unit& u) const {
        int t = i * G + c;
        if (t < ntiles) { u.pm = t % nM; u.pn = t / nM; u.z = 0; return true; }
        t -= ntiles; if (t >= nz) return false;
        u.pm = 32; u.pn = t & 7; u.z = 1 + (t >> 3); return true;
    }
    __device__ __forceinline__ int nt(const Unit& u) const { return (u.z ? ksl : K) / BK; }
    __device__ __forceinline__ const char* aptr(const Unit& u) const { return (const char*)A + (size_t)u.pm * BM * K * 2 + (u.z ? (size_t)(u.z - 1) * ksl * 2 : (size_t)0); }
    __device__ __forceinline__ const char* bptr(const Unit& u) const { return (const char*)Bt + (size_t)u.pn * BM * K * 2 + (u.z ? (size_t)(u.z - 1) * ksl * 2 : (size_t)0); }
};
struct SchedBranch {
    const bf16_t* A; const bf16_t* Bt; int K, nM, ntiles, G, c; size_t strideA, strideB;
    __device__ bool next(int i, Unit& u) const { const int t = (i >> 2) * G + c; if (t >= ntiles) return false; u.pm = t % nM; u.pn = t / nM; u.z = i & 3; return true; }
    __device__ __forceinline__ int nt(const Unit&) const { return K / BK; }
    __device__ __forceinline__ const char* aptr(const Unit& u) const { return (const char*)(A + (size_t)u.z * strideA) + (size_t)u.pm * BM * K * 2; }
    __device__ __forceinline__ const char* bptr(const Unit& u) const { return (const char*)(Bt + (size_t)u.z * strideB) + (size_t)u.pn * BM * K * 2; }
};
struct SchedDual {
    const bf16_t* A0; const bf16_t* B0; const bf16_t* A1; const bf16_t* B1; int K, nM0, n0, nM1, n1, G, c;
    __device__ bool next(int i, Unit& u) const {
        int L = i * G + c;
        if (L < n0) { u.z = 0; u.pm = L % nM0; u.pn = L / nM0; return true; }
        L -= n0; if (L >= n1) return false;
        u.z = 1; u.pm = L % nM1; u.pn = L / nM1; return true;
    }
    __device__ __forceinline__ int nt(const Unit&) const { return K / BK; }
    __device__ __forceinline__ const char* aptr(const Unit& u) const { return (const char*)(u.z ? A1 : A0) + (size_t)u.pm * BM * K * 2; }
    __device__ __forceinline__ const char* bptr(const Unit& u) const { return (const char*)(u.z ? B1 : B0) + (size_t)u.pn * BM * K * 2; }
};

__device__ __forceinline__ float gelu_tanh(float x) { const float t = 1.5957691216057308f * (x + 0.044715f * x * x * x); return x / (1.f + __expf(-t)); }
__device__ __forceinline__ float sigmoidf(float x) { return 1.f / (1.f + __expf(-x)); }

struct EpiAct {
    static constexpr bool PERM = true;
    bf16_t* O0; int ld0; bf16_t* O1; int ld1; const float* bias; int bias_col0; int gelu_lo, sig_lo; int fixed_act;
    __device__ __forceinline__ void operator()(const f32x4 (&acc)[2][2][4][2], const Unit& u, int wr, int wc, int fr, int fq) const {
        bf16_t* base = u.z ? O1 : O0; const int ldc = u.z ? ld1 : ld0;
        const int act = fixed_act >= 0 ? fixed_act : (u.pn >= sig_lo ? 2 : (u.pn >= gelu_lo ? 1 : 0));
        const int row0 = u.pm * BM + wr * 64 + fr, col0 = u.pn * BM + wc * 32 + 8 * fq;
#pragma unroll
        for (int bj = 0; bj < 2; ++bj) {
            f32x4 b0 = (f32x4){0.f, 0.f, 0.f, 0.f}, b1 = b0;
            if (act == 2) { b0 = *(const f32x4*)(bias + (col0 + bj * HALF - bias_col0)); b1 = *(const f32x4*)(bias + (col0 + bj * HALF - bias_col0 + 4)); }
#pragma unroll
            for (int ai = 0; ai < 2; ++ai)
#pragma unroll
                for (int m = 0; m < 4; ++m) {
                    f32x4 v0 = acc[ai][bj][m][0], v1 = acc[ai][bj][m][1];
                    if (act == 1) {
#pragma unroll
                        for (int j = 0; j < 4; ++j) { v0[j] = gelu_tanh(v0[j]); v1[j] = gelu_tanh(v1[j]); }
                    } else if (act == 2) {
#pragma unroll
                        for (int j = 0; j < 4; ++j) { v0[j] = sigmoidf(v0[j] + b0[j]); v1[j] = sigmoidf(v1[j] + b1[j]); }
                    } else if (act == 3) {
#pragma unroll
                        for (int j = 0; j < 4; ++j) { float a = fmaxf(v0[j], 0.f), b = fmaxf(v1[j], 0.f); v0[j] = a * a; v1[j] = b * b; }
                    }
                    u32x4 w; w.x = cvt_pk_bf16(v0[0], v0[1]); w.y = cvt_pk_bf16(v0[2], v0[3]); w.z = cvt_pk_bf16(v1[0], v1[1]); w.w = cvt_pk_bf16(v1[2], v1[3]);
                    *(u32x4*)(base + (size_t)(row0 + ai * HALF + m * 16) * ldc + col0 + bj * HALF) = w;
                }
        }
    }
};
struct EpiGate {
    static constexpr bool PERM = true;
    const bf16_t* P; float* MRG; bf16_t* MG;
    __device__ __forceinline__ void operator()(const f32x4 (&acc)[2][2][4][2], const Unit& u, int wr, int wc, int fr, int fq) const {
        const int row0 = u.pm * BM + wr * 64 + fr, col0 = u.pn * BM + wc * 32 + 8 * fq; const int z = u.z;
#pragma unroll
        for (int ai = 0; ai < 2; ++ai)
#pragma unroll
            for (int m = 0; m < 4; ++m) {
                const size_t row = (size_t)(row0 + ai * HALF + m * 16);
#pragma unroll
                for (int bj = 0; bj < 2; ++bj) {
                    const int col = col0 + bj * HALF;
                    const bf16x8 g = *(const bf16x8*)(P + row * NINP + P_G + z * DM + col);
                    f32x4 v0 = acc[ai][bj][m][0], v1 = acc[ai][bj][m][1];
#pragma unroll
                    for (int j = 0; j < 4; ++j) { v0[j] *= bf2f_s(g[j]); v1[j] *= bf2f_s(g[4 + j]); }
                    float* mp = MRG + row * DM + col;
                    if (z > 0) { v0 += *(const f32x4*)mp; v1 += *(const f32x4*)(mp + 4); }
                    if (z < 3) { *(f32x4*)mp = v0; *(f32x4*)(mp + 4) = v1; }
                    else { u32x4 w; w.x = cvt_pk_bf16(v0[0], v0[1]); w.y = cvt_pk_bf16(v0[2], v0[3]); w.z = cvt_pk_bf16(v1[0], v1[1]); w.w = cvt_pk_bf16(v1[2], v1[3]);
                           *(u32x4*)(MG + row * DM + col) = w; }
                }
            }
    }
};
struct EpiRes {
    static constexpr bool PERM = false;
    const float* basex; const float* basez; float* out; const float* gx; const float* gz; int zpm; float* slab;
    __device__ __forceinline__ void operator()(const f32x4 (&acc)[2][2][4][2], const Unit& u, int wr, int wc, int fr, int fq) const {
        if (u.z) {
            float* o = slab + (size_t)(u.z - 1) * BM * DM; const int col0 = u.pn * BM + wc * 32 + 4 * fq;
#pragma unroll
            for (int bj = 0; bj < 2; ++bj)
#pragma unroll
                for (int n = 0; n < 2; ++n)
#pragma unroll
                    for (int ai = 0; ai < 2; ++ai)
#pragma unroll
                        for (int m = 0; m < 4; ++m) *(f32x4*)(o + (size_t)(ai * HALF + wr * 64 + m * 16 + fr) * DM + col0 + bj * HALF + n * 16) = acc[ai][bj][m][n];
            return;
        }
        const bool isz = (u.pm == zpm);
        const float* base = isz ? basez : basex + (size_t)u.pm * BM * DM; const float* gv = isz ? gz : gx;
        float* o = out + (size_t)u.pm * BM * DM;
        const int col0 = u.pn * BM + wc * 32 + 4 * fq;
#pragma unroll
        for (int bj = 0; bj < 2; ++bj)
#pragma unroll
            for (int n = 0; n < 2; ++n) {
                const int col = col0 + bj * HALF + n * 16; const f32x4 g4 = *(const f32x4*)(gv + col);
#pragma unroll
                for (int ai = 0; ai < 2; ++ai)
#pragma unroll
                    for (int m = 0; m < 4; ++m) {
                        const size_t off = (size_t)(ai * HALF + wr * 64 + m * 16 + fr) * DM + col;
                        const f32x4 bs = *(const f32x4*)(base + off);
                        *(f32x4*)(o + off) = bs + g4 * acc[ai][bj][m][n];
                    }
            }
    }
};

template <class Epi, class Sched, bool ALIGN_EPI = false, bool SP2 = false>
__device__ __forceinline__ void gemm_phase(LAS unsigned char* lds, const int K, const Sched& S, const Epi& E) {
    int tid_ = threadIdx.x; asm volatile("" : "+v"(tid_));
    const int tid = tid_, wid = __builtin_amdgcn_readfirstlane(tid >> 6), lane = tid & 63, wr = wid >> 2, wc = wid & 3, fr = lane & 15, fq = lane >> 4;
    unsigned voffA[2], voffB[2];
#pragma unroll
    for (int i = 0; i < 2; ++i) { int R, C; stage_rc(tid * 16 + i * 8192, R, C); const int Rb = Epi::PERM ? ((R & ~31) + perm32(R & 31)) : R;
        voffA[i] = (unsigned)(R * K + C) * 2u; voffB[i] = (unsigned)(Rb * K + C) * 2u; }
    const size_t kstep = (size_t)(BK * 2);
    const size_t hstep = (size_t)HALF * K * 2;
    const unsigned ldsw = (unsigned)wid * 1024u;
    const int aoff = lds_byte(wr * 64 + fr, fq * 8), boff = lds_byte(wc * 32 + fr, fq * 8);
#define PG8_SA(b, h) (((b) * 2 + (h)) * HTB)
#define PG8_SB(b, h) ((4 + (b) * 2 + (h)) * HTB)
#define PG8_STAGE(bufoff, gbase, voff) do { _Pragma("unroll") for (int _i = 0; _i < 2; ++_i) \
        __builtin_amdgcn_global_load_lds((const unsigned*)((const char*)(gbase) + (voff)[_i]), (LAS unsigned*)(lds + (bufoff) + ldsw + _i * 8192), 16, 0, 0); } while (0)
#define PG8_LDA(dst, b, h) do { _Pragma("unroll") for (int m = 0; m < 4; ++m) _Pragma("unroll") for (int k = 0; k < 2; ++k) dst[m][k] = *(const LAS bf16x8*)(lds + PG8_SA(b, h) + aoff + m * 2048 + k * 1024); } while (0)
#define PG8_LDB(dst, b, h) do { _Pragma("unroll") for (int n = 0; n < 2; ++n) _Pragma("unroll") for (int k = 0; k < 2; ++k) dst[n][k] = *(const LAS bf16x8*)(lds + PG8_SB(b, h) + boff + n * 2048 + k * 1024); } while (0)
#define PG8_MMA(ai, bj, At, Bt) do { __builtin_amdgcn_s_setprio(1); _Pragma("unroll") for (int m = 0; m < 4; ++m) _Pragma("unroll") for (int n = 0; n < 2; ++n) _Pragma("unroll") for (int k = 0; k < 2; ++k) \
        acc[ai][bj][m][n] = __builtin_amdgcn_mfma_f32_16x16x32_bf16(Bt[n][k], At[m][k], acc[ai][bj][m][n], 0, 0, 0); __builtin_amdgcn_s_setprio(0); } while (0)
#define PG8_WAIT_V(n) asm volatile("s_waitcnt vmcnt(" #n ")" ::: "memory")
#define PG8_WAIT_L(n) asm volatile("s_waitcnt lgkmcnt(" #n ")" ::: "memory")
#define PG8_BAR __builtin_amdgcn_s_barrier()
#define PG8_SCHED __builtin_amdgcn_sched_barrier(0)
    Unit cur, nxt; int ui = 0;
    if (!S.next(0, cur)) return;
    int nt = S.nt(cur);
    f32x4 acc[2][2][4][2];
#pragma unroll
    for (int a = 0; a < 2; ++a)
#pragma unroll
        for (int b = 0; b < 2; ++b)
#pragma unroll
            for (int m = 0; m < 4; ++m)
#pragma unroll
                for (int n = 0; n < 2; ++n) acc[a][b][m][n] = (f32x4){0.f, 0.f, 0.f, 0.f};
    bf16x8 At[4][2], B0[2][2], B1[2][2];
    const char* cA = S.aptr(cur); const char* cB = S.bptr(cur);
    if constexpr (SP2) {
        PG8_STAGE(PG8_SB(0, 0), cB, voffB); PG8_STAGE(PG8_SB(0, 1), cB + hstep, voffB); PG8_STAGE(PG8_SA(0, 0), cA, voffA); PG8_STAGE(PG8_SA(0, 1), cA + hstep, voffA);
        if (wr == 1) PG8_BAR;
        PG8_WAIT_V(2); PG8_BAR;
        PG8_STAGE(PG8_SB(1, 0), cB + kstep, voffB); PG8_STAGE(PG8_SA(1, 0), cA + kstep, voffA); PG8_STAGE(PG8_SB(1, 1), cB + hstep + kstep, voffB);
        PG8_WAIT_V(6); PG8_BAR;
    } else {
        PG8_STAGE(PG8_SB(0, 0), cB, voffB); PG8_STAGE(PG8_SA(0, 0), cA, voffA); PG8_STAGE(PG8_SB(0, 1), cB + hstep, voffB); PG8_STAGE(PG8_SA(0, 1), cA + hstep, voffA);
        if (wr == 1) PG8_BAR;
        PG8_WAIT_V(4); PG8_BAR;
        PG8_STAGE(PG8_SB(1, 0), cB + kstep, voffB); PG8_STAGE(PG8_SA(1, 0), cA + kstep, voffA); PG8_STAGE(PG8_SB(1, 1), cB + hstep + kstep, voffB);
        PG8_WAIT_V(6); PG8_BAR;
    }
    for (;;) {
        const bool has_next = S.next(ui + 1, nxt);
        const char* nA = has_next ? S.aptr(nxt) : cA; const char* nB = has_next ? S.bptr(nxt) : cB;
        for (int t = 0; t < nt; t += 2) {
            const bool last = (t == nt - 2);
            const char* a1 = cA + (size_t)(t + 1) * kstep;
            const char* a2 = last ? nA : cA + (size_t)(t + 2) * kstep; const char* b2 = last ? nB : cB + (size_t)(t + 2) * kstep;
            const char* a3 = a2 + kstep; const char* b3 = b2 + kstep;
            if constexpr (SP2) {
            PG8_LDB(B0, 0, 0); PG8_LDB(B1, 0, 1); PG8_SCHED; PG8_LDA(At, 0, 0); PG8_STAGE(PG8_SA(1, 1), a1 + hstep, voffA);
            PG8_WAIT_V(8); PG8_WAIT_L(0); PG8_BAR; PG8_MMA(0, 0, At, B0); PG8_MMA(0, 1, At, B1); PG8_BAR; PG8_SCHED;
            PG8_LDA(At, 0, 1); PG8_STAGE(PG8_SB(0, 0), b2, voffB); PG8_STAGE(PG8_SB(0, 1), b2 + hstep, voffB); PG8_STAGE(PG8_SA(0, 0), a2, voffA);
            PG8_WAIT_V(8); PG8_WAIT_L(0); PG8_BAR; PG8_MMA(1, 0, At, B0); PG8_MMA(1, 1, At, B1); PG8_BAR; PG8_SCHED;
            PG8_LDB(B0, 1, 0); PG8_LDB(B1, 1, 1); PG8_SCHED; PG8_LDA(At, 1, 0); PG8_STAGE(PG8_SA(0, 1), a2 + hstep, voffA);
            PG8_WAIT_V(8); PG8_WAIT_L(0); PG8_BAR; PG8_MMA(0, 0, At, B0); PG8_MMA(0, 1, At, B1); PG8_BAR; PG8_SCHED;
            PG8_LDA(At, 1, 1); PG8_STAGE(PG8_SB(1, 0), b3, voffB); PG8_STAGE(PG8_SB(1, 1), b3 + hstep, voffB); PG8_STAGE(PG8_SA(1, 0), a3, voffA);
            PG8_WAIT_V(8); PG8_WAIT_L(0); PG8_BAR; PG8_MMA(1, 0, At, B0); PG8_MMA(1, 1, At, B1); PG8_BAR; PG8_SCHED;
            } else {
            PG8_LDB(B0, 0, 0); PG8_SCHED; PG8_LDA(At, 0, 0); PG8_STAGE(PG8_SA(1, 1), a1 + hstep, voffA);
            PG8_WAIT_L(8); PG8_BAR; PG8_WAIT_L(0); PG8_MMA(0, 0, At, B0); PG8_BAR; PG8_SCHED;
            PG8_LDB(B1, 0, 1); PG8_STAGE(PG8_SB(0, 0), b2, voffB);
            PG8_BAR; PG8_WAIT_L(0); PG8_MMA(0, 1, At, B1); PG8_BAR;
            PG8_LDA(At, 0, 1); PG8_STAGE(PG8_SA(0, 0), a2, voffA);
            PG8_BAR; PG8_WAIT_L(0); PG8_MMA(1, 0, At, B0); PG8_BAR; PG8_SCHED;
            PG8_STAGE(PG8_SB(0, 1), b2 + hstep, voffB);
            PG8_WAIT_V(6); PG8_BAR; PG8_MMA(1, 1, At, B1); PG8_BAR;
            PG8_LDB(B0, 1, 0); PG8_SCHED; PG8_LDA(At, 1, 0); PG8_STAGE(PG8_SA(0, 1), a2 + hstep, voffA);
            PG8_WAIT_L(8); PG8_BAR; PG8_WAIT_L(0); PG8_MMA(0, 0, At, B0); PG8_BAR; PG8_SCHED;
            PG8_LDB(B1, 1, 1); PG8_STAGE(PG8_SB(1, 0), b3, voffB);
            PG8_BAR; PG8_WAIT_L(0); PG8_MMA(0, 1, At, B1); PG8_BAR;
            PG8_LDA(At, 1, 1); PG8_STAGE(PG8_SA(1, 0), a3, voffA);
            PG8_BAR; PG8_WAIT_L(0); PG8_MMA(1, 0, At, B0); PG8_BAR; PG8_SCHED;
            PG8_STAGE(PG8_SB(1, 1), b3 + hstep, voffB);
            PG8_WAIT_V(6); PG8_BAR; PG8_MMA(1, 1, At, B1); PG8_BAR;
            }
        }
        if constexpr (ALIGN_EPI) { if (wr == 0) PG8_BAR; }
        E(acc, cur, wr, wc, fr, fq);
        if (!has_next) break;
#pragma unroll
        for (int a = 0; a < 2; ++a)
#pragma unroll
            for (int b = 0; b < 2; ++b)
#pragma unroll
                for (int m = 0; m < 4; ++m)
#pragma unroll
                    for (int n = 0; n < 2; ++n) acc[a][b][m][n] = (f32x4){0.f, 0.f, 0.f, 0.f};
        cur = nxt; cA = nA; cB = nB; ++ui; nt = S.nt(cur);
        if constexpr (ALIGN_EPI) { if (wr == 1) PG8_BAR; }
    }
    PG8_WAIT_V(0);
    if constexpr (!ALIGN_EPI) { if (wr == 0) PG8_BAR; }
    PG8_BAR;
#undef PG8_SA
#undef PG8_SB
#undef PG8_STAGE
#undef PG8_LDA
#undef PG8_LDB
#undef PG8_MMA
#undef PG8_WAIT_V
#undef PG8_WAIT_L
#undef PG8_BAR
#undef PG8_SCHED
}
}

namespace att {
constexpr int NW = 8, QBLK = 32, KVBLK = 64;
constexpr float THR = 8.f;
constexpr size_t SHM_V = KVBLK * 128 * 2;
#define SBAR() __builtin_amdgcn_sched_barrier(0)
__device__ __forceinline__ int crow(int r, int hi) { return (r & 3) + 8 * (r >> 2) + 4 * hi; }
__device__ __forceinline__ unsigned cvtpk(float lo, float hi) { unsigned r; asm volatile("v_cvt_pk_bf16_f32 %0, %1, %2" : "=v"(r) : "v"(lo), "v"(hi)); return r; }

template <int DQ> __device__ __forceinline__ void partialSM(f32x16& p0, f32x16& p1, float& m_reg, float& mn, float& alpha) {
  constexpr float SCALE = (DQ == 128) ? 0.088388347648318440f : 0.072168783648703220f;
  constexpr float C = SCALE * 1.4426950408889634f;
  float pmax = p0[0];
#pragma unroll
  for (int r = 1; r < 16; ++r) pmax = fmaxf(pmax, p0[r]);
#pragma unroll
  for (int r = 0; r < 16; ++r) pmax = fmaxf(pmax, p1[r]);
  { auto rr = __builtin_amdgcn_permlane32_swap(__float_as_uint(pmax), __float_as_uint(pmax), false, false);
    pmax = fmaxf(__uint_as_float(rr[0]), __uint_as_float(rr[1])); }
  if (__builtin_expect(__all(pmax - m_reg <= THR / SCALE), 1)) { mn = m_reg; alpha = 1.f; }
  else { mn = fmaxf(m_reg, pmax); alpha = __builtin_amdgcn_exp2f((m_reg - mn) * C); m_reg = mn; }
  float mnC = -mn * C;
#pragma unroll
  for (int r = 0; r < 16; ++r) p0[r] = fmaf(p0[r], C, mnC);
#pragma unroll
  for (int r = 0; r < 16; ++r) p1[r] = fmaf(p1[r], C, mnC);
#pragma unroll
  for (int r = 0; r < 16; ++r) p0[r] = __builtin_amdgcn_exp2f(p0[r]);
}
__device__ __forceinline__ void finishSM(f32x16& p0, f32x16& p1, float alpha, float& l_reg, bf16x8& pa0, bf16x8& pa1, bf16x8& pa2, bf16x8& pa3) {
#pragma unroll
  for (int r = 0; r < 16; ++r) p1[r] = __builtin_amdgcn_exp2f(p1[r]);
  float ps = 0;
#pragma unroll
  for (int r = 0; r < 16; ++r) ps += p0[r];
#pragma unroll
  for (int r = 0; r < 16; ++r) ps += p1[r];
  { auto rr = __builtin_amdgcn_permlane32_swap(__float_as_uint(ps), __float_as_uint(ps), false, false);
    ps = __uint_as_float(rr[0]) + __uint_as_float(rr[1]); }
  l_reg = l_reg * alpha + ps;
#define PK4(P, BASE, OUT) do { unsigned a0 = cvtpk(P[BASE + 0], P[BASE + 1]), a1 = cvtpk(P[BASE + 2], P[BASE + 3]);   \
    unsigned b0 = cvtpk(P[BASE + 4], P[BASE + 5]), b1 = cvtpk(P[BASE + 6], P[BASE + 7]);                              \
    auto r0 = __builtin_amdgcn_permlane32_swap(a0, b0, false, false); auto r1 = __builtin_amdgcn_permlane32_swap(a1, b1, false, false); \
    u32x4 w = {r0[0], r1[0], r0[1], r1[1]}; OUT = *reinterpret_cast<bf16x8*>(&w); } while (0)
  PK4(p0, 0, pa0); PK4(p0, 8, pa1); PK4(p1, 0, pa2); PK4(p1, 8, pa3);
#undef PK4
}
template <int DQ> __device__ __forceinline__ int kswz(int row, int colB) { return row * (DQ * 2) + (colB ^ ((row & 7) << 4)); }
template <int DQ> __device__ __forceinline__ void qkt(f32x16& p0, f32x16& p1, const char* Ks, const bf16x8* qr, const char* qx, const int (&kb)[4]) {
  p0 = f32x16{}; p1 = f32x16{};
#pragma unroll
  for (int d0 = 0; d0 < DQ / 16; ++d0) {
    bf16x8 b0 = *reinterpret_cast<const bf16x8*>(Ks + kb[d0 & 3] + (d0 >> 2) * 128);
    bf16x8 b1 = *reinterpret_cast<const bf16x8*>(Ks + kb[d0 & 3] + (d0 >> 2) * 128 + 32 * DQ * 2);
    bf16x8 q; if (d0 < 8) q = qr[d0]; else q = *reinterpret_cast<const bf16x8*>(qx + (d0 - 8) * 1024);
    p0 = __builtin_amdgcn_mfma_f32_32x32x16_bf16(b0, q, p0, 0, 0, 0);
    p1 = __builtin_amdgcn_mfma_f32_32x32x16_bf16(b1, q, p1, 0, 0, 0); }
}
__device__ __forceinline__ int v_st(int k, int c) { const int kk = (k & ~0xC) | ((k & 4) << 1) | ((k & 8) >> 1); return ((kk >> 3) * 4 + (c >> 5)) * 512 + ((kk & 7) * 32 + (c & 31)) * 2; }
__device__ __forceinline__ int v_rd_base(int lane) { return ((lane & 3) << 3) | (((lane >> 2) & 3) << 6) | (((lane >> 4) & 1) << 5) | (((lane >> 5) & 1) << 8); }
constexpr int v_rd_off(int d0, int ks, int half) { return d0 * 512 + ks * 4096 + half * 2048; }
template <int OFF> __device__ __forceinline__ s16x4 tr_read(int vb) {
  s16x4 r; asm volatile("ds_read_b64_tr_b16 %0, %1 offset:%2" : "=&v"(r) : "v"(vb), "i"(OFF) : "memory"); return r;
}
template <int D0> __device__ __forceinline__ void pv_one(f32x16& od, int vb, bf16x8 pa0, bf16x8 pa1, bf16x8 pa2, bf16x8 pa3) {
  const s16x4 l0 = tr_read<v_rd_off(D0, 0, 0)>(vb), h0 = tr_read<v_rd_off(D0, 0, 1)>(vb), l1 = tr_read<v_rd_off(D0, 1, 0)>(vb), h1 = tr_read<v_rd_off(D0, 1, 1)>(vb);
  const s16x4 l2 = tr_read<v_rd_off(D0, 2, 0)>(vb), h2 = tr_read<v_rd_off(D0, 2, 1)>(vb), l3 = tr_read<v_rd_off(D0, 3, 0)>(vb), h3 = tr_read<v_rd_off(D0, 3, 1)>(vb);
  asm volatile("s_waitcnt lgkmcnt(0)" ::: "memory"); SBAR();
#define PK(L, H) (bf16x8){L[0], L[1], L[2], L[3], H[0], H[1], H[2], H[3]}
  od = __builtin_amdgcn_mfma_f32_32x32x16_bf16(pa0, PK(l0, h0), od, 0, 0, 0);
  od = __builtin_amdgcn_mfma_f32_32x32x16_bf16(pa1, PK(l1, h1), od, 0, 0, 0);
  od = __builtin_amdgcn_mfma_f32_32x32x16_bf16(pa2, PK(l2, h2), od, 0, 0, 0);
  od = __builtin_amdgcn_mfma_f32_32x32x16_bf16(pa3, PK(l3, h3), od, 0, 0, 0);
#undef PK
}
__device__ __forceinline__ void pv_d0(f32x16* o, int vb, bf16x8 pa0, bf16x8 pa1, bf16x8 pa2, bf16x8 pa3) {
  pv_one<0>(o[0], vb, pa0, pa1, pa2, pa3); pv_one<1>(o[1], vb, pa0, pa1, pa2, pa3); pv_one<2>(o[2], vb, pa0, pa1, pa2, pa3); pv_one<3>(o[3], vb, pa0, pa1, pa2, pa3);
}

template <int DQ, int ldq, int ldk0, int ldk1, int ldv, int ldo>
__device__ __forceinline__ void attn_body(const bf16_t* __restrict__ Qb, const bf16_t* __restrict__ K0, const bf16_t* __restrict__ K1,
                                          const bf16_t* __restrict__ Vh, bf16_t* __restrict__ Ob, int seq, char* lds, bool ropeq, int qpos0, const float2* __restrict__ tabC) {
  constexpr size_t SHM_K = KVBLK * DQ * 2;
  int tid_ = threadIdx.x; asm volatile("" : "+v"(tid_));
  const int tid = tid_, wid = tid >> 6, lane = tid & 63, r32 = lane & 31, hi = lane >> 5;
  char* V_lds = lds; char* K_lds = lds + 2 * SHM_V;
  float* ws = (float*)(lds + 2 * SHM_V + 2 * SHM_K) + wid * 64; float* li_l = ws; float* al_l = ws + 32;
  float m_reg = -1e30f, l_reg = 0; f32x16 o[4] = {}; bf16x8 qr[8];
  const bf16_t* Qw = Qb + (long)(wid * QBLK + r32) * ldq + hi * 8;
#pragma unroll
  for (int d0 = 0; d0 < 8; ++d0) qr[d0] = *reinterpret_cast<const bf16x8*>(Qw + d0 * 16);
  char* qx = lds + 2 * SHM_V + 2 * SHM_K + 2048 + wid * 4096 + lane * 16;
  if constexpr (DQ == 192) {
    const int t = qpos0 + wid * QBLK + r32;
#pragma unroll
    for (int ax = 0; ax < 2; ++ax) {
      const int pos = ax ? (t & 63) : (t >> 6); const float2* tb = tabC + pos * 16 + hi * 8;
      bf16x8 a = *reinterpret_cast<const bf16x8*>(Qw + (8 + 2 * ax) * 16), b = *reinterpret_cast<const bf16x8*>(Qw + (9 + 2 * ax) * 16);
      if (ropeq) {
#pragma unroll
        for (int j = 0; j < 8; ++j) { const float2 cs = tb[j]; const float x1 = bf2f_s(a[j]), x2 = bf2f_s(b[j]);
          a[j] = (short)f2bf(x1 * cs.x - x2 * cs.y); b[j] = (short)f2bf(x1 * cs.y + x2 * cs.x); }
      }
      *reinterpret_cast<bf16x8*>(qx + (2 * ax) * 1024) = a; *reinterpret_cast<bf16x8*>(qx + (2 * ax + 1) * 1024) = b;
    }
  }
  int kb[4];
#pragma unroll
  for (int m = 0; m < 4; ++m) kb[m] = kswz<DQ>(r32, m * 32 + hi * 16);
  const int sr = tid >> 4, sc = (tid & 15) * 8, vst0 = v_st(sr, sc), vst1 = v_st(32 + sr, sc);
  const int sr2 = tid >> 3, sc2 = (tid & 7) * 8;
  const int vb0 = (int)(uintptr_t)V_lds + v_rd_base(lane);
  struct { bf16x8 vs0, vs1, ks0, ks1, ks2; } sr_[1];
#define SLOAD(i, k0) do { sr_[i].vs0 = *(const bf16x8*)(&Vh[(long)((k0) + sr) * ldv + sc]); sr_[i].vs1 = *(const bf16x8*)(&Vh[(long)((k0) + 32 + sr) * ldv + sc]); \
    sr_[i].ks0 = *(const bf16x8*)(&K0[(long)((k0) + sr) * ldk0 + sc]); sr_[i].ks1 = *(const bf16x8*)(&K0[(long)((k0) + 32 + sr) * ldk0 + sc]); \
    if constexpr (DQ == 192) sr_[i].ks2 = *(const bf16x8*)(&K1[(long)((k0) + sr2) * ldk1 + sc2]); } while (0)
#define SWRITE(b, i) do { *(bf16x8*)(V_lds + (b) * SHM_V + vst0) = sr_[i].vs0;          \
    *(bf16x8*)(V_lds + (b) * SHM_V + vst1) = sr_[i].vs1; int kc = sc * 2;               \
    *(bf16x8*)(K_lds + (b) * SHM_K + kswz<DQ>(sr, kc)) = sr_[i].ks0;                       \
    *(bf16x8*)(K_lds + (b) * SHM_K + kswz<DQ>(32 + sr, kc)) = sr_[i].ks1;                  \
    if constexpr (DQ == 192) *(bf16x8*)(K_lds + (b) * SHM_K + kswz<DQ>(sr2, 256 + sc2 * 2)) = sr_[i].ks2; } while (0)
#define SWAIT() asm volatile("s_waitcnt vmcnt(0)" ::: "memory")
#define RESC(a) do { if (__any((a) < 1.f)) { if (hi == 0) al_l[r32] = (a); asm volatile("s_waitcnt lgkmcnt(0)" ::: "memory"); \
    _Pragma("unroll") for (int d = 0; d < 4; ++d) _Pragma("unroll") for (int r = 0; r < 16; ++r) o[d][r] *= al_l[crow(r, hi)]; } } while (0)
  f32x16 pA0, pA1, pB0, pB1; float mnA, mnB, alA, alB; bf16x8 pa0, pa1, pa2, pa3; const int NT = seq / KVBLK;
  SLOAD(0, 0); SWAIT(); SWRITE(0, 0); __syncthreads();
  qkt<DQ>(pA0, pA1, K_lds, qr, qx, kb); partialSM<DQ>(pA0, pA1, m_reg, mnA, alA);
  SLOAD(0, KVBLK);
  SWAIT(); SWRITE(1, 0); __syncthreads();
  for (int j = 1; j + 1 < NT; j += 2) {
    SBAR(); qkt<DQ>(pB0, pB1, K_lds + SHM_K, qr, qx, kb);
    finishSM(pA0, pA1, alA, l_reg, pa0, pa1, pa2, pa3); SBAR();
    SLOAD(0, (j + 1) * KVBLK); SBAR();
    pv_d0(o, vb0, pa0, pa1, pa2, pa3); partialSM<DQ>(pB0, pB1, m_reg, mnB, alB);
    __syncthreads(); SWAIT(); SWRITE(0, 0);
    RESC(alB); __syncthreads();
    SBAR(); qkt<DQ>(pA0, pA1, K_lds, qr, qx, kb);
    finishSM(pB0, pB1, alB, l_reg, pa0, pa1, pa2, pa3); SBAR();
    SLOAD(0, (j + 2) * KVBLK); SBAR();
    pv_d0(o, vb0 + (int)SHM_V, pa0, pa1, pa2, pa3); partialSM<DQ>(pA0, pA1, m_reg, mnA, alA);
    __syncthreads(); SWAIT(); SWRITE(1, 0);
    RESC(alA); __syncthreads();
  }
  SBAR(); qkt<DQ>(pB0, pB1, K_lds + SHM_K, qr, qx, kb);
  finishSM(pA0, pA1, alA, l_reg, pa0, pa1, pa2, pa3); SBAR();
  pv_d0(o, vb0, pa0, pa1, pa2, pa3); partialSM<DQ>(pB0, pB1, m_reg, mnB, alB);
  __syncthreads(); RESC(alB);
  finishSM(pB0, pB1, alB, l_reg, pa0, pa1, pa2, pa3); SBAR();
  pv_d0(o, vb0 + (int)SHM_V, pa0, pa1, pa2, pa3);
  if (hi == 0) li_l[r32] = l_reg; asm volatile("s_waitcnt lgkmcnt(0)" ::: "memory");
  float rli[16];
#pragma unroll
  for (int r = 0; r < 16; ++r) rli[r] = __builtin_amdgcn_rcpf(li_l[crow(r, hi)]);
  bf16_t* Ow = Ob + (long)(wid * QBLK) * ldo;
#pragma unroll
  for (int r = 0; r < 16; ++r) { int orow = crow(r, hi);
#pragma unroll
    for (int d0 = 0; d0 < 4; ++d0) Ow[(long)orow * ldo + d0 * 32 + r32] = (bf16_t)f2bf(o[d0][r] * rli[r]); }
  __syncthreads();
#undef SLOAD
#undef SWRITE
#undef SWAIT
#undef RESC
}
#undef SBAR
}


#define XB_TMO      128
#define XB_XCNT(j)  (256  + 64 * (j))
#define XB_XSUB(j)  (1280 + 64 * (j))
#define XB_XGEN(j)  (2304 + 64 * (j))
#define XB_TOP      3328
#define XB_TOPGEN   3392
#define XCD_BAR_WORDS 3456
#define XB_SPIN_CAP (1u << 20)
__device__ __forceinline__ unsigned xb_ld(unsigned* p)              { return __hip_atomic_load(p, __ATOMIC_RELAXED, __HIP_MEMORY_SCOPE_AGENT); }
__device__ __forceinline__ unsigned xb_add(unsigned* p, unsigned v) { return __hip_atomic_fetch_add(p, v, __ATOMIC_RELAXED, __HIP_MEMORY_SCOPE_AGENT); }
__device__ __forceinline__ unsigned xb_xcc_id() { return (unsigned)__builtin_amdgcn_s_getreg((3 << 11) | 20) & 0xFu; }
#define XB_SPIN(cond, bar) do { unsigned _sp = 0; while (cond) { __builtin_amdgcn_s_sleep(1); \
    if ((++_sp & 255u) == 0u) { if (xb_ld(&(bar)[XB_TMO])) break; if (_sp > XB_SPIN_CAP) { atomicAdd(&(bar)[XB_TMO], 1u); break; } } } } while (0)
struct XcdBarrier { unsigned* bar; unsigned x; volatile LAS unsigned* st; };
__device__ __forceinline__ XcdBarrier xcd_barrier_post(unsigned* bar, volatile LAS unsigned* st) {
    XcdBarrier b; b.bar = bar; b.x = xb_xcc_id(); b.st = st;
    if (threadIdx.x == 0) (void)xb_add(&bar[XB_XCNT(b.x)], 1u);
    return b;
}
__device__ __forceinline__ void xcd_barrier_complete(unsigned* bar, unsigned x, unsigned& nloc, unsigned& nx) {
    const unsigned G = gridDim.x * gridDim.y * gridDim.z;
    unsigned sum, cnt, mine, sp = 0u;
    for (;;) {
        sum = 0u; cnt = 0u; mine = 0u;
#pragma unroll
        for (unsigned j = 0; j < 16; ++j) { const unsigned c = xb_ld(&bar[XB_XCNT(j)]); sum += c; cnt += (c > 0u) ? 1u : 0u; mine = (j == x) ? c : mine; }
        if (sum == G) break;
        __builtin_amdgcn_s_sleep(1);
        if ((++sp & 255u) == 0u) { if (xb_ld(&bar[XB_TMO])) break; if (sp > XB_SPIN_CAP) { atomicAdd(&bar[XB_TMO], 1u); break; } }
    }
    nloc = mine > 0u ? mine : 1u; nx = cnt > 0u ? cnt : 1u;
}
__device__ __forceinline__ void xcd_barrier(const XcdBarrier& b) {
    asm volatile("s_waitcnt vmcnt(0)" ::: "memory");
    __syncthreads();
    if (threadIdx.x == 0) {
        unsigned* bar = b.bar;
        __builtin_amdgcn_s_waitcnt(0);
        unsigned nloc = b.st[0], nx = b.st[1];
        if (nloc == 0u) { xcd_barrier_complete(bar, b.x, nloc, nx); b.st[0] = nloc; b.st[1] = nx; }
        const unsigned old = xb_add(&bar[XB_XSUB(b.x)], 1u);
        const unsigned gen = old / nloc;
        if (old + 1u == (gen + 1u) * nloc) {
            __builtin_amdgcn_fence(__ATOMIC_RELEASE, "agent");
            asm volatile("s_waitcnt vmcnt(0)" ::: "memory");
            const unsigned og = xb_add(&bar[XB_TOP], 1u);
            const unsigned tg = og / nx;
            if (og + 1u == (tg + 1u) * nx) xb_add(&bar[XB_TOPGEN], 1u);
            else XB_SPIN(xb_ld(&bar[XB_TOPGEN]) == tg, bar);
            __builtin_amdgcn_fence(__ATOMIC_ACQUIRE, "agent");
            xb_add(&bar[XB_XGEN(b.x)], 1u);
            asm volatile("s_waitcnt vmcnt(0)" ::: "memory");
        } else {
            XB_SPIN(xb_ld(&bar[XB_XGEN(b.x)]) == gen, bar);
            __builtin_amdgcn_fence(__ATOMIC_ACQUIRE, "agent");
            asm volatile("s_waitcnt vmcnt(0)" ::: "memory");
        }
    }
    __syncthreads();
}

struct Params { const float* in[26]; float* out; unsigned char* ws; };
enum { I_X = 0, I_C, I_CTX, I_CCTX, I_WADA, I_BADA, I_NMIXG, I_WIN, I_BGATE, I_CONVW, I_QNG, I_KNG, I_MQNG, I_MKVNG, I_WUQ, I_WUKV, I_SLNG, I_SLNB,
       I_SWS, I_SBS, I_WBR, I_WOUT, I_NFFNG, I_WFF1, I_WFF2, I_FNG };

__device__ __forceinline__ void transpose_item(const float* W, int K, int N, bf16_t* WT, bool padmode, LAS float* scr, int item, int lane) {
    const int nblk = N / 64, kb = item / nblk, nb = item % nblk, k0 = 64 * kb, n0 = 64 * nb;
    const int lr = lane >> 4, lc = (lane & 15) * 4;
    f32x4 v[16];
#pragma unroll
    for (int i = 0; i < 16; ++i) v[i] = *(const f32x4*)(W + (size_t)(k0 + 4 * i + lr) * N + n0 + lc);
#pragma unroll
    for (int i = 0; i < 16; ++i) { LAS float* d = scr + (4 * i + lr) * 65 + lc; d[0] = v[i][0]; d[1] = v[i][1]; d[2] = v[i][2]; d[3] = v[i][3]; }
    asm volatile("s_waitcnt lgkmcnt(0)" ::: "memory");
    const int c = lane & 7; const int roff = (padmode && n0 >= 1088) ? 192 : 0;
#pragma unroll
    for (int j = 0; j < 8; ++j) { const int n = (lane >> 3) + 8 * j; const LAS float* s = scr + (8 * c) * 65 + n;
        u32x4 o; o.x = pk2(s[0 * 65], s[1 * 65]); o.y = pk2(s[2 * 65], s[3 * 65]); o.z = pk2(s[4 * 65], s[5 * 65]); o.w = pk2(s[6 * 65], s[7 * 65]);
        *(u32x4*)(WT + (size_t)(roff + n0 + n) * K + k0 + 8 * c) = o; }
    asm volatile("s_waitcnt lgkmcnt(0)" ::: "memory");
}

typedef const Params __attribute__((address_space(4))) KParams;
__global__ void __launch_bounds__(NTHR, 2) mega_fwd(Params p_arg) {
    extern __shared__ __attribute__((aligned(16))) unsigned char lds_raw[];
    cg::grid_group grid = cg::this_grid();
    LAS unsigned char* lds = (LAS unsigned char*)lds_raw;
    const int tid0 = threadIdx.x, wave = __builtin_amdgcn_readfirstlane(tid0 >> 6);
    const int G = gridDim.x;
#define PHASE_IDS() int tid = tid0; asm volatile("" : "+v"(tid)); const int lane = tid & 63; (void)lane
    const int NGW = G * NWAVES;
#define WS_PTRS() KParams* pk_ = (KParams*)__builtin_amdgcn_kernarg_segment_ptr(); asm volatile("" : "+s"(pk_)); KParams& p = *pk_;   \
    unsigned char* ws = p.ws; asm volatile("" : "+s"(ws)); int bx_ = blockIdx.x; asm volatile("" : "+s"(bx_)); const int bx = bx_, gw = bx * NWAVES + wave; (void)gw; \
    float* MOD = (float*)(ws + WS_MOD); float2* tabB = (float2*)(ws + WS_TABB); float2* tabC = (float2*)(ws + WS_TABC); float2* stats = (float2*)(ws + WS_STATS); \
    bf16_t* H = (bf16_t*)(ws + WS_H); bf16_t* P = (bf16_t*)(ws + WS_P); bf16_t* U = (bf16_t*)(ws + WS_P); \
    bf16_t* KB = (bf16_t*)(ws + WS_KB); bf16_t* KR = (bf16_t*)(ws + WS_KR); bf16_t* QB = (bf16_t*)(ws + WS_QB); \
    bf16_t* CKVN = (bf16_t*)(ws + WS_CKVN); bf16_t* CQN = (bf16_t*)(ws + WS_CQN); bf16_t* QC = (bf16_t*)(ws + WS_QC); bf16_t* KVU = (bf16_t*)(ws + WS_KVU); \
    bf16_t* YS = (bf16_t*)(ws + WS_YS); float* MRG = (float*)(ws + WS_MRG); bf16_t* MG = (bf16_t*)(ws + WS_MG); float* XS = (float*)(ws + WS_XS); float* ZSLAB = (float*)(ws + WS_ZSLAB); \
    (void)MOD; (void)tabB; (void)tabC; (void)stats; (void)H; (void)P; (void)U; (void)KB; (void)KR; (void)QB; (void)CKVN; (void)CQN; (void)QC; (void)KVU; (void)YS; (void)MRG; (void)MG; (void)XS; (void)ZSLAB
#define LAYER_PTRS() unsigned char* wl = ws + WS_W0 + l * W_LSTRIDE; \
    const bf16_t* Win_t = (const bf16_t*)(wl + WO_IN); const bf16_t* Wuq_t = (const bf16_t*)(wl + WO_UQ); const bf16_t* Wukv_t = (const bf16_t*)(wl + WO_UKV); \
    const bf16_t* Wbr_t = (const bf16_t*)(wl + WO_BR); const bf16_t* Wout_t = (const bf16_t*)(wl + WO_OUT); const bf16_t* W1_t = (const bf16_t*)(wl + WO_F1); \
    const bf16_t* W2_t = (const bf16_t*)(wl + WO_F2); const bf16_t* Wsg = (const bf16_t*)(wl + WO_SG); \
    const float* modx = MOD + (size_t)(l * 2 + 0) * 12288; const float* modz = MOD + (size_t)(l * 2 + 1) * 12288; \
    const float* xsrc = l0 ? p.in[I_X] : XS; const float* zsrc = l0 ? p.in[I_CTX] : XS + (size_t)SEQ * DM; \
    (void)Win_t; (void)Wuq_t; (void)Wukv_t; (void)Wbr_t; (void)Wout_t; (void)W1_t; (void)W2_t; (void)Wsg; (void)modx; (void)modz; (void)xsrc; (void)zsrc

    {
        if (blockIdx.x == 0) for (int i = tid0; i < XCD_BAR_WORDS; i += NTHR) ((unsigned*)(p_arg.ws + WS_BAR))[i] = 0u;
        if (tid0 < 2) ((volatile LAS unsigned*)(lds + LDS_BARST))[tid0] = 0u;
    }
#if (PHM & 1)
    for (int rp0_ = 0; rp0_ < REP_P0; ++rp0_)
    {
        PHASE_IDS(); WS_PTRS();
#if (PHM & 4096)
        LAS float* sl = (LAS float*)lds;
        LAS float* red = (LAS float*)(lds + 16384);
        if (bx < 192) {
            for (int i = tid; i < 4096; i += NTHR) { const int cond = i >> 11, k = i & 2047; const float v = (cond ? p.in[I_CCTX] : p.in[I_C])[k]; sl[i] = v / (1.f + __expf(-v)); }
            __syncthreads();
        }
        for (int item = bx; item < 192; item += G) {
            typedef float f32x2 __attribute__((ext_vector_type(2)));
            const int l = item / 96, n0 = (item % 96) * 128;
            const float* wp = p.in[I_WADA] + (size_t)l * DM * 12288 + n0 + lane * 2;
            f32x2 a0 = (f32x2){0.f, 0.f}, a1 = a0;
#pragma unroll 16
            for (int kk = 0; kk < 256; ++kk) { const int k = wave * 256 + kk; const f32x2 wv = *(const f32x2*)(wp + (size_t)k * 12288); a0 += wv * sl[k]; a1 += wv * sl[2048 + k]; }
            *(LAS f32x2*)(red + (wave * 2 + 0) * 128 + lane * 2) = a0; *(LAS f32x2*)(red + (wave * 2 + 1) * 128 + lane * 2) = a1;
            __syncthreads();
            if (tid < 256) { const int cond = tid >> 7, col = tid & 127; float s = p.in[I_BADA][(size_t)l * 12288 + n0 + col];
#pragma unroll
              for (int w = 0; w < 8; ++w) s += red[(w * 2 + cond) * 128 + col];
              MOD[(size_t)(l * 2 + cond) * 12288 + n0 + col] = s; }
            __syncthreads();
        }
#endif
#if (PHM & 8192)
        for (int idx = bx * NTHR + tid; idx < 128 * 48; idx += G * NTHR) {
            const int pos = idx / 48, j = idx % 48;
            if (j < 32) { const float inv = powf(10000.0f, -(float)(2 * j) / 64.0f); const float ang = (float)pos * inv; tabB[pos * 32 + j] = make_float2(cosf(ang), sinf(ang)); }
            else { const int i = j - 32; const float inv = powf(10000.0f, -(float)(2 * i) / 32.0f); const float ang = (float)pos * inv; tabC[pos * 16 + i] = make_float2(cosf(ang), sinf(ang)); }
        }
#endif
#if (PHM & 16384)
        for (int idx = bx * NTHR + tid; idx < 2 * 131072 / 4; idx += G * NTHR) {
            const int l = idx / 32768, r = idx % 32768; const f32x4 v = *(const f32x4*)(p.in[I_SWS] + (size_t)idx * 4);
            u32x2 o; o.x = pk2(v[0], v[1]); o.y = pk2(v[2], v[3]);
            *(u32x2*)((bf16_t*)(ws + WS_W0 + l * W_LSTRIDE + WO_SG) + (size_t)r * 4) = o;
        }
#endif
        __syncthreads();
#if (PHM & 32768)
        LAS float* scr = (LAS float*)(lds + wave * 16640);
        constexpr int PER_L = 7968 + 192 + 256 + 2048 + 1024 + 4096 + 4096;
        for (int it = gw; it < 2 * PER_L; it += NGW) {
            const int l = it / PER_L; int r = it % PER_L; unsigned char* wl = ws + WS_W0 + l * W_LSTRIDE;
            if (r < 7968) { transpose_item(p.in[I_WIN] + (size_t)l * DM * NIN, DM, NIN, (bf16_t*)(wl + WO_IN), true, scr, r, lane); continue; } r -= 7968;
            if (r < 192) { transpose_item(p.in[I_WUQ] + (size_t)l * 512 * 1536, 512, 1536, (bf16_t*)(wl + WO_UQ), false, scr, r, lane); continue; } r -= 192;
            if (r < 256) { transpose_item(p.in[I_WUKV] + (size_t)l * 512 * 2048, 512, 2048, (bf16_t*)(wl + WO_UKV), false, scr, r, lane); continue; } r -= 256;
            if (r < 2048) { const int br = r >> 9; transpose_item(p.in[I_WBR] + (size_t)(l * 4 + br) * 1024 * DM, 1024, DM, (bf16_t*)(wl + WO_BR) + (size_t)br * DM * 1024, false, scr, r & 511, lane); continue; } r -= 2048;
            if (r < 1024) { transpose_item(p.in[I_WOUT] + (size_t)l * DM * DM, DM, DM, (bf16_t*)(wl + WO_OUT), false, scr, r, lane); continue; } r -= 1024;
            if (r < 4096) { transpose_item(p.in[I_WFF1] + (size_t)l * DM * DFF, DM, DFF, (bf16_t*)(wl + WO_F1), false, scr, r, lane); continue; } r -= 4096;
            transpose_item(p.in[I_WFF2] + (size_t)l * DFF * DM, DFF, DM, (bf16_t*)(wl + WO_F2), false, scr, r, lane);
        }
#endif
    }
    #endif
        grid.sync();
        const XcdBarrier xb = xcd_barrier_post((unsigned*)(p_arg.ws + WS_BAR), (volatile LAS unsigned*)(lds + LDS_BARST));

    for (int l = 0; l < 2; ++l) {
        const bool l0 = (l == 0);
        const int TQ = l0 ? TALL : SEQ;
        const int nMq = TQ / 256;

#if (PHM & 2)
        {
        WS_PTRS(); LAYER_PTRS();
        PHASE_IDS();
            const float* gmix = p.in[I_NMIXG] + (size_t)l * DM;
            for (int rew_ = 0; rew_ < REP_EW; ++rew_)
            for (int row = gw; row < TALL; row += NGW) {
                const bool isz = row >= SEQ; const float* src = isz ? zsrc + (size_t)(row - SEQ) * DM : xsrc + (size_t)row * DM; const float* md = isz ? modz : modx;
                f32x4 v[8]; float ss = 0.f;
#pragma unroll
                for (int j = 0; j < 8; ++j) v[j] = *(const f32x4*)(src + (lane + 64 * j) * 4);
                if (isz && !l0) {
                    const float* g2z = MOD + (size_t)12288 + 5 * 2048;
#pragma unroll
                    for (int j = 0; j < 8; ++j) { const int c = (lane + 64 * j) * 4; f32x4 s = (f32x4){0.f, 0.f, 0.f, 0.f};
                        for (int ks = 0; ks < 16; ++ks) s += *(const f32x4*)(ZSLAB + ((size_t)ks * 256 + (row - SEQ)) * DM + c);
                        v[j] += *(const f32x4*)(g2z + c) * s; }
                }
#pragma unroll
                for (int j = 0; j < 8; ++j) ss += v[j][0] * v[j][0] + v[j][1] * v[j][1] + v[j][2] * v[j][2] + v[j][3] * v[j][3];
                const float r = rsqrtf(wave_sum(ss) * (1.f / DM) + EPS);
#pragma unroll
                for (int j = 0; j < 8; ++j) { const int c = (lane + 64 * j) * 4; const f32x4 g = *(const f32x4*)(gmix + c), sh = *(const f32x4*)(md + c), sc = *(const f32x4*)(md + 2048 + c);
                    f32x4 h = (v[j] * r * g) * (sc + 1.f) + sh; u32x2 o; o.x = pk2(h[0], h[1]); o.y = pk2(h[2], h[3]); *(u32x2*)(H + (size_t)row * DM + c) = o; }
            }
        }
        #endif
        for (int rs_ = 0; rs_ < REP_SYNC; ++rs_) xcd_barrier(xb);

#if (PHM & 4)
        {
        WS_PTRS(); LAYER_PTRS();
            pg8::SchedWide S{H, Win_t, DM, nMq, NINP / 256, nMq * (NINP / 256), 32, l0 ? 0 : 5, G, bx};
            pg8::EpiAct E{P, NINP, P, NINP, p.in[I_BGATE] + (size_t)l * 8192, P_G, P_U / 256, P_G / 256, -1};
            int nrep = REP_B; asm volatile("" : "+s"(nrep));
            for (int rep = 0; rep < nrep; ++rep) pg8::gemm_phase<pg8::EpiAct, pg8::SchedWide, true, true>(lds, DM, S, E);
        }
        #endif
        for (int rs_ = 0; rs_ < REP_SYNC; ++rs_) xcd_barrier(xb);

#if (PHM & 8)
        {
        WS_PTRS(); LAYER_PTRS();
        PHASE_IDS();
            const float* kng = p.in[I_KNG] + l * 128; const float* qng = p.in[I_QNG] + l * 128;
            const float* mqg = p.in[I_MQNG] + l * 512; const float* mkg = p.in[I_MKVNG] + l * 512; const float* cw = p.in[I_CONVW] + (size_t)l * 3 * 1024;
            for (int rew_ = 0; rew_ < REP_EW; ++rew_)
            for (int t = gw; t < TALL; t += NGW) {
                const bool isz = t >= SEQ, full = l0 || !isz; const bf16_t* pr = P + (size_t)t * NINP;
                const int li = lane & 31, hh = lane >> 5;
                const float2 csr = tabB[(t >> 6) * 32 + li], csc = tabB[(t & 63) * 32 + li];
                { const bf16_t* s = pr + P_KB + hh * 128 + li; float y0 = bf2f(s[0]), y1 = bf2f(s[32]), y2 = bf2f(s[64]), y3 = bf2f(s[96]);
                  const float r = rsqrtf(half_sum(y0 * y0 + y1 * y1 + y2 * y2 + y3 * y3) * (1.f / 128.f) + EPS);
                  y0 *= r * kng[li]; y1 *= r * kng[32 + li]; y2 *= r * kng[64 + li]; y3 *= r * kng[96 + li];
                  if (!isz) { const float a0 = y0 * csr.x - y1 * csr.y, a1 = y0 * csr.y + y1 * csr.x, a2 = y2 * csc.x - y3 * csc.y, a3 = y2 * csc.y + y3 * csc.x; y0 = a0; y1 = a1; y2 = a2; y3 = a3; }
                  bf16_t* d = KB + (size_t)t * 256 + hh * 128 + li; d[0] = (bf16_t)f2bf(y0); d[32] = (bf16_t)f2bf(y1); d[64] = (bf16_t)f2bf(y2); d[96] = (bf16_t)f2bf(y3); }
                { const bf16x8 v = *(const bf16x8*)(pr + P_CKV + lane * 8); float f[8], ss = 0.f;
#pragma unroll
                  for (int j = 0; j < 8; ++j) { f[j] = bf2f_s(v[j]); ss += f[j] * f[j]; }
                  const float r = rsqrtf(wave_sum(ss) * (1.f / 512.f) + EPS); u32x4 o;
                  o.x = pk2(f[0] * r * mkg[lane * 8 + 0], f[1] * r * mkg[lane * 8 + 1]); o.y = pk2(f[2] * r * mkg[lane * 8 + 2], f[3] * r * mkg[lane * 8 + 3]);
                  o.z = pk2(f[4] * r * mkg[lane * 8 + 4], f[5] * r * mkg[lane * 8 + 5]); o.w = pk2(f[6] * r * mkg[lane * 8 + 6], f[7] * r * mkg[lane * 8 + 7]);
                  *(u32x4*)(CKVN + (size_t)t * 512 + lane * 8) = o; }
                if (lane < 32) { const int ax = lane >> 4, i = lane & 15; const bf16_t* s = pr + P_KR + ax * 32 + i; float x1 = bf2f(s[0]), x2 = bf2f(s[16]);
                  if (!isz) { const float2 cs = tabC[(ax ? (t & 63) : (t >> 6)) * 16 + i]; const float a = x1 * cs.x - x2 * cs.y, b = x1 * cs.y + x2 * cs.x; x1 = a; x2 = b; }
                  bf16_t* d = KR + (size_t)t * 64 + ax * 32 + i; d[0] = (bf16_t)f2bf(x1); d[16] = (bf16_t)f2bf(x2); }
                if (full) {
#pragma unroll
                    for (int it = 0; it < 4; ++it) { const int hd = it * 2 + hh; const bf16_t* s = pr + P_QB + hd * 128 + li; float y0 = bf2f(s[0]), y1 = bf2f(s[32]), y2 = bf2f(s[64]), y3 = bf2f(s[96]);
                      const float r = rsqrtf(half_sum(y0 * y0 + y1 * y1 + y2 * y2 + y3 * y3) * (1.f / 128.f) + EPS);
                      y0 *= r * qng[li]; y1 *= r * qng[32 + li]; y2 *= r * qng[64 + li]; y3 *= r * qng[96 + li];
                      if (!isz) { const float a0 = y0 * csr.x - y1 * csr.y, a1 = y0 * csr.y + y1 * csr.x, a2 = y2 * csc.x - y3 * csc.y, a3 = y2 * csc.y + y3 * csc.x; y0 = a0; y1 = a1; y2 = a2; y3 = a3; }
                      bf16_t* d = QB + (size_t)t * 1024 + hd * 128 + li; d[0] = (bf16_t)f2bf(y0); d[32] = (bf16_t)f2bf(y1); d[64] = (bf16_t)f2bf(y2); d[96] = (bf16_t)f2bf(y3); }
                    { const bf16x8 v = *(const bf16x8*)(pr + P_CQ + lane * 8); float f[8], ss = 0.f;
#pragma unroll
                      for (int j = 0; j < 8; ++j) { f[j] = bf2f_s(v[j]); ss += f[j] * f[j]; }
                      const float r = rsqrtf(wave_sum(ss) * (1.f / 512.f) + EPS); u32x4 o;
                      o.x = pk2(f[0] * r * mqg[lane * 8 + 0], f[1] * r * mqg[lane * 8 + 1]); o.y = pk2(f[2] * r * mqg[lane * 8 + 2], f[3] * r * mqg[lane * 8 + 3]);
                      o.z = pk2(f[4] * r * mqg[lane * 8 + 4], f[5] * r * mqg[lane * 8 + 5]); o.w = pk2(f[6] * r * mqg[lane * 8 + 6], f[7] * r * mqg[lane * 8 + 7]);
                      *(u32x4*)(CQN + (size_t)t * 512 + lane * 8) = o; }
                    { const int tlo = isz ? SEQ : 0, thi = isz ? TALL : SEQ; const bool hp = t > tlo, hn = t + 1 < thi;
#pragma unroll
                      for (int q = 0; q < 2; ++q) { const int c = lane * 16 + q * 8;
                        const bf16x8 gb = *(const bf16x8*)(pr + P_GB + c), gc = *(const bf16x8*)(pr + P_GC + c), xa = *(const bf16x8*)(pr + P_XA + c);
                        bf16x8 gcp = gc, xap = xa, gcn = gc, xan = xa;
                        if (hp) { gcp = *(const bf16x8*)(pr - NINP + P_GC + c); xap = *(const bf16x8*)(pr - NINP + P_XA + c); }
                        if (hn) { gcn = *(const bf16x8*)(pr + NINP + P_GC + c); xan = *(const bf16x8*)(pr + NINP + P_XA + c); }
                        float y[8];
#pragma unroll
                        for (int j = 0; j < 8; ++j) { const float uc = bf2f_s(gc[j]) * bf2f_s(xa[j]); const float up = hp ? bf2f_s(gcp[j]) * bf2f_s(xap[j]) : 0.f; const float un = hn ? bf2f_s(gcn[j]) * bf2f_s(xan[j]) : 0.f;
                          y[j] = bf2f_s(gb[j]) * (cw[c + j] * up + cw[1024 + c + j] * uc + cw[2048 + c + j] * un); }
                        u32x4 o; o.x = pk2(y[0], y[1]); o.y = pk2(y[2], y[3]); o.z = pk2(y[4], y[5]); o.w = pk2(y[6], y[7]);
                        *(u32x4*)(YS + (size_t)t * 1024 + c) = o; } }
                    { const bf16x8 v0 = *(const bf16x8*)(pr + P_V + lane * 16), v1 = *(const bf16x8*)(pr + P_V + lane * 16 + 8); float f[16], s = 0.f;
#pragma unroll
                      for (int j = 0; j < 8; ++j) { f[j] = bf2f_s(v0[j]); f[8 + j] = bf2f_s(v1[j]); s += f[j] + f[8 + j]; }
                      const float mean = wave_sum(s) * (1.f / 1024.f); float q = 0.f;
#pragma unroll
                      for (int j = 0; j < 16; ++j) { const float d = f[j] - mean; q += d * d; }
                      const float rstd = rsqrtf(wave_sum(q) * (1.f / 1024.f) + EPS);
                      if (lane == 0) stats[t] = make_float2(mean, rstd); }
                }
            }
        }
        #endif
        for (int rs_ = 0; rs_ < REP_SYNC; ++rs_) xcd_barrier(xb);

#if (PHM & 16)
        {
        WS_PTRS(); LAYER_PTRS();
            pg8::SchedDual S{CQN, Wuq_t, CKVN, Wukv_t, 512, nMq, nMq * 6, TALL / 256, (TALL / 256) * 8, G, bx};
            pg8::EpiAct E{QC, 1536, KVU, 2048, nullptr, 0, 1 << 30, 1 << 30, 0};
            pg8::gemm_phase<pg8::EpiAct, pg8::SchedDual, true, true>(lds, 512, S, E);
            __syncthreads();
        PHASE_IDS();
            const float* lng = p.in[I_SLNG] + l * 1024; const float* lnb = p.in[I_SLNB] + l * 1024; const float* bs = p.in[I_SBS] + l * 1024;
            LAS bf16_t* VnT = (LAS bf16_t*)lds;
            const int r32 = lane & 31, hi = lane >> 5;
            for (int rew_ = 0; rew_ < REP_EW; ++rew_)
            for (int item = bx; item < (TQ / 128) * 8; item += G) {
                const int ch = item >> 3, g = item & 7, t0 = ch * 128;
                { const int q = tid >> 2, cs = (tid & 3) * 32; const float2 st = stats[t0 + q]; const bf16_t* src = P + (size_t)(t0 + q) * NINP + P_V + g * 128 + cs;
#pragma unroll
                  for (int k4 = 0; k4 < 4; ++k4) { const bf16x8 v = *(const bf16x8*)(src + k4 * 8);
#pragma unroll
                    for (int j = 0; j < 8; ++j) { const int c = cs + k4 * 8 + j; const float f = (bf2f_s(v[j]) - st.x) * st.y * lng[g * 128 + c] + lnb[g * 128 + c]; VnT[c * 136 + q] = (bf16_t)f2bf(f); } } }
                __syncthreads();
                const int pb = wave >> 1, cb0 = (wave & 1) * 2;
                f32x16 acc0 = {}, acc1 = {};
                const bf16_t* Ap = Wsg + (size_t)g * 16384 + (pb * 32 + r32) * 128 + hi * 8;
#pragma unroll
                for (int ks = 0; ks < 8; ++ks) { const bf16x8 a = *(const bf16x8*)(Ap + ks * 16);
                    const bf16x8 b0 = *(const LAS bf16x8*)(VnT + ((cb0 * 32 + r32) * 136 + ks * 16 + hi * 8)), b1 = *(const LAS bf16x8*)(VnT + (((cb0 + 1) * 32 + r32) * 136 + ks * 16 + hi * 8));
                    acc0 = __builtin_amdgcn_mfma_f32_32x32x16_bf16(a, b0, acc0, 0, 0, 0); acc1 = __builtin_amdgcn_mfma_f32_32x32x16_bf16(a, b1, acc1, 0, 0, 0); }
#pragma unroll
                for (int r = 0; r < 16; ++r) { const int pp = pb * 32 + att::crow(r, hi); const int t = t0 + pp; const float bias = bs[g * 128 + pp];
                    const int c0 = g * 128 + cb0 * 32 + r32; const bf16_t* up = P + (size_t)t * NINP + P_U; bf16_t* yp = YS + 3 * YS_STRIDE + (size_t)t * 1024;
                    yp[c0] = (bf16_t)f2bf(bf2f(up[c0]) * (acc0[r] + bias)); yp[c0 + 32] = (bf16_t)f2bf(bf2f(up[c0 + 32]) * (acc1[r] + bias)); }
                __syncthreads();
            }
        }
        #endif
        for (int rs_ = 0; rs_ < REP_SYNC; ++rs_) xcd_barrier(xb);

#if (PHM & 32)
        {
        WS_PTRS(); LAYER_PTRS();
            const int h = bx & 7, qb = bx >> 3;
            const int nun = (l0 && bx < 8) ? 2 : 1;
            int nrepF = REP_F; asm volatile("" : "+s"(nrepF));
#if EN192
            for (int ui = 0; ui < nun * nrepF; ++ui) {
                const bool zu = (ui % nun) == 1; const size_t r0 = zu ? (size_t)SEQ : (size_t)qb * 256; const size_t k0 = zu ? (size_t)SEQ : 0; const int seq = zu ? CTXL : TALL;
                att::attn_body<192, 1536, 2048, 64, 2048, 1024>(QC + r0 * 1536 + h * 192, KVU + k0 * 2048 + h * 256, KR + k0 * 64, KVU + k0 * 2048 + h * 256 + 128,
                                    YS + 2 * YS_STRIDE + r0 * 1024 + h * 128, seq, (char*)lds_raw, !zu, (int)r0, tabC);
            }
#endif
#if EN128
            for (int ui = 0; ui < nun * nrepF; ++ui) {
                const bool zu = (ui % nun) == 1; const size_t r0 = zu ? (size_t)SEQ : (size_t)qb * 256; const size_t k0 = zu ? (size_t)SEQ : 0; const int seq = zu ? CTXL : TALL;
                att::attn_body<128, 1024, 256, 64, NINP, 1024>(QB + r0 * 1024 + h * 128, KB + k0 * 256 + (h >> 2) * 128, nullptr, P + k0 * NINP + P_VB + (h >> 2) * 128,
                                    YS + 1 * YS_STRIDE + r0 * 1024 + h * 128, seq, (char*)lds_raw, false, 0, tabC);
            }
#endif
        }
        #endif
        for (int rs_ = 0; rs_ < REP_SYNC; ++rs_) xcd_barrier(xb);

#if (PHM & 64)
        {
        WS_PTRS(); LAYER_PTRS();
            pg8::SchedBranch S{YS, Wbr_t, 1024, nMq, nMq * 8, G, bx, YS_STRIDE, (size_t)DM * 1024};
            pg8::EpiGate E{P, MRG, MG};
            pg8::gemm_phase<pg8::EpiGate, pg8::SchedBranch, true, true>(lds, 1024, S, E);
        }
        #endif
        for (int rs_ = 0; rs_ < REP_SYNC; ++rs_) xcd_barrier(xb);

#if (PHM & 128)
        {
        WS_PTRS(); LAYER_PTRS();
            pg8::SchedNarrowZ S{MG, Wout_t, DM, 32, 256, G, bx, l0 ? 8 * 8 : 0, 256};
            pg8::EpiRes E{xsrc, zsrc, XS, modx + 2 * 2048, modz + 2 * 2048, 32, ZSLAB};
            pg8::gemm_phase<pg8::EpiRes, pg8::SchedNarrowZ, true, true>(lds, DM, S, E);
        }
        #endif
        for (int rs_ = 0; rs_ < REP_SYNC; ++rs_) xcd_barrier(xb);

#if (PHM & 256)
        {
        WS_PTRS(); LAYER_PTRS();
        PHASE_IDS();
            const float* gffn = p.in[I_NFFNG] + (size_t)l * DM;
            for (int rew_ = 0; rew_ < REP_EW; ++rew_)
            for (int row = gw; row < TQ; row += NGW) {
                const bool isz = row >= SEQ; const float* src = isz ? zsrc + (size_t)(row - SEQ) * DM : XS + (size_t)row * DM; const float* md = isz ? modz : modx;
                f32x4 v[8]; float ss = 0.f;
#pragma unroll
                for (int j = 0; j < 8; ++j) v[j] = *(const f32x4*)(src + (lane + 64 * j) * 4);
                if (isz) {
#pragma unroll
                    for (int j = 0; j < 8; ++j) { const int c = (lane + 64 * j) * 4; f32x4 s = (f32x4){0.f, 0.f, 0.f, 0.f};
                        for (int ks = 0; ks < 8; ++ks) s += *(const f32x4*)(ZSLAB + ((size_t)ks * 256 + (row - SEQ)) * DM + c);
                        v[j] += *(const f32x4*)(modz + 2 * 2048 + c) * s; *(f32x4*)(XS + (size_t)row * DM + c) = v[j]; }
                }
#pragma unroll
                for (int j = 0; j < 8; ++j) ss += v[j][0] * v[j][0] + v[j][1] * v[j][1] + v[j][2] * v[j][2] + v[j][3] * v[j][3];
                const float r = rsqrtf(wave_sum(ss) * (1.f / DM) + EPS);
#pragma unroll
                for (int j = 0; j < 8; ++j) { const int c = (lane + 64 * j) * 4; const f32x4 g = *(const f32x4*)(gffn + c), sh = *(const f32x4*)(md + 3 * 2048 + c), sc = *(const f32x4*)(md + 4 * 2048 + c);
                    f32x4 h = (v[j] * r * g) * (sc + 1.f) + sh; u32x2 o; o.x = pk2(h[0], h[1]); o.y = pk2(h[2], h[3]); *(u32x2*)(H + (size_t)row * DM + c) = o; }
            }
        }
        #endif
        for (int rs_ = 0; rs_ < REP_SYNC; ++rs_) xcd_barrier(xb);

#if (PHM & 512)
        {
        WS_PTRS(); LAYER_PTRS();
            pg8::SchedWide S{H, W1_t, DM, nMq, DFF / 256, nMq * (DFF / 256), 0, 0, G, bx};
            pg8::EpiAct E{U, DFF, U, DFF, nullptr, 0, 1 << 30, 1 << 30, 3};
            int nrep = REP_J; asm volatile("" : "+s"(nrep));
            for (int rep = 0; rep < nrep; ++rep) pg8::gemm_phase<pg8::EpiAct, pg8::SchedWide, true, true>(lds, DM, S, E);
        }
        #endif
        for (int rs_ = 0; rs_ < REP_SYNC; ++rs_) xcd_barrier(xb);

#if (PHM & 1024)
        {
        WS_PTRS(); LAYER_PTRS();
            pg8::SchedNarrowZ S{U, W2_t, DFF, 32, 256, G, bx, l0 ? 8 * 16 : 0, 512};
            pg8::EpiRes E{XS, XS + (size_t)SEQ * DM, XS, modx + 5 * 2048, modz + 5 * 2048, 32, ZSLAB};
            pg8::gemm_phase<pg8::EpiRes, pg8::SchedNarrowZ, true, true>(lds, DFF, S, E);
        }
        #endif
        for (int rs_ = 0; rs_ < REP_SYNC; ++rs_) xcd_barrier(xb);
    }

    {
        WS_PTRS();
        PHASE_IDS();
        const float* gf = p.in[I_FNG];
        for (int row = gw; row < SEQ; row += NGW) {
            const float* src = XS + (size_t)row * DM; f32x4 v[8]; float ss = 0.f;
#pragma unroll
            for (int j = 0; j < 8; ++j) { v[j] = *(const f32x4*)(src + (lane + 64 * j) * 4); ss += v[j][0] * v[j][0] + v[j][1] * v[j][1] + v[j][2] * v[j][2] + v[j][3] * v[j][3]; }
            const float r = rsqrtf(wave_sum(ss) * (1.f / DM) + EPS);
#pragma unroll
            for (int j = 0; j < 8; ++j) { const int c = (lane + 64 * j) * 4; const f32x4 g = *(const f32x4*)(gf + c); *(f32x4*)(p.out + (size_t)row * DM + c) = v[j] * r * g; }
        }
    }
}

extern "C" void kernel_launch(void* const* d_in, const int* in_sizes, int n_in, void* d_out, int out_size, void* d_ws, size_t ws_size, hipStream_t stream) {
    static int grid = 0;
    if (grid == 0) {
        if (n_in != 26 || out_size != SEQ * DM || ws_size < WS_END) { fprintf(stderr, "kernel_launch: unexpected shapes (n_in %d out %d ws %zu, need ws >= %zu)\n", n_in, out_size, ws_size, (size_t)WS_END); grid = -1; return; }
        int dev = 0, cus = 0, per_cu = 0;
        hipGetDevice(&dev); hipDeviceGetAttribute(&cus, hipDeviceAttributeMultiprocessorCount, dev);
        if (hipFuncSetAttribute((const void*)mega_fwd, hipFuncAttributeMaxDynamicSharedMemorySize, LDS_BYTES) != hipSuccess) { fprintf(stderr, "kernel_launch: hipFuncSetAttribute failed\n"); grid = -1; return; }
        hipOccupancyMaxActiveBlocksPerMultiprocessor(&per_cu, (const void*)mega_fwd, NTHR, LDS_BYTES);
        (void)hipGetLastError();
        if (per_cu < 1) fprintf(stderr, "kernel_launch: occupancy query says %d blocks per CU\n", per_cu);
        grid = 256;
        if (cus != 256) fprintf(stderr, "kernel_launch: device has %d CUs; this kernel is built for a 256-workgroup grid\n", cus);
    }
    if (grid < 0) return;
    Params p{};
    for (int i = 0; i < 26; ++i) p.in[i] = (const float*)d_in[i];
    p.out = (float*)d_out; p.ws = (unsigned char*)d_ws;
    void* args[] = {&p};
    hipError_t e = hipLaunchCooperativeKernel((const void*)mega_fwd, dim3(grid), dim3(NTHR), args, LDS_BYTES, stream);
    if (e != hipSuccess) fprintf(stderr, "kernel_launch: cooperative launch failed: %s\n", hipGetErrorString(e));
}
```

```cpp
#include <hip/hip_runtime.h>
#include <hip/hip_cooperative_groups.h>
#include <cstdio>
#include <cstdint>
namespace cg = cooperative_groups;
#ifndef PHM
#define PHM 0xFFFF
#endif
#ifndef REP_F
#define REP_F 1
#endif
#ifndef REP_B
#define REP_B 1
#endif
#ifndef REP_J
#define REP_J 1
#endif
#ifndef REP_P0
#define REP_P0 1
#endif
#ifndef REP_SYNC
#define REP_SYNC 1
#endif
#ifndef REP_EW
#define REP_EW 1
#endif
#ifndef REP_G
#define REP_G 1
#endif
#ifndef REP_D
#define REP_D 1
#endif
#ifndef EN192
#define EN192 1
#endif
#ifndef EN128
#define EN128 1
#endif

#define LAS __attribute__((address_space(3)))
typedef unsigned short bf16_t;
typedef short bf16x8 __attribute__((ext_vector_type(8)));
typedef short s16x4 __attribute__((ext_vector_type(4)));
typedef float f32x4 __attribute__((ext_vector_type(4)));
typedef float f32x16 __attribute__((ext_vector_type(16)));
typedef unsigned u32x4 __attribute__((ext_vector_type(4)));
typedef unsigned u32x2 __attribute__((ext_vector_type(2)));

constexpr int DM = 2048, SEQ = 8192, CTXL = 256, TALL = SEQ + CTXL;
constexpr int NIN = 15936, NINP = 16128;
constexpr int P_KB = 0, P_VB = 256, P_CKV = 512, P_KR = 1024, P_QB = 1280, P_CQ = 2304, P_GB = 2816, P_GC = 3840, P_XA = 4864,
              P_U = 5888, P_V = 6912, P_G = 7936;
constexpr int DFF = 8192;
constexpr float EPS = 1e-6f;
constexpr int NWAVES = 8, NTHR = 512;

constexpr size_t MiB = 1u << 20;
constexpr size_t WS_MOD = 0;
constexpr size_t WS_TABB = 256 * 1024;
constexpr size_t WS_TABC = 320 * 1024;
constexpr size_t WS_STATS = 512 * 1024;
constexpr size_t WS_BAR = 768 * 1024;
constexpr int LDS_BARST = 134144;
constexpr size_t WS_W0 = 1 * MiB, W_LSTRIDE = 155 * MiB;
constexpr size_t WO_IN = 0, WO_UQ = 63 * MiB, WO_UKV = WO_UQ + 3 * MiB / 2, WO_BR = WO_UKV + 2 * MiB, WO_OUT = WO_BR + 16 * MiB,
                 WO_F1 = WO_OUT + 8 * MiB, WO_F2 = WO_F1 + 32 * MiB, WO_SG = WO_F2 + 32 * MiB;
constexpr size_t WS_H = 311 * MiB, WS_P = 344 * MiB, WS_KB = 604 * MiB, WS_KR = 609 * MiB, WS_QB = 611 * MiB, WS_CKVN = 628 * MiB,
                 WS_CQN = 637 * MiB, WS_QC = 646 * MiB, WS_KVU = 671 * MiB, WS_YS = 704 * MiB, WS_MRG = 770 * MiB, WS_MG = 836 * MiB,
                 WS_XS = 869 * MiB, WS_ZSLAB = 935 * MiB, WS_END = 967 * MiB;
constexpr size_t YS_STRIDE = (size_t)TALL * 1024;
static_assert(WO_SG + 2 * 8 * 128 * 128 <= W_LSTRIDE, "weights map");

constexpr int LDS_BYTES = 132 * 1024;

__device__ __forceinline__ float bf2f(bf16_t v) { return __uint_as_float(((unsigned)v) << 16); }
__device__ __forceinline__ float bf2f_s(short v) { return __uint_as_float(((unsigned)(unsigned short)v) << 16); }
__device__ __forceinline__ unsigned f2bf(float f) { unsigned u = __float_as_uint(f); return (u + 0x7fffu + ((u >> 16) & 1u)) >> 16; }
__device__ __forceinline__ unsigned pk2(float lo, float hi) { return f2bf(lo) | (f2bf(hi) << 16); }
__device__ __forceinline__ unsigned cvt_pk_bf16(float lo, float hi) { unsigned r; asm volatile("v_cvt_pk_bf16_f32 %0, %1, %2" : "=v"(r) : "v"(lo), "v"(hi)); return r; }
__device__ __forceinline__ float wave_sum(float v) {
#pragma unroll
    for (int o = 1; o < 64; o <<= 1) v += __shfl_xor(v, o);
    return v;
}
__device__ __forceinline__ float half_sum(float v) {
#pragma unroll
    for (int o = 1; o < 32; o <<= 1) v += __shfl_xor(v, o);
    return v;
}

namespace pg8 {
constexpr int BM = 256, BK = 64, HALF = 128, HTB = HALF * BK * 2, STAGE_BYTES = 8 * HTB, NXCD = 8, WGM = 8;
__host__ __device__ __forceinline__ int lds_byte(int r, int c) { const int st = (r >> 4) * 2 + (c >> 5), rr = r & 15, cc = c & 31, ob = rr * 64 + cc * 2; return st * 1024 + (ob ^ (((ob >> 9) & 1) << 5)); }
__host__ __device__ __forceinline__ void stage_rc(int b, int& R, int& C) { const int st = b / 1024, sb = b % 1024, swz = sb ^ (((sb >> 9) & 1) << 5); R = (st >> 1) * 16 + swz / 64; C = (st & 1) * 32 + (swz % 64) / 2; }
__host__ __device__ __forceinline__ int perm32(int rho) { const int n = rho >> 4, i = rho & 15; return 8 * (i >> 2) + 4 * n + (i & 3); }
struct Unit { int pm, pn, z; };

struct SchedWide {
    const bf16_t* A; const bf16_t* Bt; int K, nM, nN, nwg, xpm, xn, G, c;
    __device__ bool next(int i, Unit& u) const {
        long L = (long)i * G + c;
        if (L < nwg) {
            int wgid = (int)L; { const int q = nwg / NXCD, r = nwg % NXCD, xcd = wgid % NXCD, off = wgid / NXCD; wgid = (xcd < r ? xcd * (q + 1) : r * (q + 1) + (xcd - r) * q) + off; }
            const int nig = WGM * nN, gid = wgid / nig, fm = gid * WGM, gsz = (nM - fm) < WGM ? (nM - fm) : WGM;
            u.pm = fm + ((wgid % nig) % gsz); u.pn = (wgid % nig) / gsz; u.z = 0; return true;
        }
        L -= nwg; if (L < xn) { u.pm = xpm; u.pn = (int)L; u.z = 0; return true; }
        return false;
    }
    __device__ __forceinline__ int nt(const Unit&) const { return K / BK; }
    __device__ __forceinline__ const char* aptr(const Unit& u) const { return (const char*)A + (size_t)u.pm * BM * K * 2; }
    __device__ __forceinline__ const char* bptr(const Unit& u) const { return (const char*)Bt + (size_t)u.pn * BM * K * 2; }
};
struct SchedNarrow {
    const bf16_t* A; const bf16_t* Bt; int K, nM, ntiles, G, c;
    __device__ bool next(int i, Unit& u) const { const int t = i * G + c; if (t >= ntiles) return false; u.pm = t % nM; u.pn = t / nM; u.z = 0; return true; }
    __device__ __forceinline__ int nt(const Unit&) const { return K / BK; }
    __device__ __forceinline__ const char* aptr(const Unit& u) const { return (const char*)A + (size_t)u.pm * BM * K * 2; }
    __device__ __forceinline__ const char* bptr(const Unit& u) const { return (const char*)Bt + (size_t)u.pn * BM * K * 2; }
};
struct SchedNarrowZ {
    const bf16_t* A; const bf16_t* Bt; int K, nM, ntiles, G, c, nz, ksl;
    __device__ bool next(int i, Unit& u) const {
        int t = i * G + c;
        if (t < ntiles) { u.pm = t % nM; u.pn = t / nM; u.z = 0; return true; }
        t -= ntiles; if (t >= nz) return false;
        u.pm = 32; u.pn = t & 7; u.z = 1 + (t >> 3); return true;
    }
    __device__ __forceinline__ int nt(const Unit& u) const { return (u.z ? ksl : K) / BK; }
    __device__ __forceinline__ const char* aptr(const Unit& u) const { return (const char*)A + (size_t)u.pm * BM * K * 2 + (u.z ? (size_t)(u.z - 1) * ksl * 2 : (size_t)0); }
    __device__ __forceinline__ const char* bptr(const Unit& u) const { return (const char*)Bt + (size_t)u.pn * BM * K * 2 + (u.z ? (size_t)(u.z - 1) * ksl * 2 : (size_t)0); }
};
struct SchedBranch {
    const bf16_t* A; const bf16_t* Bt; int K, nM, ntiles, G, c; size_t strideA, strideB;
    __device__ bool next(int i, Unit& u) const { const int t = (i >> 2) * G + c; if (t >= ntiles) return false; u.pm = t % nM; u.pn = t / nM; u.z = i & 3; return true; }
    __device__ __forceinline__ int nt(const Unit&) const { return K / BK; }
    __device__ __forceinline__ const char* aptr(const Unit& u) const { return (const char*)(A + (size_t)u.z * strideA) + (size_t)u.pm * BM * K * 2; }
    __device__ __forceinline__ const char* bptr(const Unit& u) const { return (const char*)(Bt + (size_t)u.z * strideB) + (size_t)u.pn * BM * K * 2; }
};
struct SchedDual {
    const bf16_t* A0; const bf16_t* B0; const bf16_t* A1; const bf16_t* B1; int K, nM0, n0, nM1, n1, G, c;
    __device__ bool next(int i, Unit& u) const {
        int L = i * G + c;
        if (L < n0) { u.z = 0; u.pm = L % nM0; u.pn = L / nM0; return true; }
        L -= n0; if (L >= n1) return false;
        u.z = 1; u.pm = L % nM1; u.pn = L / nM1; return true;
    }
    __device__ __forceinline__ int nt(const Unit&) const { return K / BK; }
    __device__ __forceinline__ const char* aptr(const Unit& u) const { return (const char*)(u.z ? A1 : A0) + (size_t)u.pm * BM * K * 2; }
    __device__ __forceinline__ const char* bptr(const Unit& u) const { return (const char*)(u.z ? B1 : B0) + (size_t)u.pn * BM * K * 2; }
};

__device__ __forceinline__ float gelu_tanh(float x) { const float t = 1.5957691216057308f * (x + 0.044715f * x * x * x); return x / (1.f + __expf(-t)); }
__device__ __forceinline__ float sigmoidf(float x) { return 1.f / (1.f + __expf(-x)); }

struct EpiAct {
    static constexpr bool PERM = true;
    __device__ __forceinline__ bool zero_after(const Unit&) const { return true; }
    bf16_t* O0; int ld0; bf16_t* O1; int ld1; const float* bias; int bias_col0; int gelu_lo, sig_lo; int fixed_act;
    __device__ __forceinline__ void operator()(f32x4 (&acc)[2][2][4][2], const Unit& u, int wr, int wc, int fr, int fq) const {
        bf16_t* base = u.z ? O1 : O0; const int ldc = u.z ? ld1 : ld0;
        const int act = fixed_act >= 0 ? fixed_act : (u.pn >= sig_lo ? 2 : (u.pn >= gelu_lo ? 1 : 0));
        const int row0 = u.pm * BM + wr * 64 + fr, col0 = u.pn * BM + wc * 32 + 8 * fq;
#pragma unroll
        for (int bj = 0; bj < 2; ++bj) {
            f32x4 b0 = (f32x4){0.f, 0.f, 0.f, 0.f}, b1 = b0;
            if (act == 2) { b0 = *(const f32x4*)(bias + (col0 + bj * HALF - bias_col0)); b1 = *(const f32x4*)(bias + (col0 + bj * HALF - bias_col0 + 4)); }
#pragma unroll
            for (int ai = 0; ai < 2; ++ai)
#pragma unroll
                for (int m = 0; m < 4; ++m) {
                    f32x4 v0 = acc[ai][bj][m][0], v1 = acc[ai][bj][m][1];
                    if (act == 1) {
#pragma unroll
                        for (int j = 0; j < 4; ++j) { v0[j] = gelu_tanh(v0[j]); v1[j] = gelu_tanh(v1[j]); }
                    } else if (act == 2) {
#pragma unroll
                        for (int j = 0; j < 4; ++j) { v0[j] = sigmoidf(v0[j] + b0[j]); v1[j] = sigmoidf(v1[j] + b1[j]); }
                    } else if (act == 3) {
#pragma unroll
                        for (int j = 0; j < 4; ++j) { float a = fmaxf(v0[j], 0.f), b = fmaxf(v1[j], 0.f); v0[j] = a * a; v1[j] = b * b; }
                    }
                    u32x4 w; w.x = cvt_pk_bf16(v0[0], v0[1]); w.y = cvt_pk_bf16(v0[2], v0[3]); w.z = cvt_pk_bf16(v1[0], v1[1]); w.w = cvt_pk_bf16(v1[2], v1[3]);
                    *(u32x4*)(base + (size_t)(row0 + ai * HALF + m * 16) * ldc + col0 + bj * HALF) = w;
                }
        }
    }
};
struct EpiGate {
    static constexpr bool PERM = true;
    const bf16_t* P; bf16_t* MG;
    __device__ __forceinline__ bool zero_after(const Unit& u) const { return u.z == 3; }
    __device__ __forceinline__ void operator()(f32x4 (&acc)[2][2][4][2], const Unit& u, int wr, int wc, int fr, int fq) const {
        const int row0 = u.pm * BM + wr * 64 + fr, col0 = u.pn * BM + wc * 32 + 8 * fq; const int z = u.z;
        const bf16_t* gbase = P + (size_t)row0 * NINP + P_G + z * DM + col0;
#pragma unroll
        for (int ai = 0; ai < 2; ++ai) {
            bf16x8 g[4][2], gn[4][2];
#pragma unroll
            for (int m = 0; m < 4; ++m)
#pragma unroll
                for (int bj = 0; bj < 2; ++bj) {
                    const bf16_t* gp = gbase + (size_t)(ai * HALF + m * 16) * NINP + bj * HALF;
                    g[m][bj] = *(const bf16x8*)gp; gn[m][bj] = *(const bf16x8*)(gp + (z < 3 ? DM : 0)); }
            asm volatile("" ::: "memory");
#pragma unroll
            for (int m = 0; m < 4; ++m)
#pragma unroll
                for (int bj = 0; bj < 2; ++bj) {
                    if (z < 3) {
#pragma unroll
                        for (int j = 0; j < 4; ++j) {
                            acc[ai][bj][m][0][j] *= fmaxf(bf2f_s(g[m][bj][j]), 1e-18f) * __builtin_amdgcn_rcpf(fmaxf(bf2f_s(gn[m][bj][j]), 1e-18f));
                            acc[ai][bj][m][1][j] *= fmaxf(bf2f_s(g[m][bj][4 + j]), 1e-18f) * __builtin_amdgcn_rcpf(fmaxf(bf2f_s(gn[m][bj][4 + j]), 1e-18f)); }
                    } else {
                        f32x4 v0 = acc[ai][bj][m][0], v1 = acc[ai][bj][m][1];
#pragma unroll
                        for (int j = 0; j < 4; ++j) { v0[j] *= fmaxf(bf2f_s(g[m][bj][j]), 1e-18f); v1[j] *= fmaxf(bf2f_s(g[m][bj][4 + j]), 1e-18f); }
                        u32x4 w; w.x = cvt_pk_bf16(v0[0], v0[1]); w.y = cvt_pk_bf16(v0[2], v0[3]); w.z = cvt_pk_bf16(v1[0], v1[1]); w.w = cvt_pk_bf16(v1[2], v1[3]);
                        *(u32x4*)(MG + (size_t)(row0 + ai * HALF + m * 16) * DM + col0 + bj * HALF) = w;
                    }
                }
        }
    }
};
struct EpiRes {
    static constexpr bool PERM = false;
    __device__ __forceinline__ bool zero_after(const Unit&) const { return true; }
    const float* basex; const float* basez; float* out; const float* gx; const float* gz; int zpm; float* slab;
    __device__ __forceinline__ void operator()(f32x4 (&acc)[2][2][4][2], const Unit& u, int wr, int wc, int fr, int fq) const {
        if (u.z) {
            float* o = slab + (size_t)(u.z - 1) * BM * DM; const int col0 = u.pn * BM + wc * 32 + 4 * fq;
#pragma unroll
            for (int bj = 0; bj < 2; ++bj)
#pragma unroll
                for (int n = 0; n < 2; ++n)
#pragma unroll
                    for (int ai = 0; ai < 2; ++ai)
#pragma unroll
                        for (int m = 0; m < 4; ++m) *(f32x4*)(o + (size_t)(ai * HALF + wr * 64 + m * 16 + fr) * DM + col0 + bj * HALF + n * 16) = acc[ai][bj][m][n];
            return;
        }
        const bool isz = (u.pm == zpm);
        const float* base = isz ? basez : basex + (size_t)u.pm * BM * DM; const float* gv = isz ? gz : gx;
        float* o = out + (size_t)u.pm * BM * DM;
        const int col0 = u.pn * BM + wc * 32 + 4 * fq;
#pragma unroll
        for (int bj = 0; bj < 2; ++bj)
#pragma unroll
            for (int n = 0; n < 2; ++n) {
                const int col = col0 + bj * HALF + n * 16; const f32x4 g4 = *(const f32x4*)(gv + col);
#pragma unroll
                for (int ai = 0; ai < 2; ++ai)
#pragma unroll
                    for (int m = 0; m < 4; ++m) {
                        const size_t off = (size_t)(ai * HALF + wr * 64 + m * 16 + fr) * DM + col;
                        const f32x4 bs = *(const f32x4*)(base + off);
                        *(f32x4*)(o + off) = bs + g4 * acc[ai][bj][m][n];
                    }
            }
    }
};

template <class Epi, class Sched, bool ALIGN_EPI = false, bool SP2 = false>
__device__ __forceinline__ void gemm_phase(LAS unsigned char* lds, const int K, const Sched& S, const Epi& E) {
    int tid_ = threadIdx.x; asm volatile("" : "+v"(tid_));
    const int tid = tid_, wid = __builtin_amdgcn_readfirstlane(tid >> 6), lane = tid & 63, wr = wid >> 2, wc = wid & 3, fr = lane & 15, fq = lane >> 4;
    unsigned voffA[2], voffB[2];
#pragma unroll
    for (int i = 0; i < 2; ++i) { int R, C; stage_rc(tid * 16 + i * 8192, R, C); const int Rb = Epi::PERM ? ((R & ~31) + perm32(R & 31)) : R;
        voffA[i] = (unsigned)(R * K + C) * 2u; voffB[i] = (unsigned)(Rb * K + C) * 2u; }
    const size_t kstep = (size_t)(BK * 2);
    const size_t hstep = (size_t)HALF * K * 2;
    const unsigned ldsw = (unsigned)wid * 1024u;
    const int aoff = lds_byte(wr * 64 + fr, fq * 8), boff = lds_byte(wc * 32 + fr, fq * 8);
#define PG8_SA(b, h) (((b) * 2 + (h)) * HTB)
#define PG8_SB(b, h) ((4 + (b) * 2 + (h)) * HTB)
#define PG8_STAGE(bufoff, gbase, voff) do { _Pragma("unroll") for (int _i = 0; _i < 2; ++_i) \
        __builtin_amdgcn_global_load_lds((const unsigned*)((const char*)(gbase) + (voff)[_i]), (LAS unsigned*)(lds + (bufoff) + ldsw + _i * 8192), 16, 0, 0); } while (0)
#define PG8_LDA(dst, b, h) do { _Pragma("unroll") for (int m = 0; m < 4; ++m) _Pragma("unroll") for (int k = 0; k < 2; ++k) dst[m][k] = *(const LAS bf16x8*)(lds + PG8_SA(b, h) + aoff + m * 2048 + k * 1024); } while (0)
#define PG8_LDB(dst, b, h) do { _Pragma("unroll") for (int n = 0; n < 2; ++n) _Pragma("unroll") for (int k = 0; k < 2; ++k) dst[n][k] = *(const LAS bf16x8*)(lds + PG8_SB(b, h) + boff + n * 2048 + k * 1024); } while (0)
#define PG8_MMA(ai, bj, At, Bt) do { __builtin_amdgcn_s_setprio(1); _Pragma("unroll") for (int m = 0; m < 4; ++m) _Pragma("unroll") for (int n = 0; n < 2; ++n) _Pragma("unroll") for (int k = 0; k < 2; ++k) \
        acc[ai][bj][m][n] = __builtin_amdgcn_mfma_f32_16x16x32_bf16(Bt[n][k], At[m][k], acc[ai][bj][m][n], 0, 0, 0); __builtin_amdgcn_s_setprio(0); } while (0)
#define PG8_WAIT_V(n) asm volatile("s_waitcnt vmcnt(" #n ")" ::: "memory")
#define PG8_WAIT_L(n) asm volatile("s_waitcnt lgkmcnt(" #n ")" ::: "memory")
#define PG8_BAR __builtin_amdgcn_s_barrier()
#define PG8_SCHED __builtin_amdgcn_sched_barrier(0)
    Unit cur, nxt; int ui = 0;
    if (!S.next(0, cur)) return;
    int nt = S.nt(cur);
    f32x4 acc[2][2][4][2];
#pragma unroll
    for (int a = 0; a < 2; ++a)
#pragma unroll
        for (int b = 0; b < 2; ++b)
#pragma unroll
            for (int m = 0; m < 4; ++m)
#pragma unroll
                for (int n = 0; n < 2; ++n) acc[a][b][m][n] = (f32x4){0.f, 0.f, 0.f, 0.f};
    bf16x8 At[4][2], B0[2][2], B1[2][2];
    const char* cA = S.aptr(cur); const char* cB = S.bptr(cur);
    if constexpr (SP2) {
        PG8_STAGE(PG8_SB(0, 0), cB, voffB); PG8_STAGE(PG8_SB(0, 1), cB + hstep, voffB); PG8_STAGE(PG8_SA(0, 0), cA, voffA); PG8_STAGE(PG8_SA(0, 1), cA + hstep, voffA);
        if (wr == 1) PG8_BAR;
        PG8_WAIT_V(2); PG8_BAR;
        PG8_STAGE(PG8_SB(1, 0), cB + kstep, voffB); PG8_STAGE(PG8_SA(1, 0), cA + kstep, voffA); PG8_STAGE(PG8_SB(1, 1), cB + hstep + kstep, voffB);
        PG8_WAIT_V(6); PG8_BAR;
    } else {
        PG8_STAGE(PG8_SB(0, 0), cB, voffB); PG8_STAGE(PG8_SA(0, 0), cA, voffA); PG8_STAGE(PG8_SB(0, 1), cB + hstep, voffB); PG8_STAGE(PG8_SA(0, 1), cA + hstep, voffA);
        if (wr == 1) PG8_BAR;
        PG8_WAIT_V(4); PG8_BAR;
        PG8_STAGE(PG8_SB(1, 0), cB + kstep, voffB); PG8_STAGE(PG8_SA(1, 0), cA + kstep, voffA); PG8_STAGE(PG8_SB(1, 1), cB + hstep + kstep, voffB);
        PG8_WAIT_V(6); PG8_BAR;
    }
    for (;;) {
        const bool has_next = S.next(ui + 1, nxt);
        const char* nA = has_next ? S.aptr(nxt) : cA; const char* nB = has_next ? S.bptr(nxt) : cB;
        for (int t = 0; t < nt; t += 2) {
            const bool last = (t == nt - 2);
            const char* a1 = cA + (size_t)(t + 1) * kstep;
            const char* a2 = last ? nA : cA + (size_t)(t + 2) * kstep; const char* b2 = last ? nB : cB + (size_t)(t + 2) * kstep;
            const char* a3 = a2 + kstep; const char* b3 = b2 + kstep;
            if constexpr (SP2) {
            PG8_LDB(B0, 0, 0); PG8_LDB(B1, 0, 1); PG8_SCHED; PG8_LDA(At, 0, 0); PG8_STAGE(PG8_SA(1, 1), a1 + hstep, voffA);
            PG8_WAIT_V(8); PG8_WAIT_L(0); PG8_BAR; PG8_MMA(0, 0, At, B0); PG8_MMA(0, 1, At, B1); PG8_BAR; PG8_SCHED;
            PG8_LDA(At, 0, 1); PG8_STAGE(PG8_SB(0, 0), b2, voffB); PG8_STAGE(PG8_SB(0, 1), b2 + hstep, voffB); PG8_STAGE(PG8_SA(0, 0), a2, voffA);
            PG8_WAIT_V(8); PG8_WAIT_L(0); PG8_BAR; PG8_MMA(1, 0, At, B0); PG8_MMA(1, 1, At, B1); PG8_BAR; PG8_SCHED;
            PG8_LDB(B0, 1, 0); PG8_LDB(B1, 1, 1); PG8_SCHED; PG8_LDA(At, 1, 0); PG8_STAGE(PG8_SA(0, 1), a2 + hstep, voffA);
            PG8_WAIT_V(8); PG8_WAIT_L(0); PG8_BAR; PG8_MMA(0, 0, At, B0); PG8_MMA(0, 1, At, B1); PG8_BAR; PG8_SCHED;
            PG8_LDA(At, 1, 1); PG8_STAGE(PG8_SB(1, 0), b3, voffB); PG8_STAGE(PG8_SB(1, 1), b3 + hstep, voffB); PG8_STAGE(PG8_SA(1, 0), a3, voffA);
            PG8_WAIT_V(8); PG8_WAIT_L(0); PG8_BAR; PG8_MMA(1, 0, At, B0); PG8_MMA(1, 1, At, B1); PG8_BAR; PG8_SCHED;
            } else {
            PG8_LDB(B0, 0, 0); PG8_SCHED; PG8_LDA(At, 0, 0); PG8_STAGE(PG8_SA(1, 1), a1 + hstep, voffA);
            PG8_WAIT_L(8); PG8_BAR; PG8_WAIT_L(0); PG8_MMA(0, 0, At, B0); PG8_BAR; PG8_SCHED;
            PG8_LDB(B1, 0, 1); PG8_STAGE(PG8_SB(0, 0), b2, voffB);
            PG8_BAR; PG8_WAIT_L(0); PG8_MMA(0, 1, At, B1); PG8_BAR;
            PG8_LDA(At, 0, 1); PG8_STAGE(PG8_SA(0, 0), a2, voffA);
            PG8_BAR; PG8_WAIT_L(0); PG8_MMA(1, 0, At, B0); PG8_BAR; PG8_SCHED;
            PG8_STAGE(PG8_SB(0, 1), b2 + hstep, voffB);
            PG8_WAIT_V(6); PG8_BAR; PG8_MMA(1, 1, At, B1); PG8_BAR;
            PG8_LDB(B0, 1, 0); PG8_SCHED; PG8_LDA(At, 1, 0); PG8_STAGE(PG8_SA(0, 1), a2 + hstep, voffA);
            PG8_WAIT_L(8); PG8_BAR; PG8_WAIT_L(0); PG8_MMA(0, 0, At, B0); PG8_BAR; PG8_SCHED;
            PG8_LDB(B1, 1, 1); PG8_STAGE(PG8_SB(1, 0), b3, voffB);
            PG8_BAR; PG8_WAIT_L(0); PG8_MMA(0, 1, At, B1); PG8_BAR;
            PG8_LDA(At, 1, 1); PG8_STAGE(PG8_SA(1, 0), a3, voffA);
            PG8_BAR; PG8_WAIT_L(0); PG8_MMA(1, 0, At, B0); PG8_BAR; PG8_SCHED;
            PG8_STAGE(PG8_SB(1, 1), b3 + hstep, voffB);
            PG8_WAIT_V(6); PG8_BAR; PG8_MMA(1, 1, At, B1); PG8_BAR;
            }
        }
        if constexpr (ALIGN_EPI) { if (wr == 0) PG8_BAR; }
        E(acc, cur, wr, wc, fr, fq);
        if (!has_next) break;
        if (E.zero_after(cur)) {
#pragma unroll
        for (int a = 0; a < 2; ++a)
#pragma unroll
            for (int b = 0; b < 2; ++b)
#pragma unroll
                for (int m = 0; m < 4; ++m)
#pragma unroll
                    for (int n = 0; n < 2; ++n) acc[a][b][m][n] = (f32x4){0.f, 0.f, 0.f, 0.f};
        }
        cur = nxt; cA = nA; cB = nB; ++ui; nt = S.nt(cur);
        if constexpr (ALIGN_EPI) { if (wr == 1) PG8_BAR; }
    }
    PG8_WAIT_V(0);
    if constexpr (!ALIGN_EPI) { if (wr == 0) PG8_BAR; }
    PG8_BAR;
#undef PG8_SA
#undef PG8_SB
#undef PG8_STAGE
#undef PG8_LDA
#undef PG8_LDB
#undef PG8_MMA
#undef PG8_WAIT_V
#undef PG8_WAIT_L
#undef PG8_BAR
#undef PG8_SCHED
}
}

namespace att {
constexpr int NW = 8, QBLK = 32, KVBLK = 64;
constexpr float THR = 8.f;
constexpr size_t SHM_V = KVBLK * 128 * 2;
#define SBAR() __builtin_amdgcn_sched_barrier(0)
__device__ __forceinline__ int crow(int r, int hi) { return (r & 3) + 8 * (r >> 2) + 4 * hi; }
__device__ __forceinline__ unsigned cvtpk(float lo, float hi) { unsigned r; asm volatile("v_cvt_pk_bf16_f32 %0, %1, %2" : "=v"(r) : "v"(lo), "v"(hi)); return r; }

template <int DQ> __device__ __forceinline__ void partialSM(f32x16& p0, f32x16& p1, float& m_reg, float& mn, float& alpha) {
  constexpr float SCALE = (DQ == 128) ? 0.088388347648318440f : 0.072168783648703220f;
  constexpr float C = SCALE * 1.4426950408889634f;
  float pmax = p0[0];
#pragma unroll
  for (int r = 1; r < 16; ++r) pmax = fmaxf(pmax, p0[r]);
#pragma unroll
  for (int r = 0; r < 16; ++r) pmax = fmaxf(pmax, p1[r]);
  { auto rr = __builtin_amdgcn_permlane32_swap(__float_as_uint(pmax), __float_as_uint(pmax), false, false);
    pmax = fmaxf(__uint_as_float(rr[0]), __uint_as_float(rr[1])); }
  if (__builtin_expect(__all(pmax - m_reg <= THR / SCALE), 1)) { mn = m_reg; alpha = 1.f; }
  else { mn = fmaxf(m_reg, pmax); alpha = __builtin_amdgcn_exp2f((m_reg - mn) * C); m_reg = mn; }
  float mnC = -mn * C;
#pragma unroll
  for (int r = 0; r < 16; ++r) p0[r] = fmaf(p0[r], C, mnC);
#pragma unroll
  for (int r = 0; r < 16; ++r) p1[r] = fmaf(p1[r], C, mnC);
#pragma unroll
  for (int r = 0; r < 16; ++r) p0[r] = __builtin_amdgcn_exp2f(p0[r]);
}
__device__ __forceinline__ void finishSM(f32x16& p0, f32x16& p1, float alpha, float& l_reg, bf16x8& pa0, bf16x8& pa1, bf16x8& pa2, bf16x8& pa3) {
#pragma unroll
  for (int r = 0; r < 16; ++r) p1[r] = __builtin_amdgcn_exp2f(p1[r]);
  float ps = 0;
#pragma unroll
  for (int r = 0; r < 16; ++r) ps += p0[r];
#pragma unroll
  for (int r = 0; r < 16; ++r) ps += p1[r];
  { auto rr = __builtin_amdgcn_permlane32_swap(__float_as_uint(ps), __float_as_uint(ps), false, false);
    ps = __uint_as_float(rr[0]) + __uint_as_float(rr[1]); }
  l_reg = l_reg * alpha + ps;
#define PK4(P, BASE, OUT) do { unsigned a0 = cvtpk(P[BASE + 0], P[BASE + 1]), a1 = cvtpk(P[BASE + 2], P[BASE + 3]);   \
    unsigned b0 = cvtpk(P[BASE + 4], P[BASE + 5]), b1 = cvtpk(P[BASE + 6], P[BASE + 7]);                              \
    auto r0 = __builtin_amdgcn_permlane32_swap(a0, b0, false, false); auto r1 = __builtin_amdgcn_permlane32_swap(a1, b1, false, false); \
    u32x4 w = {r0[0], r1[0], r0[1], r1[1]}; OUT = *reinterpret_cast<bf16x8*>(&w); } while (0)
  PK4(p0, 0, pa0); PK4(p0, 8, pa1); PK4(p1, 0, pa2); PK4(p1, 8, pa3);
#undef PK4
}
template <int DQ> __device__ __forceinline__ int kswz(int row, int colB) { return row * (DQ * 2 + 16) + colB; }
template <int DQ> __device__ __forceinline__ void qkt(f32x16& p0, f32x16& p1, const char* Ks, const bf16x8* qr, const char* qx, const int kb) {
  p0 = f32x16{}; p1 = f32x16{};
#pragma unroll
  for (int d0 = 0; d0 < DQ / 16; ++d0) {
    bf16x8 b0 = *reinterpret_cast<const bf16x8*>(Ks + kb + d0 * 32);
    bf16x8 b1 = *reinterpret_cast<const bf16x8*>(Ks + kb + d0 * 32 + 32 * (DQ * 2 + 16));
    bf16x8 q; if (d0 < 8) q = qr[d0]; else q = *reinterpret_cast<const bf16x8*>(qx + (d0 - 8) * 1024);
    p0 = __builtin_amdgcn_mfma_f32_32x32x16_bf16(b0, q, p0, 0, 0, 0);
    p1 = __builtin_amdgcn_mfma_f32_32x32x16_bf16(b1, q, p1, 0, 0, 0); }
}
__device__ __forceinline__ int v_st(int k, int c) { const int kk = (k & ~0xC) | ((k & 4) << 1) | ((k & 8) >> 1); return ((kk >> 3) * 4 + (c >> 5)) * 512 + ((kk & 7) * 32 + (c & 31)) * 2; }
__device__ __forceinline__ int v_rd_base(int lane) { return ((lane & 3) << 3) | (((lane >> 2) & 3) << 6) | (((lane >> 4) & 1) << 5) | (((lane >> 5) & 1) << 8); }
constexpr int v_rd_off(int d0, int ks, int half) { return d0 * 512 + ks * 4096 + half * 2048; }
template <int OFF> __device__ __forceinline__ s16x4 tr_read(int vb) {
  s16x4 r; asm volatile("ds_read_b64_tr_b16 %0, %1 offset:%2" : "=&v"(r) : "v"(vb), "i"(OFF) : "memory"); return r;
}
template <int D0> __device__ __forceinline__ void pv_one(f32x16& od, int vb, bf16x8 pa0, bf16x8 pa1, bf16x8 pa2, bf16x8 pa3) {
  const s16x4 l0 = tr_read<v_rd_off(D0, 0, 0)>(vb), h0 = tr_read<v_rd_off(D0, 0, 1)>(vb), l1 = tr_read<v_rd_off(D0, 1, 0)>(vb), h1 = tr_read<v_rd_off(D0, 1, 1)>(vb);
  const s16x4 l2 = tr_read<v_rd_off(D0, 2, 0)>(vb), h2 = tr_read<v_rd_off(D0, 2, 1)>(vb), l3 = tr_read<v_rd_off(D0, 3, 0)>(vb), h3 = tr_read<v_rd_off(D0, 3, 1)>(vb);
  asm volatile("s_waitcnt lgkmcnt(0)" ::: "memory"); SBAR();
#define PK(L, H) (bf16x8){L[0], L[1], L[2], L[3], H[0], H[1], H[2], H[3]}
  od = __builtin_amdgcn_mfma_f32_32x32x16_bf16(pa0, PK(l0, h0), od, 0, 0, 0);
  od = __builtin_amdgcn_mfma_f32_32x32x16_bf16(pa1, PK(l1, h1), od, 0, 0, 0);
  od = __builtin_amdgcn_mfma_f32_32x32x16_bf16(pa2, PK(l2, h2), od, 0, 0, 0);
  od = __builtin_amdgcn_mfma_f32_32x32x16_bf16(pa3, PK(l3, h3), od, 0, 0, 0);
#undef PK
}
__device__ __forceinline__ void pv_d0(f32x16* o, int vb, bf16x8 pa0, bf16x8 pa1, bf16x8 pa2, bf16x8 pa3) {
  pv_one<0>(o[0], vb, pa0, pa1, pa2, pa3); pv_one<1>(o[1], vb, pa0, pa1, pa2, pa3); pv_one<2>(o[2], vb, pa0, pa1, pa2, pa3); pv_one<3>(o[3], vb, pa0, pa1, pa2, pa3);
}

template <int DQ, int ldq, int ldk0, int ldk1, int ldv, int ldo>
__device__ __forceinline__ void attn_body(const bf16_t* __restrict__ Qb, const bf16_t* __restrict__ K0, const bf16_t* __restrict__ K1,
                                          const bf16_t* __restrict__ Vh, bf16_t* __restrict__ Ob, int seq, char* lds, bool ropeq, int qpos0, const float2* __restrict__ tabC) {
  constexpr size_t SHM_K = KVBLK * (DQ * 2 + 16);
  int tid_ = threadIdx.x; asm volatile("" : "+v"(tid_));
  const int tid = tid_, wid = tid >> 6, lane = tid & 63, r32 = lane & 31, hi = lane >> 5;
  char* V_lds = lds; char* K_lds = lds + 2 * SHM_V;
  float* ws = (float*)(lds + 2 * SHM_V + 2 * SHM_K) + wid * 64; float* li_l = ws; float* al_l = ws + 32;
  float m_reg = -1e30f, l_reg = 0; f32x16 o[4] = {}; bf16x8 qr[8];
  const bf16_t* Qw = Qb + (long)(wid * QBLK + r32) * ldq + hi * 8;
#pragma unroll
  for (int d0 = 0; d0 < 8; ++d0) qr[d0] = *reinterpret_cast<const bf16x8*>(Qw + d0 * 16);
  char* qx = lds + 2 * SHM_V + 2 * SHM_K + 2048 + wid * 4096 + lane * 16;
  if constexpr (DQ == 192) {
    const int t = qpos0 + wid * QBLK + r32;
#pragma unroll
    for (int ax = 0; ax < 2; ++ax) {
      const int pos = ax ? (t & 63) : (t >> 6); const float2* tb = tabC + pos * 16 + hi * 8;
      bf16x8 a = *reinterpret_cast<const bf16x8*>(Qw + (8 + 2 * ax) * 16), b = *reinterpret_cast<const bf16x8*>(Qw + (9 + 2 * ax) * 16);
      if (ropeq) {
#pragma unroll
        for (int j = 0; j < 8; ++j) { const float2 cs = tb[j]; const float x1 = bf2f_s(a[j]), x2 = bf2f_s(b[j]);
          a[j] = (short)f2bf(x1 * cs.x - x2 * cs.y); b[j] = (short)f2bf(x1 * cs.y + x2 * cs.x); }
      }
      *reinterpret_cast<bf16x8*>(qx + (2 * ax) * 1024) = a; *reinterpret_cast<bf16x8*>(qx + (2 * ax + 1) * 1024) = b;
    }
  }
  const int kb = kswz<DQ>(r32, hi * 16);
  const int sr = tid >> 4, sc = (tid & 15) * 8, vst0 = v_st(sr, sc), vst1 = v_st(32 + sr, sc);
  const int sr2 = tid >> 3, sc2 = (tid & 7) * 8;
  const int vb0 = (int)(uintptr_t)V_lds + v_rd_base(lane);
  struct { bf16x8 vs0, vs1, ks0, ks1, ks2; } sr_[1];
#define SLOAD(i, k0) do { sr_[i].vs0 = *(const bf16x8*)(&Vh[(long)((k0) + sr) * ldv + sc]); sr_[i].vs1 = *(const bf16x8*)(&Vh[(long)((k0) + 32 + sr) * ldv + sc]); \
    sr_[i].ks0 = *(const bf16x8*)(&K0[(long)((k0) + sr) * ldk0 + sc]); sr_[i].ks1 = *(const bf16x8*)(&K0[(long)((k0) + 32 + sr) * ldk0 + sc]); \
    if constexpr (DQ == 192) sr_[i].ks2 = *(const bf16x8*)(&K1[(long)((k0) + sr2) * ldk1 + sc2]); } while (0)
#define SWRITE(b, i) do { *(bf16x8*)(V_lds + (b) * SHM_V + vst0) = sr_[i].vs0;          \
    *(bf16x8*)(V_lds + (b) * SHM_V + vst1) = sr_[i].vs1; int kc = sc * 2;               \
    *(bf16x8*)(K_lds + (b) * SHM_K + kswz<DQ>(sr, kc)) = sr_[i].ks0;                       \
    *(bf16x8*)(K_lds + (b) * SHM_K + kswz<DQ>(32 + sr, kc)) = sr_[i].ks1;                  \
    if constexpr (DQ == 192) *(bf16x8*)(K_lds + (b) * SHM_K + kswz<DQ>(sr2, 256 + sc2 * 2)) = sr_[i].ks2; } while (0)
#define SWAIT() asm volatile("s_waitcnt vmcnt(0)" ::: "memory")
#define RESC(a) do { if (__any((a) < 1.f)) { if (hi == 0) al_l[r32] = (a); asm volatile("s_waitcnt lgkmcnt(0)" ::: "memory"); \
    _Pragma("unroll") for (int d = 0; d < 4; ++d) _Pragma("unroll") for (int r = 0; r < 16; ++r) o[d][r] *= al_l[crow(r, hi)]; } } while (0)
  f32x16 pA0, pA1, pB0, pB1; float mnA, mnB, alA, alB; bf16x8 pa0, pa1, pa2, pa3; const int NT = seq / KVBLK;
  SLOAD(0, 0); SWAIT(); SWRITE(0, 0); __syncthreads();
  qkt<DQ>(pA0, pA1, K_lds, qr, qx, kb); partialSM<DQ>(pA0, pA1, m_reg, mnA, alA);
  SLOAD(0, KVBLK);
  SWAIT(); SWRITE(1, 0); __syncthreads();
  for (int j = 1; j + 1 < NT; j += 2) {
    SBAR(); qkt<DQ>(pB0, pB1, K_lds + SHM_K, qr, qx, kb);
    finishSM(pA0, pA1, alA, l_reg, pa0, pa1, pa2, pa3); SBAR();
    SLOAD(0, (j + 1) * KVBLK); SBAR();
    pv_d0(o, vb0, pa0, pa1, pa2, pa3); partialSM<DQ>(pB0, pB1, m_reg, mnB, alB);
    __syncthreads(); SWAIT(); SWRITE(0, 0);
    RESC(alB); __syncthreads();
    SBAR(); qkt<DQ>(pA0, pA1, K_lds, qr, qx, kb);
    finishSM(pB0, pB1, alB, l_reg, pa0, pa1, pa2, pa3); SBAR();
    SLOAD(0, (j + 2) * KVBLK); SBAR();
    pv_d0(o, vb0 + (int)SHM_V, pa0, pa1, pa2, pa3); partialSM<DQ>(pA0, pA1, m_reg, mnA, alA);
    __syncthreads(); SWAIT(); SWRITE(1, 0);
    RESC(alA); __syncthreads();
  }
  SBAR(); qkt<DQ>(pB0, pB1, K_lds + SHM_K, qr, qx, kb);
  finishSM(pA0, pA1, alA, l_reg, pa0, pa1, pa2, pa3); SBAR();
  pv_d0(o, vb0, pa0, pa1, pa2, pa3); partialSM<DQ>(pB0, pB1, m_reg, mnB, alB);
  __syncthreads(); RESC(alB);
  finishSM(pB0, pB1, alB, l_reg, pa0, pa1, pa2, pa3); SBAR();
  pv_d0(o, vb0 + (int)SHM_V, pa0, pa1, pa2, pa3);
  if (hi == 0) li_l[r32] = l_reg; asm volatile("s_waitcnt lgkmcnt(0)" ::: "memory");
  float rli[16];
#pragma unroll
  for (int r = 0; r < 16; ++r) rli[r] = __builtin_amdgcn_rcpf(li_l[crow(r, hi)]);
  bf16_t* Ow = Ob + (long)(wid * QBLK) * ldo;
#pragma unroll
  for (int r = 0; r < 16; ++r) { int orow = crow(r, hi);
#pragma unroll
    for (int d0 = 0; d0 < 4; ++d0) Ow[(long)orow * ldo + d0 * 32 + r32] = (bf16_t)f2bf(o[d0][r] * rli[r]); }
  __syncthreads();
#undef SLOAD
#undef SWRITE
#undef SWAIT
#undef RESC
}
#undef SBAR
}


#define XB_TMO      128
#define XB_XCNT(j)  (256  + 64 * (j))
#define XB_XSUB(j)  (1280 + 64 * (j))
#define XB_XGEN(j)  (2304 + 64 * (j))
#define XB_TOP      3328
#define XB_TOPGEN   3392
#define XCD_BAR_WORDS 3456
#define XB_SPIN_CAP (1u << 20)
__device__ __forceinline__ unsigned xb_ld(unsigned* p)              { return __hip_atomic_load(p, __ATOMIC_RELAXED, __HIP_MEMORY_SCOPE_AGENT); }
__device__ __forceinline__ unsigned xb_add(unsigned* p, unsigned v) { return __hip_atomic_fetch_add(p, v, __ATOMIC_RELAXED, __HIP_MEMORY_SCOPE_AGENT); }
__device__ __forceinline__ unsigned xb_xcc_id() { return (unsigned)__builtin_amdgcn_s_getreg((3 << 11) | 20) & 0xFu; }
#define XB_SPIN(cond, bar) do { unsigned _sp = 0; while (cond) { __builtin_amdgcn_s_sleep(1); \
    if ((++_sp & 255u) == 0u) { if (xb_ld(&(bar)[XB_TMO])) break; if (_sp > XB_SPIN_CAP) { atomicAdd(&(bar)[XB_TMO], 1u); break; } } } } while (0)
struct XcdBarrier { unsigned* bar; unsigned x; volatile LAS unsigned* st; };
__device__ __forceinline__ XcdBarrier xcd_barrier_post(unsigned* bar, volatile LAS unsigned* st) {
    XcdBarrier b; b.bar = bar; b.x = xb_xcc_id(); b.st = st;
    if (threadIdx.x == 0) (void)xb_add(&bar[XB_XCNT(b.x)], 1u);
    return b;
}
__device__ __forceinline__ void xcd_barrier_complete(unsigned* bar, unsigned x, unsigned& nloc, unsigned& nx) {
    const unsigned G = gridDim.x * gridDim.y * gridDim.z;
    unsigned sum, cnt, mine, sp = 0u;
    for (;;) {
        sum = 0u; cnt = 0u; mine = 0u;
#pragma unroll
        for (unsigned j = 0; j < 16; ++j) { const unsigned c = xb_ld(&bar[XB_XCNT(j)]); sum += c; cnt += (c > 0u) ? 1u : 0u; mine = (j == x) ? c : mine; }
        if (sum == G) break;
        __builtin_amdgcn_s_sleep(1);
        if ((++sp & 255u) == 0u) { if (xb_ld(&bar[XB_TMO])) break; if (sp > XB_SPIN_CAP) { atomicAdd(&bar[XB_TMO], 1u); break; } }
    }
    nloc = mine > 0u ? mine : 1u; nx = cnt > 0u ? cnt : 1u;
}
__device__ __forceinline__ void xcd_barrier(const XcdBarrier& b) {
    asm volatile("s_waitcnt vmcnt(0)" ::: "memory");
    __syncthreads();
    if (threadIdx.x == 0) {
        unsigned* bar = b.bar;
        __builtin_amdgcn_s_waitcnt(0);
        unsigned nloc = b.st[0], nx = b.st[1];
        if (nloc == 0u) { xcd_barrier_complete(bar, b.x, nloc, nx); b.st[0] = nloc; b.st[1] = nx; }
        const unsigned old = xb_add(&bar[XB_XSUB(b.x)], 1u);
        const unsigned gen = old / nloc;
        if (old + 1u == (gen + 1u) * nloc) {
            __builtin_amdgcn_fence(__ATOMIC_RELEASE, "agent");
            asm volatile("s_waitcnt vmcnt(0)" ::: "memory");
            const unsigned og = xb_add(&bar[XB_TOP], 1u);
            const unsigned tg = og / nx;
            if (og + 1u == (tg + 1u) * nx) xb_add(&bar[XB_TOPGEN], 1u);
            else XB_SPIN(xb_ld(&bar[XB_TOPGEN]) == tg, bar);
            __builtin_amdgcn_fence(__ATOMIC_ACQUIRE, "agent");
            xb_add(&bar[XB_XGEN(b.x)], 1u);
            asm volatile("s_waitcnt vmcnt(0)" ::: "memory");
        } else {
            XB_SPIN(xb_ld(&bar[XB_XGEN(b.x)]) == gen, bar);
            __builtin_amdgcn_fence(__ATOMIC_ACQUIRE, "agent");
            asm volatile("s_waitcnt vmcnt(0)" ::: "memory");
        }
    }
    __syncthreads();
}

struct Params { const float* in[26]; float* out; unsigned char* ws; };
enum { I_X = 0, I_C, I_CTX, I_CCTX, I_WADA, I_BADA, I_NMIXG, I_WIN, I_BGATE, I_CONVW, I_QNG, I_KNG, I_MQNG, I_MKVNG, I_WUQ, I_WUKV, I_SLNG, I_SLNB,
       I_SWS, I_SBS, I_WBR, I_WOUT, I_NFFNG, I_WFF1, I_WFF2, I_FNG };

__device__ __forceinline__ void transpose_item(const float* W, int K, int N, bf16_t* WT, bool padmode, LAS float* scr, int item, int lane) {
    const int nblk = N / 64, kb = item / nblk, nb = item % nblk, k0 = 64 * kb, n0 = 64 * nb;
    const int lr = lane >> 4, lc = (lane & 15) * 4;
    f32x4 v[16];
#pragma unroll
    for (int i = 0; i < 16; ++i) v[i] = *(const f32x4*)(W + (size_t)(k0 + 4 * i + lr) * N + n0 + lc);
#pragma unroll
    for (int i = 0; i < 16; ++i) { LAS float* d = scr + (4 * i + lr) * 65 + lc; d[0] = v[i][0]; d[1] = v[i][1]; d[2] = v[i][2]; d[3] = v[i][3]; }
    asm volatile("s_waitcnt lgkmcnt(0)" ::: "memory");
    const int c = lane & 7; const int roff = (padmode && n0 >= 1088) ? 192 : 0;
#pragma unroll
    for (int j = 0; j < 8; ++j) { const int n = (lane >> 3) + 8 * j; const LAS float* s = scr + (8 * c) * 65 + n;
        u32x4 o; o.x = pk2(s[0 * 65], s[1 * 65]); o.y = pk2(s[2 * 65], s[3 * 65]); o.z = pk2(s[4 * 65], s[5 * 65]); o.w = pk2(s[6 * 65], s[7 * 65]);
        *(u32x4*)(WT + (size_t)(roff + n0 + n) * K + k0 + 8 * c) = o; }
    asm volatile("s_waitcnt lgkmcnt(0)" ::: "memory");
}

typedef const Params __attribute__((address_space(4))) KParams;
constexpr int TR_PER_L = 7968 + 192 + 256 + 2048 + 1024 + 4096 + 4096;
constexpr int TR_FIRST = 7968 + 192 + 256, TR_FF2 = TR_PER_L - 4096;
__device__ __forceinline__ void transpose_layer_item(KParams& p, unsigned char* ws, int l, int r, LAS float* scr, int lane) {
    unsigned char* wl = ws + WS_W0 + l * W_LSTRIDE;
    if (r < 7968) { transpose_item(p.in[I_WIN] + (size_t)l * DM * NIN, DM, NIN, (bf16_t*)(wl + WO_IN), true, scr, r, lane); return; } r -= 7968;
    if (r < 192) { transpose_item(p.in[I_WUQ] + (size_t)l * 512 * 1536, 512, 1536, (bf16_t*)(wl + WO_UQ), false, scr, r, lane); return; } r -= 192;
    if (r < 256) { transpose_item(p.in[I_WUKV] + (size_t)l * 512 * 2048, 512, 2048, (bf16_t*)(wl + WO_UKV), false, scr, r, lane); return; } r -= 256;
    if (r < 2048) { const int br = r >> 9; transpose_item(p.in[I_WBR] + (size_t)(l * 4 + br) * 1024 * DM, 1024, DM, (bf16_t*)(wl + WO_BR) + (size_t)br * DM * 1024, false, scr, r & 511, lane); return; } r -= 2048;
    if (r < 1024) { transpose_item(p.in[I_WOUT] + (size_t)l * DM * DM, DM, DM, (bf16_t*)(wl + WO_OUT), false, scr, r, lane); return; } r -= 1024;
    if (r < 4096) { transpose_item(p.in[I_WFF1] + (size_t)l * DM * DFF, DM, DFF, (bf16_t*)(wl + WO_F1), false, scr, r, lane); return; } r -= 4096;
    transpose_item(p.in[I_WFF2] + (size_t)l * DFF * DM, DFF, DM, (bf16_t*)(wl + WO_F2), false, scr, r, lane);
}
__global__ void __launch_bounds__(NTHR, 2) mega_fwd(Params p_arg) {
    extern __shared__ __attribute__((aligned(16))) unsigned char lds_raw[];
    cg::grid_group grid = cg::this_grid();
    LAS unsigned char* lds = (LAS unsigned char*)lds_raw;
    const int tid0 = threadIdx.x, wave = __builtin_amdgcn_readfirstlane(tid0 >> 6);
    const int G = gridDim.x;
#define PHASE_IDS() int tid = tid0; asm volatile("" : "+v"(tid)); const int lane = tid & 63; (void)lane
    const int NGW = G * NWAVES;
#define WS_PTRS() KParams* pk_ = (KParams*)__builtin_amdgcn_kernarg_segment_ptr(); asm volatile("" : "+s"(pk_)); KParams& p = *pk_;   \
    unsigned char* ws = p.ws; asm volatile("" : "+s"(ws)); int bx_ = blockIdx.x; asm volatile("" : "+s"(bx_)); const int bx = bx_, gw = bx * NWAVES + wave; (void)gw; \
    float* MOD = (float*)(ws + WS_MOD); float2* tabB = (float2*)(ws + WS_TABB); float2* tabC = (float2*)(ws + WS_TABC); float2* stats = (float2*)(ws + WS_STATS); \
    bf16_t* H = (bf16_t*)(ws + WS_H); bf16_t* P = (bf16_t*)(ws + WS_P); bf16_t* U = (bf16_t*)(ws + WS_P); \
    bf16_t* KB = (bf16_t*)(ws + WS_KB); bf16_t* KR = (bf16_t*)(ws + WS_KR); bf16_t* QB = (bf16_t*)(ws + WS_QB); \
    bf16_t* CKVN = (bf16_t*)(ws + WS_CKVN); bf16_t* CQN = (bf16_t*)(ws + WS_CQN); bf16_t* QC = (bf16_t*)(ws + WS_QC); bf16_t* KVU = (bf16_t*)(ws + WS_KVU); \
    bf16_t* YS = (bf16_t*)(ws + WS_YS); float* MRG = (float*)(ws + WS_MRG); bf16_t* MG = (bf16_t*)(ws + WS_MG); float* XS = (float*)(ws + WS_XS); float* ZSLAB = (float*)(ws + WS_ZSLAB); \
    (void)MOD; (void)tabB; (void)tabC; (void)stats; (void)H; (void)P; (void)U; (void)KB; (void)KR; (void)QB; (void)CKVN; (void)CQN; (void)QC; (void)KVU; (void)YS; (void)MRG; (void)MG; (void)XS; (void)ZSLAB
#define LAYER_PTRS() unsigned char* wl = ws + WS_W0 + l * W_LSTRIDE; \
    const bf16_t* Win_t = (const bf16_t*)(wl + WO_IN); const bf16_t* Wuq_t = (const bf16_t*)(wl + WO_UQ); const bf16_t* Wukv_t = (const bf16_t*)(wl + WO_UKV); \
    const bf16_t* Wbr_t = (const bf16_t*)(wl + WO_BR); const bf16_t* Wout_t = (const bf16_t*)(wl + WO_OUT); const bf16_t* W1_t = (const bf16_t*)(wl + WO_F1); \
    const bf16_t* W2_t = (const bf16_t*)(wl + WO_F2); const bf16_t* Wsg = (const bf16_t*)(wl + WO_SG); \
    const float* modx = MOD + (size_t)(l * 2 + 0) * 12288; const float* modz = MOD + (size_t)(l * 2 + 1) * 12288; \
    const float* xsrc = l0 ? p.in[I_X] : XS; const float* zsrc = l0 ? p.in[I_CTX] : XS + (size_t)SEQ * DM; \
    (void)Win_t; (void)Wuq_t; (void)Wukv_t; (void)Wbr_t; (void)Wout_t; (void)W1_t; (void)W2_t; (void)Wsg; (void)modx; (void)modz; (void)xsrc; (void)zsrc

    {
        if (blockIdx.x == 0) for (int i = tid0; i < XCD_BAR_WORDS; i += NTHR) ((unsigned*)(p_arg.ws + WS_BAR))[i] = 0u;
        if (tid0 < 2) ((volatile LAS unsigned*)(lds + LDS_BARST))[tid0] = 0u;
    }
#if (PHM & 1)
    for (int rp0_ = 0; rp0_ < REP_P0; ++rp0_)
    {
        PHASE_IDS(); WS_PTRS();
#if (PHM & 4096)
        LAS float* sl = (LAS float*)lds;
        LAS float* red = (LAS float*)(lds + 16384);
        if (bx < 192) {
            for (int i = tid; i < 4096; i += NTHR) { const int cond = i >> 11, k = i & 2047; const float v = (cond ? p.in[I_CCTX] : p.in[I_C])[k]; sl[i] = v / (1.f + __expf(-v)); }
            __syncthreads();
        }
        for (int item = bx; item < 192; item += G) {
            typedef float f32x2 __attribute__((ext_vector_type(2)));
            const int l = item / 96, n0 = (item % 96) * 128;
            const float* wp = p.in[I_WADA] + (size_t)l * DM * 12288 + n0 + lane * 2;
            f32x2 a0 = (f32x2){0.f, 0.f}, a1 = a0;
#pragma unroll 16
            for (int kk = 0; kk < 256; ++kk) { const int k = wave * 256 + kk; const f32x2 wv = *(const f32x2*)(wp + (size_t)k * 12288); a0 += wv * sl[k]; a1 += wv * sl[2048 + k]; }
            *(LAS f32x2*)(red + (wave * 2 + 0) * 128 + lane * 2) = a0; *(LAS f32x2*)(red + (wave * 2 + 1) * 128 + lane * 2) = a1;
            __syncthreads();
            if (tid < 256) { const int cond = tid >> 7, col = tid & 127; float s = p.in[I_BADA][(size_t)l * 12288 + n0 + col];
#pragma unroll
              for (int w = 0; w < 8; ++w) s += red[(w * 2 + cond) * 128 + col];
              MOD[(size_t)(l * 2 + cond) * 12288 + n0 + col] = s; }
            __syncthreads();
        }
#endif
#if (PHM & 8192)
        for (int idx = bx * NTHR + tid; idx < 128 * 48; idx += G * NTHR) {
            const int pos = idx / 48, j = idx % 48;
            if (j < 32) { const float inv = powf(10000.0f, -(float)(2 * j) / 64.0f); const float ang = (float)pos * inv; tabB[pos * 32 + j] = make_float2(cosf(ang), sinf(ang)); }
            else { const int i = j - 32; const float inv = powf(10000.0f, -(float)(2 * i) / 32.0f); const float ang = (float)pos * inv; tabC[pos * 16 + i] = make_float2(cosf(ang), sinf(ang)); }
        }
#endif
#if (PHM & 16384)
        for (int idx = bx * NTHR + tid; idx < 2 * 131072 / 4; idx += G * NTHR) {
            const int l = idx / 32768, r = idx % 32768; const f32x4 v = *(const f32x4*)(p.in[I_SWS] + (size_t)idx * 4);
            u32x2 o; o.x = pk2(v[0], v[1]); o.y = pk2(v[2], v[3]);
            *(u32x2*)((bf16_t*)(ws + WS_W0 + l * W_LSTRIDE + WO_SG) + (size_t)r * 4) = o;
        }
#endif
        __syncthreads();
#if (PHM & 32768)
        LAS float* scr = (LAS float*)(lds + wave * 16640);
        for (int it = gw; it < TR_FIRST; it += NGW) transpose_layer_item(p, ws, 0, it, scr, lane);
#endif
    }
    #endif
        grid.sync();
        const XcdBarrier xb = xcd_barrier_post((unsigned*)(p_arg.ws + WS_BAR), (volatile LAS unsigned*)(lds + LDS_BARST));

    for (int l = 0; l < 2; ++l) {
        const bool l0 = (l == 0);
        const int TQ = l0 ? TALL : SEQ;
        const int nMq = TQ / 256;

#if (PHM & 2)
        {
        WS_PTRS(); LAYER_PTRS();
        PHASE_IDS();
            const float* gmix = p.in[I_NMIXG] + (size_t)l * DM;
            for (int rew_ = 0; rew_ < REP_EW; ++rew_)
            for (int row = gw; row < TALL; row += NGW) {
                const bool isz = row >= SEQ; const float* src = isz ? zsrc + (size_t)(row - SEQ) * DM : xsrc + (size_t)row * DM; const float* md = isz ? modz : modx;
                f32x4 v[8]; float ss = 0.f;
#pragma unroll
                for (int j = 0; j < 8; ++j) v[j] = *(const f32x4*)(src + (lane + 64 * j) * 4);
                if (isz && !l0) {
                    const float* g2z = MOD + (size_t)12288 + 5 * 2048;
#pragma unroll
                    for (int j = 0; j < 8; ++j) { const int c = (lane + 64 * j) * 4; f32x4 s = (f32x4){0.f, 0.f, 0.f, 0.f};
                        for (int ks = 0; ks < 16; ++ks) s += *(const f32x4*)(ZSLAB + ((size_t)ks * 256 + (row - SEQ)) * DM + c);
                        v[j] += *(const f32x4*)(g2z + c) * s; }
                }
#pragma unroll
                for (int j = 0; j < 8; ++j) ss += v[j][0] * v[j][0] + v[j][1] * v[j][1] + v[j][2] * v[j][2] + v[j][3] * v[j][3];
                const float r = rsqrtf(wave_sum(ss) * (1.f / DM) + EPS);
#pragma unroll
                for (int j = 0; j < 8; ++j) { const int c = (lane + 64 * j) * 4; const f32x4 g = *(const f32x4*)(gmix + c), sh = *(const f32x4*)(md + c), sc = *(const f32x4*)(md + 2048 + c);
                    f32x4 h = (v[j] * r * g) * (sc + 1.f) + sh; u32x2 o; o.x = pk2(h[0], h[1]); o.y = pk2(h[2], h[3]); *(u32x2*)(H + (size_t)row * DM + c) = o; }
            }
        }
        #endif
        for (int rs_ = 0; rs_ < REP_SYNC; ++rs_) xcd_barrier(xb);

#if (PHM & 4)
        {
        WS_PTRS(); LAYER_PTRS();
            pg8::SchedWide S{H, Win_t, DM, nMq, NINP / 256, nMq * (NINP / 256), 32, l0 ? 0 : 5, G, bx};
            pg8::EpiAct E{P, NINP, P, NINP, p.in[I_BGATE] + (size_t)l * 8192, P_G, P_U / 256, P_G / 256, -1};
            int nrep = REP_B; asm volatile("" : "+s"(nrep));
            for (int rep = 0; rep < nrep; ++rep) pg8::gemm_phase<pg8::EpiAct, pg8::SchedWide, true, true>(lds, DM, S, E);
            if (l0 && bx >= 31) {
                PHASE_IDS();
                LAS float* scr = (LAS float*)(lds + wave * 16640);
                for (int it = TR_FIRST + (bx - 31) * NWAVES + wave; it < TR_FF2; it += 225 * NWAVES) transpose_layer_item(p, ws, 0, it, scr, lane);
            }
        }
        #endif
        for (int rs_ = 0; rs_ < REP_SYNC; ++rs_) xcd_barrier(xb);

#if (PHM & 8)
        {
        WS_PTRS(); LAYER_PTRS();
        PHASE_IDS();
            const float* kng = p.in[I_KNG] + l * 128; const float* qng = p.in[I_QNG] + l * 128;
            const float* mqg = p.in[I_MQNG] + l * 512; const float* mkg = p.in[I_MKVNG] + l * 512; const float* cw = p.in[I_CONVW] + (size_t)l * 3 * 1024;
            for (int rew_ = 0; rew_ < REP_EW; ++rew_)
            for (int t = gw; t < TALL; t += NGW) {
                const bool isz = t >= SEQ, full = l0 || !isz; const bf16_t* pr = P + (size_t)t * NINP;
                const int li = lane & 31, hh = lane >> 5;
                const float2 csr = tabB[(t >> 6) * 32 + li], csc = tabB[(t & 63) * 32 + li];
                { const bf16_t* s = pr + P_KB + hh * 128 + li; float y0 = bf2f(s[0]), y1 = bf2f(s[32]), y2 = bf2f(s[64]), y3 = bf2f(s[96]);
                  const float r = rsqrtf(half_sum(y0 * y0 + y1 * y1 + y2 * y2 + y3 * y3) * (1.f / 128.f) + EPS);
                  y0 *= r * kng[li]; y1 *= r * kng[32 + li]; y2 *= r * kng[64 + li]; y3 *= r * kng[96 + li];
                  if (!isz) { const float a0 = y0 * csr.x - y1 * csr.y, a1 = y0 * csr.y + y1 * csr.x, a2 = y2 * csc.x - y3 * csc.y, a3 = y2 * csc.y + y3 * csc.x; y0 = a0; y1 = a1; y2 = a2; y3 = a3; }
                  bf16_t* d = KB + (size_t)t * 256 + hh * 128 + li; d[0] = (bf16_t)f2bf(y0); d[32] = (bf16_t)f2bf(y1); d[64] = (bf16_t)f2bf(y2); d[96] = (bf16_t)f2bf(y3); }
                { const bf16x8 v = *(const bf16x8*)(pr + P_CKV + lane * 8); float f[8], ss = 0.f;
#pragma unroll
                  for (int j = 0; j < 8; ++j) { f[j] = bf2f_s(v[j]); ss += f[j] * f[j]; }
                  const float r = rsqrtf(wave_sum(ss) * (1.f / 512.f) + EPS); u32x4 o;
                  o.x = pk2(f[0] * r * mkg[lane * 8 + 0], f[1] * r * mkg[lane * 8 + 1]); o.y = pk2(f[2] * r * mkg[lane * 8 + 2], f[3] * r * mkg[lane * 8 + 3]);
                  o.z = pk2(f[4] * r * mkg[lane * 8 + 4], f[5] * r * mkg[lane * 8 + 5]); o.w = pk2(f[6] * r * mkg[lane * 8 + 6], f[7] * r * mkg[lane * 8 + 7]);
                  *(u32x4*)(CKVN + (size_t)t * 512 + lane * 8) = o; }
                if (lane < 32) { const int ax = lane >> 4, i = lane & 15; const bf16_t* s = pr + P_KR + ax * 32 + i; float x1 = bf2f(s[0]), x2 = bf2f(s[16]);
                  if (!isz) { const float2 cs = tabC[(ax ? (t & 63) : (t >> 6)) * 16 + i]; const float a = x1 * cs.x - x2 * cs.y, b = x1 * cs.y + x2 * cs.x; x1 = a; x2 = b; }
                  bf16_t* d = KR + (size_t)t * 64 + ax * 32 + i; d[0] = (bf16_t)f2bf(x1); d[16] = (bf16_t)f2bf(x2); }
                if (full) {
#pragma unroll
                    for (int it = 0; it < 4; ++it) { const int hd = it * 2 + hh; const bf16_t* s = pr + P_QB + hd * 128 + li; float y0 = bf2f(s[0]), y1 = bf2f(s[32]), y2 = bf2f(s[64]), y3 = bf2f(s[96]);
                      const float r = rsqrtf(half_sum(y0 * y0 + y1 * y1 + y2 * y2 + y3 * y3) * (1.f / 128.f) + EPS);
                      y0 *= r * qng[li]; y1 *= r * qng[32 + li]; y2 *= r * qng[64 + li]; y3 *= r * qng[96 + li];
                      if (!isz) { const float a0 = y0 * csr.x - y1 * csr.y, a1 = y0 * csr.y + y1 * csr.x, a2 = y2 * csc.x - y3 * csc.y, a3 = y2 * csc.y + y3 * csc.x; y0 = a0; y1 = a1; y2 = a2; y3 = a3; }
                      bf16_t* d = QB + (size_t)t * 1024 + hd * 128 + li; d[0] = (bf16_t)f2bf(y0); d[32] = (bf16_t)f2bf(y1); d[64] = (bf16_t)f2bf(y2); d[96] = (bf16_t)f2bf(y3); }
                    { const bf16x8 v = *(const bf16x8*)(pr + P_CQ + lane * 8); float f[8], ss = 0.f;
#pragma unroll
                      for (int j = 0; j < 8; ++j) { f[j] = bf2f_s(v[j]); ss += f[j] * f[j]; }
                      const float r = rsqrtf(wave_sum(ss) * (1.f / 512.f) + EPS); u32x4 o;
                      o.x = pk2(f[0] * r * mqg[lane * 8 + 0], f[1] * r * mqg[lane * 8 + 1]); o.y = pk2(f[2] * r * mqg[lane * 8 + 2], f[3] * r * mqg[lane * 8 + 3]);
                      o.z = pk2(f[4] * r * mqg[lane * 8 + 4], f[5] * r * mqg[lane * 8 + 5]); o.w = pk2(f[6] * r * mqg[lane * 8 + 6], f[7] * r * mqg[lane * 8 + 7]);
                      *(u32x4*)(CQN + (size_t)t * 512 + lane * 8) = o; }
                    { const int tlo = isz ? SEQ : 0, thi = isz ? TALL : SEQ; const bool hp = t > tlo, hn = t + 1 < thi;
#pragma unroll
                      for (int q = 0; q < 2; ++q) { const int c = lane * 16 + q * 8;
                        const bf16x8 gb = *(const bf16x8*)(pr + P_GB + c), gc = *(const bf16x8*)(pr + P_GC + c), xa = *(const bf16x8*)(pr + P_XA + c);
                        bf16x8 gcp = gc, xap = xa, gcn = gc, xan = xa;
                        if (hp) { gcp = *(const bf16x8*)(pr - NINP + P_GC + c); xap = *(const bf16x8*)(pr - NINP + P_XA + c); }
                        if (hn) { gcn = *(const bf16x8*)(pr + NINP + P_GC + c); xan = *(const bf16x8*)(pr + NINP + P_XA + c); }
                        float y[8];
#pragma unroll
                        for (int j = 0; j < 8; ++j) { const float uc = bf2f_s(gc[j]) * bf2f_s(xa[j]); const float up = hp ? bf2f_s(gcp[j]) * bf2f_s(xap[j]) : 0.f; const float un = hn ? bf2f_s(gcn[j]) * bf2f_s(xan[j]) : 0.f;
                          y[j] = bf2f_s(gb[j]) * (cw[c + j] * up + cw[1024 + c + j] * uc + cw[2048 + c + j] * un); }
                        u32x4 o; o.x = pk2(y[0], y[1]); o.y = pk2(y[2], y[3]); o.z = pk2(y[4], y[5]); o.w = pk2(y[6], y[7]);
                        *(u32x4*)(YS + (size_t)t * 1024 + c) = o; } }
                    { const bf16x8 v0 = *(const bf16x8*)(pr + P_V + lane * 16), v1 = *(const bf16x8*)(pr + P_V + lane * 16 + 8); float f[16], s = 0.f;
#pragma unroll
                      for (int j = 0; j < 8; ++j) { f[j] = bf2f_s(v0[j]); f[8 + j] = bf2f_s(v1[j]); s += f[j] + f[8 + j]; }
                      const float mean = wave_sum(s) * (1.f / 1024.f); float q = 0.f;
#pragma unroll
                      for (int j = 0; j < 16; ++j) { const float d = f[j] - mean; q += d * d; }
                      const float rstd = rsqrtf(wave_sum(q) * (1.f / 1024.f) + EPS);
                      if (lane == 0) stats[t] = make_float2(mean, rstd); }
                }
            }
        }
        #endif
        for (int rs_ = 0; rs_ < REP_SYNC; ++rs_) xcd_barrier(xb);

#if (PHM & 16)
        {
        WS_PTRS(); LAYER_PTRS();
            pg8::SchedDual S{CQN, Wuq_t, CKVN, Wukv_t, 512, nMq, nMq * 6, TALL / 256, (TALL / 256) * 8, G, bx};
            pg8::EpiAct E{QC, 1536, KVU, 2048, nullptr, 0, 1 << 30, 1 << 30, 0};
            int nrepd = REP_D; asm volatile("" : "+s"(nrepd));
            for (int rep = 0; rep < nrepd; ++rep) pg8::gemm_phase<pg8::EpiAct, pg8::SchedDual, true, true>(lds, 512, S, E);
            __syncthreads();
        PHASE_IDS();
            const float* lng = p.in[I_SLNG] + l * 1024; const float* lnb = p.in[I_SLNB] + l * 1024; const float* bs = p.in[I_SBS] + l * 1024;
            LAS bf16_t* VnT = (LAS bf16_t*)lds;
            const int r32 = lane & 31, hi = lane >> 5;
            for (int rew_ = 0; rew_ < REP_EW; ++rew_)
            for (int item = bx; item < (TQ / 128) * 8; item += G) {
                const int ch = item >> 3, g = item & 7, t0 = ch * 128;
                { const int q = tid >> 2, cs = (tid & 3) * 32; const float2 st = stats[t0 + q]; const bf16_t* src = P + (size_t)(t0 + q) * NINP + P_V + g * 128 + cs;
#pragma unroll
                  for (int k4 = 0; k4 < 4; ++k4) { const bf16x8 v = *(const bf16x8*)(src + k4 * 8);
#pragma unroll
                    for (int j = 0; j < 8; ++j) { const int c = cs + k4 * 8 + j; const float f = (bf2f_s(v[j]) - st.x) * st.y * lng[g * 128 + c] + lnb[g * 128 + c]; VnT[c * 136 + q] = (bf16_t)f2bf(f); } } }
                __syncthreads();
                const int pb = wave >> 1, cb0 = (wave & 1) * 2;
                f32x16 acc0 = {}, acc1 = {};
                const bf16_t* Ap = Wsg + (size_t)g * 16384 + (pb * 32 + r32) * 128 + hi * 8;
#pragma unroll
                for (int ks = 0; ks < 8; ++ks) { const bf16x8 a = *(const bf16x8*)(Ap + ks * 16);
                    const bf16x8 b0 = *(const LAS bf16x8*)(VnT + ((cb0 * 32 + r32) * 136 + ks * 16 + hi * 8)), b1 = *(const LAS bf16x8*)(VnT + (((cb0 + 1) * 32 + r32) * 136 + ks * 16 + hi * 8));
                    acc0 = __builtin_amdgcn_mfma_f32_32x32x16_bf16(a, b0, acc0, 0, 0, 0); acc1 = __builtin_amdgcn_mfma_f32_32x32x16_bf16(a, b1, acc1, 0, 0, 0); }
#pragma unroll
                for (int r = 0; r < 16; ++r) { const int pp = pb * 32 + att::crow(r, hi); const int t = t0 + pp; const float bias = bs[g * 128 + pp];
                    const int c0 = g * 128 + cb0 * 32 + r32; const bf16_t* up = P + (size_t)t * NINP + P_U; bf16_t* yp = YS + 3 * YS_STRIDE + (size_t)t * 1024;
                    yp[c0] = (bf16_t)f2bf(bf2f(up[c0]) * (acc0[r] + bias)); yp[c0 + 32] = (bf16_t)f2bf(bf2f(up[c0 + 32]) * (acc1[r] + bias)); }
                __syncthreads();
            }
        }
        #endif
        for (int rs_ = 0; rs_ < REP_SYNC; ++rs_) xcd_barrier(xb);

#if (PHM & 32)
        {
        WS_PTRS(); LAYER_PTRS();
            const int h = bx & 7, qb = bx >> 3;
            const int nun = 1;
            const bool zmla = l0 && bx < 8, zgqa = l0 && bx >= 8 && bx < 16;
            int nrepF = REP_F; asm volatile("" : "+s"(nrepF));
#if EN192
            for (int ui = 0; ui < (zmla ? 2 : 1) * nrepF; ++ui) {
                const bool zu = zmla && (ui & 1); const size_t r0 = zu ? (size_t)SEQ : (size_t)qb * 256; const size_t k0 = zu ? (size_t)SEQ : 0; const int seq = zu ? CTXL : TALL;
                att::attn_body<192, 1536, 2048, 64, 2048, 1024>(QC + r0 * 1536 + h * 192, KVU + k0 * 2048 + h * 256, KR + k0 * 64, KVU + k0 * 2048 + h * 256 + 128,
                                    YS + 2 * YS_STRIDE + r0 * 1024 + h * 128, seq, (char*)lds_raw, !zu, (int)r0, tabC);
            }
#endif
#if EN128
            for (int ui = 0; ui < (zgqa ? 2 : 1) * nrepF; ++ui) {
                const bool zu = zgqa && (ui & 1); const size_t r0 = zu ? (size_t)SEQ : (size_t)qb * 256; const size_t k0 = zu ? (size_t)SEQ : 0; const int seq = zu ? CTXL : TALL;
                att::attn_body<128, 1024, 256, 64, NINP, 1024>(QB + r0 * 1024 + h * 128, KB + k0 * 256 + (h >> 2) * 128, nullptr, P + k0 * NINP + P_VB + (h >> 2) * 128,
                                    YS + 1 * YS_STRIDE + r0 * 1024 + h * 128, seq, (char*)lds_raw, false, 0, tabC);
            }
#endif
        }
        #endif
        for (int rs_ = 0; rs_ < REP_SYNC; ++rs_) xcd_barrier(xb);

#if (PHM & 64)
        {
        WS_PTRS(); LAYER_PTRS();
            pg8::SchedBranch S{YS, Wbr_t, 1024, nMq, nMq * 8, G, bx, YS_STRIDE, (size_t)DM * 1024};
            pg8::EpiGate E{P, MG};
            int nrep = REP_G; asm volatile("" : "+s"(nrep));
            for (int rep = 0; rep < nrep; ++rep) pg8::gemm_phase<pg8::EpiGate, pg8::SchedBranch, true, true>(lds, 1024, S, E);
            if (l0 && bx >= 8) {
                PHASE_IDS();
                LAS float* scr = (LAS float*)(lds + wave * 16640);
                for (int it = (bx - 8) * NWAVES + wave; it < TR_PER_L; it += 248 * NWAVES) transpose_layer_item(p, ws, 1, it, scr, lane);
            }
        }
        #endif
        for (int rs_ = 0; rs_ < REP_SYNC; ++rs_) xcd_barrier(xb);

#if (PHM & 128)
        {
        WS_PTRS(); LAYER_PTRS();
            pg8::SchedNarrowZ S{MG, Wout_t, DM, 32, 256, G, bx, l0 ? 8 * 8 : 0, 256};
            pg8::EpiRes E{xsrc, zsrc, XS, modx + 2 * 2048, modz + 2 * 2048, 32, ZSLAB};
            pg8::gemm_phase<pg8::EpiRes, pg8::SchedNarrowZ, true, true>(lds, DM, S, E);
        }
        #endif
        for (int rs_ = 0; rs_ < REP_SYNC; ++rs_) xcd_barrier(xb);

#if (PHM & 256)
        {
        WS_PTRS(); LAYER_PTRS();
        PHASE_IDS();
            const float* gffn = p.in[I_NFFNG] + (size_t)l * DM;
            for (int rew_ = 0; rew_ < REP_EW; ++rew_)
            for (int row = gw; row < TQ; row += NGW) {
                const bool isz = row >= SEQ; const float* src = isz ? zsrc + (size_t)(row - SEQ) * DM : XS + (size_t)row * DM; const float* md = isz ? modz : modx;
                f32x4 v[8]; float ss = 0.f;
#pragma unroll
                for (int j = 0; j < 8; ++j) v[j] = *(const f32x4*)(src + (lane + 64 * j) * 4);
                if (isz) {
#pragma unroll
                    for (int j = 0; j < 8; ++j) { const int c = (lane + 64 * j) * 4; f32x4 s = (f32x4){0.f, 0.f, 0.f, 0.f};
                        for (int ks = 0; ks < 8; ++ks) s += *(const f32x4*)(ZSLAB + ((size_t)ks * 256 + (row - SEQ)) * DM + c);
                        v[j] += *(const f32x4*)(modz + 2 * 2048 + c) * s; *(f32x4*)(XS + (size_t)row * DM + c) = v[j]; }
                }
#pragma unroll
                for (int j = 0; j < 8; ++j) ss += v[j][0] * v[j][0] + v[j][1] * v[j][1] + v[j][2] * v[j][2] + v[j][3] * v[j][3];
                const float r = rsqrtf(wave_sum(ss) * (1.f / DM) + EPS);
#pragma unroll
                for (int j = 0; j < 8; ++j) { const int c = (lane + 64 * j) * 4; const f32x4 g = *(const f32x4*)(gffn + c), sh = *(const f32x4*)(md + 3 * 2048 + c), sc = *(const f32x4*)(md + 4 * 2048 + c);
                    f32x4 h = (v[j] * r * g) * (sc + 1.f) + sh; u32x2 o; o.x = pk2(h[0], h[1]); o.y = pk2(h[2], h[3]); *(u32x2*)(H + (size_t)row * DM + c) = o; }
            }
        }
        #endif
        for (int rs_ = 0; rs_ < REP_SYNC; ++rs_) xcd_barrier(xb);

#if (PHM & 512)
        {
        WS_PTRS(); LAYER_PTRS();
            pg8::SchedWide S{H, W1_t, DM, nMq, DFF / 256, nMq * (DFF / 256), 0, 0, G, bx};
            pg8::EpiAct E{U, DFF, U, DFF, nullptr, 0, 1 << 30, 1 << 30, 3};
            int nrep = REP_J; asm volatile("" : "+s"(nrep));
            for (int rep = 0; rep < nrep; ++rep) pg8::gemm_phase<pg8::EpiAct, pg8::SchedWide, true, true>(lds, DM, S, E);
            if (l0 && bx >= 32) {
                PHASE_IDS();
                LAS float* scr = (LAS float*)(lds + wave * 16640);
                for (int it = TR_FF2 + (bx - 32) * NWAVES + wave; it < TR_PER_L; it += 224 * NWAVES) transpose_layer_item(p, ws, 0, it, scr, lane);
            }
        }
        #endif
        for (int rs_ = 0; rs_ < REP_SYNC; ++rs_) xcd_barrier(xb);

#if (PHM & 1024)
        {
        WS_PTRS(); LAYER_PTRS();
            pg8::SchedNarrowZ S{U, W2_t, DFF, 32, 256, G, bx, l0 ? 8 * 16 : 0, 512};
            pg8::EpiRes E{XS, XS + (size_t)SEQ * DM, XS, modx + 5 * 2048, modz + 5 * 2048, 32, ZSLAB};
            pg8::gemm_phase<pg8::EpiRes, pg8::SchedNarrowZ, true, true>(lds, DFF, S, E);
        }
        #endif
        for (int rs_ = 0; rs_ < REP_SYNC; ++rs_) xcd_barrier(xb);
    }

    {
        WS_PTRS();
        PHASE_IDS();
        const float* gf = p.in[I_FNG];
        for (int row = gw; row < SEQ; row += NGW) {
            const float* src = XS + (size_t)row * DM; f32x4 v[8]; float ss = 0.f;
#pragma unroll
            for (int j = 0; j < 8; ++j) { v[j] = *(const f32x4*)(src + (lane + 64 * j) * 4); ss += v[j][0] * v[j][0] + v[j][1] * v[j][1] + v[j][2] * v[j][2] + v[j][3] * v[j][3]; }
            const float r = rsqrtf(wave_sum(ss) * (1.f / DM) + EPS);
#pragma unroll
            for (int j = 0; j < 8; ++j) { const int c = (lane + 64 * j) * 4; const f32x4 g = *(const f32x4*)(gf + c); *(f32x4*)(p.out + (size_t)row * DM + c) = v[j] * r * g; }
        }
    }
}

extern "C" void kernel_launch(void* const* d_in, const int* in_sizes, int n_in, void* d_out, int out_size, void* d_ws, size_t ws_size, hipStream_t stream) {
    static int grid = 0;
    if (grid == 0) {
        if (n_in != 26 || out_size != SEQ * DM || ws_size < WS_END) { fprintf(stderr, "kernel_launch: unexpected shapes (n_in %d out %d ws %zu, need ws >= %zu)\n", n_in, out_size, ws_size, (size_t)WS_END); grid = -1; return; }
        int dev = 0, cus = 0, per_cu = 0;
        hipGetDevice(&dev); hipDeviceGetAttribute(&cus, hipDeviceAttributeMultiprocessorCount, dev);
        if (hipFuncSetAttribute((const void*)mega_fwd, hipFuncAttributeMaxDynamicSharedMemorySize, LDS_BYTES) != hipSuccess) { fprintf(stderr, "kernel_launch: hipFuncSetAttribute failed\n"); grid = -1; return; }
        hipOccupancyMaxActiveBlocksPerMultiprocessor(&per_cu, (const void*)mega_fwd, NTHR, LDS_BYTES);
        (void)hipGetLastError();
        if (per_cu < 1) fprintf(stderr, "kernel_launch: occupancy query says %d blocks per CU\n", per_cu);
        grid = 256;
        if (cus != 256) fprintf(stderr, "kernel_launch: device has %d CUs; this kernel is built for a 256-workgroup grid\n", cus);
    }
    if (grid < 0) return;
    Params p{};
    for (int i = 0; i < 26; ++i) p.in[i] = (const float*)d_in[i];
    p.out = (float*)d_out; p.ws = (unsigned char*)d_ws;
    void* args[] = {&p};
    hipError_t e = hipLaunchCooperativeKernel((const void*)mega_fwd, dim3(grid), dim3(NTHR), args, LDS_BYTES, stream);
    if (e != hipSuccess) fprintf(stderr, "kernel_launch: cooperative launch failed: %s\n", hipGetErrorString(e));
}
```

```cpp
#include <hip/hip_runtime.h>
#include <hip/hip_cooperative_groups.h>
#include <cstdio>
#include <cstdint>
namespace cg = cooperative_groups;
#ifndef PHM
#define PHM 0xFFFF
#endif
#ifndef REP_F
#define REP_F 1
#endif
#ifndef REP_B
#define REP_B 1
#endif
#ifndef REP_J
#define REP_J 1
#endif
#ifndef REP_P0
#define REP_P0 1
#endif
#ifndef REP_SYNC
#define REP_SYNC 1
#endif
#ifndef REP_EW
#define REP_EW 1
#endif
#ifndef REP_C
#define REP_C 1
#endif
#ifndef REP_S
#define REP_S 1
#endif
#ifndef REP_G
#define REP_G 1
#endif
#ifndef REP_D
#define REP_D 1
#endif
#ifndef EN192
#define EN192 1
#endif
#ifndef EN128
#define EN128 1
#endif

#define LAS __attribute__((address_space(3)))
typedef unsigned short bf16_t;
typedef short bf16x8 __attribute__((ext_vector_type(8)));
typedef short s16x4 __attribute__((ext_vector_type(4)));
typedef float f32x4 __attribute__((ext_vector_type(4)));
typedef float f32x16 __attribute__((ext_vector_type(16)));
typedef unsigned u32x4 __attribute__((ext_vector_type(4)));
typedef unsigned u32x2 __attribute__((ext_vector_type(2)));

constexpr int DM = 2048, SEQ = 8192, CTXL = 256, TALL = SEQ + CTXL;
constexpr int NIN = 15936, NINP = 16128;
constexpr int P_KB = 0, P_VB = 256, P_CKV = 512, P_KR = 1024, P_QB = 1280, P_CQ = 2304, P_GB = 2816, P_GC = 3840, P_XA = 4864,
              P_U = 5888, P_V = 6912, P_G = 7936;
constexpr int DFF = 8192;
constexpr float EPS = 1e-6f;
constexpr int NWAVES = 8, NTHR = 512;

constexpr size_t MiB = 1u << 20;
constexpr size_t WS_MOD = 0;
constexpr size_t WS_TABB = 256 * 1024;
constexpr size_t WS_TABC = 320 * 1024;
constexpr size_t WS_STATS = 512 * 1024;
constexpr size_t WS_BAR = 768 * 1024;
constexpr int LDS_BARST = 134144;
constexpr size_t WS_W0 = 1 * MiB, W_LSTRIDE = 155 * MiB;
constexpr size_t WO_IN = 0, WO_UQ = 63 * MiB, WO_UKV = WO_UQ + 3 * MiB / 2, WO_BR = WO_UKV + 2 * MiB, WO_OUT = WO_BR + 16 * MiB,
                 WO_F1 = WO_OUT + 8 * MiB, WO_F2 = WO_F1 + 32 * MiB, WO_SG = WO_F2 + 32 * MiB;
constexpr size_t WS_H = 311 * MiB, WS_P = 344 * MiB, WS_KB = 604 * MiB, WS_KR = 609 * MiB, WS_QB = 611 * MiB, WS_CKVN = 628 * MiB,
                 WS_CQN = 637 * MiB, WS_QC = 646 * MiB, WS_KVU = 671 * MiB, WS_YS = 704 * MiB, WS_MRG = 770 * MiB, WS_MG = 836 * MiB,
                 WS_XS = 869 * MiB, WS_ZSLAB = 935 * MiB, WS_VBC = 967 * MiB, WS_END = 972 * MiB;
constexpr size_t YS_STRIDE = (size_t)TALL * 1024;
static_assert(WO_SG + 2 * 8 * 128 * 128 <= W_LSTRIDE, "weights map");

constexpr int LDS_BYTES = 132 * 1024;

__device__ __forceinline__ float bf2f(bf16_t v) { return __uint_as_float(((unsigned)v) << 16); }
__device__ __forceinline__ float bf2f_s(short v) { return __uint_as_float(((unsigned)(unsigned short)v) << 16); }
__device__ __forceinline__ unsigned f2bf(float f) { unsigned u = __float_as_uint(f); return (u + 0x7fffu + ((u >> 16) & 1u)) >> 16; }
__device__ __forceinline__ unsigned pk2(float lo, float hi) { return f2bf(lo) | (f2bf(hi) << 16); }
__device__ __forceinline__ unsigned cvt_pk_bf16(float lo, float hi) { unsigned r; asm volatile("v_cvt_pk_bf16_f32 %0, %1, %2" : "=v"(r) : "v"(lo), "v"(hi)); return r; }
__device__ __forceinline__ float wave_sum(float v) {
#pragma unroll
    for (int o = 1; o < 64; o <<= 1) v += __shfl_xor(v, o);
    return v;
}
__device__ __forceinline__ float half_sum(float v) {
#pragma unroll
    for (int o = 1; o < 32; o <<= 1) v += __shfl_xor(v, o);
    return v;
}

namespace pg8 {
constexpr int BM = 256, BK = 64, HALF = 128, HTB = HALF * BK * 2, STAGE_BYTES = 8 * HTB, NXCD = 8, WGM = 8;
__host__ __device__ __forceinline__ int lds_byte(int r, int c) { const int st = (r >> 4) * 2 + (c >> 5), rr = r & 15, cc = c & 31, ob = rr * 64 + cc * 2; return st * 1024 + (ob ^ (((ob >> 9) & 1) << 5)); }
__host__ __device__ __forceinline__ void stage_rc(int b, int& R, int& C) { const int st = b / 1024, sb = b % 1024, swz = sb ^ (((sb >> 9) & 1) << 5); R = (st >> 1) * 16 + swz / 64; C = (st & 1) * 32 + (swz % 64) / 2; }
__host__ __device__ __forceinline__ int perm32(int rho) { const int n = rho >> 4, i = rho & 15; return 8 * (i >> 2) + 4 * n + (i & 3); }
struct Unit { int pm, pn, z; };

struct SchedWide {
    const bf16_t* A; const bf16_t* Bt; int K, nM, nN, nwg, xpm, xn, G, c;
    __device__ bool next(int i, Unit& u) const {
        long L = (long)i * G + c;
        if (L < nwg) {
            int wgid = (int)L; { const int q = nwg / NXCD, r = nwg % NXCD, xcd = wgid % NXCD, off = wgid / NXCD; wgid = (xcd < r ? xcd * (q + 1) : r * (q + 1) + (xcd - r) * q) + off; }
            const int nig = WGM * nN, gid = wgid / nig, fm = gid * WGM, gsz = (nM - fm) < WGM ? (nM - fm) : WGM;
            u.pm = fm + ((wgid % nig) % gsz); u.pn = (wgid % nig) / gsz; u.z = 0; return true;
        }
        L -= nwg; if (L < xn) { u.pm = xpm; u.pn = (int)L; u.z = 0; return true; }
        return false;
    }
    __device__ __forceinline__ int nt(const Unit&) const { return K / BK; }
    __device__ __forceinline__ const char* aptr(const Unit& u) const { return (const char*)A + (size_t)u.pm * BM * K * 2; }
    __device__ __forceinline__ const char* bptr(const Unit& u) const { return (const char*)Bt + (size_t)u.pn * BM * K * 2; }
};
struct SchedNarrow {
    const bf16_t* A; const bf16_t* Bt; int K, nM, ntiles, G, c;
    __device__ bool next(int i, Unit& u) const { const int t = i * G + c; if (t >= ntiles) return false; u.pm = t % nM; u.pn = t / nM; u.z = 0; return true; }
    __device__ __forceinline__ int nt(const Unit&) const { return K / BK; }
    __device__ __forceinline__ const char* aptr(const Unit& u) const { return (const char*)A + (size_t)u.pm * BM * K * 2; }
    __device__ __forceinline__ const char* bptr(const Unit& u) const { return (const char*)Bt + (size_t)u.pn * BM * K * 2; }
};
struct SchedNarrowZ {
    const bf16_t* A; const bf16_t* Bt; int K, nM, ntiles, G, c, nz, ksl;
    __device__ bool next(int i, Unit& u) const {
        int t = i * G + c;
        if (t < ntiles) { u.pm = t % nM; u.pn = t / nM; u.z = 0; return true; }
        t -= ntiles; if (t >= nz) return false;
        u.pm = 32; u.pn = t & 7; u.z = 1 + (t >> 3); return true;
    }
    __device__ __forceinline__ int nt(const Unit& u) const { return (u.z ? ksl : K) / BK; }
    __device__ __forceinline__ const char* aptr(const Unit& u) const { return (const char*)A + (size_t)u.pm * BM * K * 2 + (u.z ? (size_t)(u.z - 1) * ksl * 2 : (size_t)0); }
    __device__ __forceinline__ const char* bptr(const Unit& u) const { return (const char*)Bt + (size_t)u.pn * BM * K * 2 + (u.z ? (size_t)(u.z - 1) * ksl * 2 : (size_t)0); }
};
struct SchedBranch {
    const bf16_t* A; const bf16_t* Bt; int K, nM, ntiles, G, c; size_t strideA, strideB;
    __device__ bool next(int i, Unit& u) const { const int t = (i >> 2) * G + c; if (t >= ntiles) return false; u.pm = t % nM; u.pn = t / nM; u.z = i & 3; return true; }
    __device__ __forceinline__ int nt(const Unit&) const { return K / BK; }
    __device__ __forceinline__ const char* aptr(const Unit& u) const { return (const char*)(A + (size_t)u.z * strideA) + (size_t)u.pm * BM * K * 2; }
    __device__ __forceinline__ const char* bptr(const Unit& u) const { return (const char*)(Bt + (size_t)u.z * strideB) + (size_t)u.pn * BM * K * 2; }
};
struct SchedDual {
    const bf16_t* A0; const bf16_t* B0; const bf16_t* A1; const bf16_t* B1; int K, nM0, n0, nM1, n1, G, c;
    __device__ bool next(int i, Unit& u) const {
        int L = i * G + c;
        if (L < n0) { u.z = 0; u.pm = L % nM0; u.pn = L / nM0; return true; }
        L -= n0; if (L >= n1) return false;
        u.z = 1; u.pm = L % nM1; u.pn = L / nM1; return true;
    }
    __device__ __forceinline__ int nt(const Unit&) const { return K / BK; }
    __device__ __forceinline__ const char* aptr(const Unit& u) const { return (const char*)(u.z ? A1 : A0) + (size_t)u.pm * BM * K * 2; }
    __device__ __forceinline__ const char* bptr(const Unit& u) const { return (const char*)(u.z ? B1 : B0) + (size_t)u.pn * BM * K * 2; }
};

__device__ __forceinline__ float gelu_tanh(float x) { const float t = 1.5957691216057308f * (x + 0.044715f * x * x * x); return x / (1.f + __expf(-t)); }
__device__ __forceinline__ float sigmoidf(float x) { return 1.f / (1.f + __expf(-x)); }

struct EpiAct {
    static constexpr bool PERM = true;
    __device__ __forceinline__ bool zero_after(const Unit&) const { return true; }
    bf16_t* O0; int ld0; bf16_t* O1; int ld1; const float* bias; int bias_col0; int gelu_lo, sig_lo; int fixed_act;
    __device__ __forceinline__ void operator()(f32x4 (&acc)[2][2][4][2], const Unit& u, int wr, int wc, int fr, int fq) const {
        bf16_t* base = u.z ? O1 : O0; const int ldc = u.z ? ld1 : ld0;
        const bool hsplit = u.z && ld1 == 0;
        const int act = fixed_act >= 0 ? fixed_act : (u.pn >= sig_lo ? 2 : (u.pn >= gelu_lo ? 1 : 0));
        const int row0 = u.pm * BM + wr * 64 + fr, col0 = u.pn * BM + wc * 32 + 8 * fq;
#pragma unroll
        for (int bj = 0; bj < 2; ++bj) {
            f32x4 b0 = (f32x4){0.f, 0.f, 0.f, 0.f}, b1 = b0;
            if (act == 2) { b0 = *(const f32x4*)(bias + (col0 + bj * HALF - bias_col0)); b1 = *(const f32x4*)(bias + (col0 + bj * HALF - bias_col0 + 4)); }
#pragma unroll
            for (int ai = 0; ai < 2; ++ai)
#pragma unroll
                for (int m = 0; m < 4; ++m) {
                    f32x4 v0 = acc[ai][bj][m][0], v1 = acc[ai][bj][m][1];
                    if (act == 1) {
#pragma unroll
                        for (int j = 0; j < 4; ++j) { v0[j] = gelu_tanh(v0[j]); v1[j] = gelu_tanh(v1[j]); }
                    } else if (act == 2) {
#pragma unroll
                        for (int j = 0; j < 4; ++j) { v0[j] = sigmoidf(v0[j] + b0[j]); v1[j] = sigmoidf(v1[j] + b1[j]); }
                    } else if (act == 3) {
#pragma unroll
                        for (int j = 0; j < 4; ++j) { float a = fmaxf(v0[j], 0.f), b = fmaxf(v1[j], 0.f); v0[j] = a * a; v1[j] = b * b; }
                    }
                    u32x4 w; w.x = cvt_pk_bf16(v0[0], v0[1]); w.y = cvt_pk_bf16(v0[2], v0[3]); w.z = cvt_pk_bf16(v1[0], v1[1]); w.w = cvt_pk_bf16(v1[2], v1[3]);
                    if (hsplit) *(u32x4*)(base + ((size_t)(bj * 8 + u.pn) * TALL + (row0 + ai * HALF + m * 16)) * 128 + wc * 32 + 8 * fq) = w;
                    else *(u32x4*)(base + (size_t)(row0 + ai * HALF + m * 16) * ldc + col0 + bj * HALF) = w;
                }
        }
    }
};
struct EpiGate {
    static constexpr bool PERM = true;
    const bf16_t* P; bf16_t* MG;
    __device__ __forceinline__ bool zero_after(const Unit& u) const { return u.z == 3; }
    __device__ __forceinline__ void operator()(f32x4 (&acc)[2][2][4][2], const Unit& u, int wr, int wc, int fr, int fq) const {
        const int row0 = u.pm * BM + wr * 64 + fr, col0 = u.pn * BM + wc * 32 + 8 * fq; const int z = u.z;
        const bf16_t* gbase = P + (size_t)row0 * NINP + P_G + z * DM + col0;
#pragma unroll
        for (int ai = 0; ai < 2; ++ai) {
            bf16x8 g[4][2], gn[4][2];
#pragma unroll
            for (int m = 0; m < 4; ++m)
#pragma unroll
                for (int bj = 0; bj < 2; ++bj) {
                    const bf16_t* gp = gbase + (size_t)(ai * HALF + m * 16) * NINP + bj * HALF;
                    g[m][bj] = *(const bf16x8*)gp; gn[m][bj] = *(const bf16x8*)(gp + (z < 3 ? DM : 0)); }
            asm volatile("" ::: "memory");
#pragma unroll
            for (int m = 0; m < 4; ++m)
#pragma unroll
                for (int bj = 0; bj < 2; ++bj) {
                    if (z < 3) {
#pragma unroll
                        for (int j = 0; j < 4; ++j) {
                            acc[ai][bj][m][0][j] *= fmaxf(bf2f_s(g[m][bj][j]), 1e-18f) * __builtin_amdgcn_rcpf(fmaxf(bf2f_s(gn[m][bj][j]), 1e-18f));
                            acc[ai][bj][m][1][j] *= fmaxf(bf2f_s(g[m][bj][4 + j]), 1e-18f) * __builtin_amdgcn_rcpf(fmaxf(bf2f_s(gn[m][bj][4 + j]), 1e-18f)); }
                    } else {
                        f32x4 v0 = acc[ai][bj][m][0], v1 = acc[ai][bj][m][1];
#pragma unroll
                        for (int j = 0; j < 4; ++j) { v0[j] *= fmaxf(bf2f_s(g[m][bj][j]), 1e-18f); v1[j] *= fmaxf(bf2f_s(g[m][bj][4 + j]), 1e-18f); }
                        u32x4 w; w.x = cvt_pk_bf16(v0[0], v0[1]); w.y = cvt_pk_bf16(v0[2], v0[3]); w.z = cvt_pk_bf16(v1[0], v1[1]); w.w = cvt_pk_bf16(v1[2], v1[3]);
                        *(u32x4*)(MG + (size_t)(row0 + ai * HALF + m * 16) * DM + col0 + bj * HALF) = w;
                    }
                }
        }
    }
};
struct EpiRes {
    static constexpr bool PERM = false;
    __device__ __forceinline__ bool zero_after(const Unit&) const { return true; }
    const float* basex; const float* basez; float* out; const float* gx; const float* gz; int zpm; float* slab;
    __device__ __forceinline__ void operator()(f32x4 (&acc)[2][2][4][2], const Unit& u, int wr, int wc, int fr, int fq) const {
        if (u.z) {
            float* o = slab + (size_t)(u.z - 1) * BM * DM; const int col0 = u.pn * BM + wc * 32 + 4 * fq;
#pragma unroll
            for (int bj = 0; bj < 2; ++bj)
#pragma unroll
                for (int n = 0; n < 2; ++n)
#pragma unroll
                    for (int ai = 0; ai < 2; ++ai)
#pragma unroll
                        for (int m = 0; m < 4; ++m) *(f32x4*)(o + (size_t)(ai * HALF + wr * 64 + m * 16 + fr) * DM + col0 + bj * HALF + n * 16) = acc[ai][bj][m][n];
            return;
        }
        const bool isz = (u.pm == zpm);
        const float* base = isz ? basez : basex + (size_t)u.pm * BM * DM; const float* gv = isz ? gz : gx;
        float* o = out + (size_t)u.pm * BM * DM;
        const int col0 = u.pn * BM + wc * 32 + 4 * fq;
#pragma unroll
        for (int bj = 0; bj < 2; ++bj)
#pragma unroll
            for (int n = 0; n < 2; ++n) {
                const int col = col0 + bj * HALF + n * 16; const f32x4 g4 = *(const f32x4*)(gv + col);
#pragma unroll
                for (int ai = 0; ai < 2; ++ai)
#pragma unroll
                    for (int m = 0; m < 4; ++m) {
                        const size_t off = (size_t)(ai * HALF + wr * 64 + m * 16 + fr) * DM + col;
                        const f32x4 bs = *(const f32x4*)(base + off);
                        *(f32x4*)(o + off) = bs + g4 * acc[ai][bj][m][n];
                    }
            }
    }
};

template <class Epi, class Sched, bool ALIGN_EPI = false, bool SP2 = false>
__device__ __forceinline__ void gemm_phase(LAS unsigned char* lds, const int K, const Sched& S, const Epi& E) {
    int tid_ = threadIdx.x; asm volatile("" : "+v"(tid_));
    const int tid = tid_, wid = __builtin_amdgcn_readfirstlane(tid >> 6), lane = tid & 63, wr = wid >> 2, wc = wid & 3, fr = lane & 15, fq = lane >> 4;
    unsigned voffA[2], voffB[2];
#pragma unroll
    for (int i = 0; i < 2; ++i) { int R, C; stage_rc(tid * 16 + i * 8192, R, C); const int Rb = Epi::PERM ? ((R & ~31) + perm32(R & 31)) : R;
        voffA[i] = (unsigned)(R * K + C) * 2u; voffB[i] = (unsigned)(Rb * K + C) * 2u; }
    const size_t kstep = (size_t)(BK * 2);
    const size_t hstep = (size_t)HALF * K * 2;
    const unsigned ldsw = (unsigned)wid * 1024u;
    const int aoff = lds_byte(wr * 64 + fr, fq * 8), boff = lds_byte(wc * 32 + fr, fq * 8);
#define PG8_SA(b, h) (((b) * 2 + (h)) * HTB)
#define PG8_SB(b, h) ((4 + (b) * 2 + (h)) * HTB)
#define PG8_STAGE(bufoff, gbase, voff) do { _Pragma("unroll") for (int _i = 0; _i < 2; ++_i) \
        __builtin_amdgcn_global_load_lds((const unsigned*)((const char*)(gbase) + (voff)[_i]), (LAS unsigned*)(lds + (bufoff) + ldsw + _i * 8192), 16, 0, 0); } while (0)
#define PG8_LDA(dst, b, h) do { _Pragma("unroll") for (int m = 0; m < 4; ++m) _Pragma("unroll") for (int k = 0; k < 2; ++k) dst[m][k] = *(const LAS bf16x8*)(lds + PG8_SA(b, h) + aoff + m * 2048 + k * 1024); } while (0)
#define PG8_LDB(dst, b, h) do { _Pragma("unroll") for (int n = 0; n < 2; ++n) _Pragma("unroll") for (int k = 0; k < 2; ++k) dst[n][k] = *(const LAS bf16x8*)(lds + PG8_SB(b, h) + boff + n * 2048 + k * 1024); } while (0)
#define PG8_MMA(ai, bj, At, Bt) do { __builtin_amdgcn_s_setprio(1); _Pragma("unroll") for (int m = 0; m < 4; ++m) _Pragma("unroll") for (int n = 0; n < 2; ++n) _Pragma("unroll") for (int k = 0; k < 2; ++k) \
        acc[ai][bj][m][n] = __builtin_amdgcn_mfma_f32_16x16x32_bf16(Bt[n][k], At[m][k], acc[ai][bj][m][n], 0, 0, 0); __builtin_amdgcn_s_setprio(0); } while (0)
#define PG8_WAIT_V(n) asm volatile("s_waitcnt vmcnt(" #n ")" ::: "memory")
#define PG8_WAIT_L(n) asm volatile("s_waitcnt lgkmcnt(" #n ")" ::: "memory")
#define PG8_BAR __builtin_amdgcn_s_barrier()
#define PG8_SCHED __builtin_amdgcn_sched_barrier(0)
    Unit cur, nxt; int ui = 0;
    if (!S.next(0, cur)) return;
    int nt = S.nt(cur);
    f32x4 acc[2][2][4][2];
#pragma unroll
    for (int a = 0; a < 2; ++a)
#pragma unroll
        for (int b = 0; b < 2; ++b)
#pragma unroll
            for (int m = 0; m < 4; ++m)
#pragma unroll
                for (int n = 0; n < 2; ++n) acc[a][b][m][n] = (f32x4){0.f, 0.f, 0.f, 0.f};
    bf16x8 At[4][2], B0[2][2], B1[2][2];
    const char* cA = S.aptr(cur); const char* cB = S.bptr(cur);
    if constexpr (SP2) {
        PG8_STAGE(PG8_SB(0, 0), cB, voffB); PG8_STAGE(PG8_SB(0, 1), cB + hstep, voffB); PG8_STAGE(PG8_SA(0, 0), cA, voffA); PG8_STAGE(PG8_SA(0, 1), cA + hstep, voffA);
        if (wr == 1) PG8_BAR;
        PG8_WAIT_V(2); PG8_BAR;
        PG8_STAGE(PG8_SB(1, 0), cB + kstep, voffB); PG8_STAGE(PG8_SA(1, 0), cA + kstep, voffA); PG8_STAGE(PG8_SB(1, 1), cB + hstep + kstep, voffB);
        PG8_WAIT_V(6); PG8_BAR;
    } else {
        PG8_STAGE(PG8_SB(0, 0), cB, voffB); PG8_STAGE(PG8_SA(0, 0), cA, voffA); PG8_STAGE(PG8_SB(0, 1), cB + hstep, voffB); PG8_STAGE(PG8_SA(0, 1), cA + hstep, voffA);
        if (wr == 1) PG8_BAR;
        PG8_WAIT_V(4); PG8_BAR;
        PG8_STAGE(PG8_SB(1, 0), cB + kstep, voffB); PG8_STAGE(PG8_SA(1, 0), cA + kstep, voffA); PG8_STAGE(PG8_SB(1, 1), cB + hstep + kstep, voffB);
        PG8_WAIT_V(6); PG8_BAR;
    }
    for (;;) {
        const bool has_next = S.next(ui + 1, nxt);
        const char* nA = has_next ? S.aptr(nxt) : cA; const char* nB = has_next ? S.bptr(nxt) : cB;
        for (int t = 0; t < nt; t += 2) {
            const bool last = (t == nt - 2);
            const char* a1 = cA + (size_t)(t + 1) * kstep;
            const char* a2 = last ? nA : cA + (size_t)(t + 2) * kstep; const char* b2 = last ? nB : cB + (size_t)(t + 2) * kstep;
            const char* a3 = a2 + kstep; const char* b3 = b2 + kstep;
            if constexpr (SP2) {
            PG8_LDB(B0, 0, 0); PG8_LDB(B1, 0, 1); PG8_SCHED; PG8_LDA(At, 0, 0); PG8_STAGE(PG8_SA(1, 1), a1 + hstep, voffA);
            PG8_WAIT_V(8); PG8_WAIT_L(0); PG8_BAR; PG8_MMA(0, 0, At, B0); PG8_MMA(0, 1, At, B1); PG8_BAR; PG8_SCHED;
            PG8_LDA(At, 0, 1); PG8_STAGE(PG8_SB(0, 0), b2, voffB); PG8_STAGE(PG8_SB(0, 1), b2 + hstep, voffB); PG8_STAGE(PG8_SA(0, 0), a2, voffA);
            PG8_WAIT_V(8); PG8_WAIT_L(0); PG8_BAR; PG8_MMA(1, 0, At, B0); PG8_MMA(1, 1, At, B1); PG8_BAR; PG8_SCHED;
            PG8_LDB(B0, 1, 0); PG8_LDB(B1, 1, 1); PG8_SCHED; PG8_LDA(At, 1, 0); PG8_STAGE(PG8_SA(0, 1), a2 + hstep, voffA);
            PG8_WAIT_V(8); PG8_WAIT_L(0); PG8_BAR; PG8_MMA(0, 0, At, B0); PG8_MMA(0, 1, At, B1); PG8_BAR; PG8_SCHED;
            PG8_LDA(At, 1, 1); PG8_STAGE(PG8_SB(1, 0), b3, voffB); PG8_STAGE(PG8_SB(1, 1), b3 + hstep, voffB); PG8_STAGE(PG8_SA(1, 0), a3, voffA);
            PG8_WAIT_V(8); PG8_WAIT_L(0); PG8_BAR; PG8_MMA(1, 0, At, B0); PG8_MMA(1, 1, At, B1); PG8_BAR; PG8_SCHED;
            } else {
            PG8_LDB(B0, 0, 0); PG8_SCHED; PG8_LDA(At, 0, 0); PG8_STAGE(PG8_SA(1, 1), a1 + hstep, voffA);
            PG8_WAIT_L(8); PG8_BAR; PG8_WAIT_L(0); PG8_MMA(0, 0, At, B0); PG8_BAR; PG8_SCHED;
            PG8_LDB(B1, 0, 1); PG8_STAGE(PG8_SB(0, 0), b2, voffB);
            PG8_BAR; PG8_WAIT_L(0); PG8_MMA(0, 1, At, B1); PG8_BAR;
            PG8_LDA(At, 0, 1); PG8_STAGE(PG8_SA(0, 0), a2, voffA);
            PG8_BAR; PG8_WAIT_L(0); PG8_MMA(1, 0, At, B0); PG8_BAR; PG8_SCHED;
            PG8_STAGE(PG8_SB(0, 1), b2 + hstep, voffB);
            PG8_WAIT_V(6); PG8_BAR; PG8_MMA(1, 1, At, B1); PG8_BAR;
            PG8_LDB(B0, 1, 0); PG8_SCHED; PG8_LDA(At, 1, 0); PG8_STAGE(PG8_SA(0, 1), a2 + hstep, voffA);
            PG8_WAIT_L(8); PG8_BAR; PG8_WAIT_L(0); PG8_MMA(0, 0, At, B0); PG8_BAR; PG8_SCHED;
            PG8_LDB(B1, 1, 1); PG8_STAGE(PG8_SB(1, 0), b3, voffB);
            PG8_BAR; PG8_WAIT_L(0); PG8_MMA(0, 1, At, B1); PG8_BAR;
            PG8_LDA(At, 1, 1); PG8_STAGE(PG8_SA(1, 0), a3, voffA);
            PG8_BAR; PG8_WAIT_L(0); PG8_MMA(1, 0, At, B0); PG8_BAR; PG8_SCHED;
            PG8_STAGE(PG8_SB(1, 1), b3 + hstep, voffB);
            PG8_WAIT_V(6); PG8_BAR; PG8_MMA(1, 1, At, B1); PG8_BAR;
            }
        }
        if constexpr (ALIGN_EPI) { if (wr == 0) PG8_BAR; }
        E(acc, cur, wr, wc, fr, fq);
        if (!has_next) break;
        if (E.zero_after(cur)) {
#pragma unroll
        for (int a = 0; a < 2; ++a)
#pragma unroll
            for (int b = 0; b < 2; ++b)
#pragma unroll
                for (int m = 0; m < 4; ++m)
#pragma unroll
                    for (int n = 0; n < 2; ++n) acc[a][b][m][n] = (f32x4){0.f, 0.f, 0.f, 0.f};
        }
        cur = nxt; cA = nA; cB = nB; ++ui; nt = S.nt(cur);
        if constexpr (ALIGN_EPI) { if (wr == 1) PG8_BAR; }
    }
    PG8_WAIT_V(0);
    if constexpr (!ALIGN_EPI) { if (wr == 0) PG8_BAR; }
    PG8_BAR;
#undef PG8_SA
#undef PG8_SB
#undef PG8_STAGE
#undef PG8_LDA
#undef PG8_LDB
#undef PG8_MMA
#undef PG8_WAIT_V
#undef PG8_WAIT_L
#undef PG8_BAR
#undef PG8_SCHED
}
}

namespace att {
constexpr int NW = 8, QBLK = 32, KVBLK = 64;
constexpr float THR = 8.f;
constexpr size_t SHM_V = KVBLK * 128 * 2;
#define SBAR() __builtin_amdgcn_sched_barrier(0)
__device__ __forceinline__ int crow(int r, int hi) { return (r & 3) + 8 * (r >> 2) + 4 * hi; }
__device__ __forceinline__ unsigned cvtpk(float lo, float hi) { unsigned r; asm volatile("v_cvt_pk_bf16_f32 %0, %1, %2" : "=v"(r) : "v"(lo), "v"(hi)); return r; }

template <int DQ> __device__ __forceinline__ void partialSM(f32x16& p0, f32x16& p1, float& m_reg, float& mn, float& alpha) {
  constexpr float SCALE = (DQ == 128) ? 0.088388347648318440f : 0.072168783648703220f;
  constexpr float C = SCALE * 1.4426950408889634f;
  float pmax = p0[0];
#pragma unroll
  for (int r = 1; r < 16; ++r) pmax = fmaxf(pmax, p0[r]);
#pragma unroll
  for (int r = 0; r < 16; ++r) pmax = fmaxf(pmax, p1[r]);
  { auto rr = __builtin_amdgcn_permlane32_swap(__float_as_uint(pmax), __float_as_uint(pmax), false, false);
    pmax = fmaxf(__uint_as_float(rr[0]), __uint_as_float(rr[1])); }
  if (__builtin_expect(__all(pmax - m_reg <= THR / SCALE), 1)) { mn = m_reg; alpha = 1.f; }
  else { mn = fmaxf(m_reg, pmax); alpha = __builtin_amdgcn_exp2f((m_reg - mn) * C); m_reg = mn; }
  float mnC = -mn * C;
#pragma unroll
  for (int r = 0; r < 16; ++r) p0[r] = fmaf(p0[r], C, mnC);
#pragma unroll
  for (int r = 0; r < 16; ++r) p1[r] = fmaf(p1[r], C, mnC);
#pragma unroll
  for (int r = 0; r < 16; ++r) p0[r] = __builtin_amdgcn_exp2f(p0[r]);
}
__device__ __forceinline__ void finishSM(f32x16& p0, f32x16& p1, float alpha, float& l_reg, bf16x8& pa0, bf16x8& pa1, bf16x8& pa2, bf16x8& pa3) {
#pragma unroll
  for (int r = 0; r < 16; ++r) p1[r] = __builtin_amdgcn_exp2f(p1[r]);
  float ps = 0;
#pragma unroll
  for (int r = 0; r < 16; ++r) ps += p0[r];
#pragma unroll
  for (int r = 0; r < 16; ++r) ps += p1[r];
  { auto rr = __builtin_amdgcn_permlane32_swap(__float_as_uint(ps), __float_as_uint(ps), false, false);
    ps = __uint_as_float(rr[0]) + __uint_as_float(rr[1]); }
  l_reg = l_reg * alpha + ps;
#define PK4(P, BASE, OUT) do { unsigned a0 = cvtpk(P[BASE + 0], P[BASE + 1]), a1 = cvtpk(P[BASE + 2], P[BASE + 3]);   \
    unsigned b0 = cvtpk(P[BASE + 4], P[BASE + 5]), b1 = cvtpk(P[BASE + 6], P[BASE + 7]);                              \
    auto r0 = __builtin_amdgcn_permlane32_swap(a0, b0, false, false); auto r1 = __builtin_amdgcn_permlane32_swap(a1, b1, false, false); \
    u32x4 w = {r0[0], r1[0], r0[1], r1[1]}; OUT = *reinterpret_cast<bf16x8*>(&w); } while (0)
  PK4(p0, 0, pa0); PK4(p0, 8, pa1); PK4(p1, 0, pa2); PK4(p1, 8, pa3);
#undef PK4
}
template <int DQ> __device__ __forceinline__ int kswz(int row, int colB) { return row * (DQ * 2 + 16) + colB; }
template <int DQ> __device__ __forceinline__ void qkt(f32x16& p0, f32x16& p1, const char* Ks, const bf16x8* qr, const char* qx, const int kb) {
  p0 = f32x16{}; p1 = f32x16{};
#pragma unroll
  for (int d0 = 0; d0 < DQ / 16; ++d0) {
    bf16x8 b0 = *reinterpret_cast<const bf16x8*>(Ks + kb + d0 * 32);
    bf16x8 b1 = *reinterpret_cast<const bf16x8*>(Ks + kb + d0 * 32 + 32 * (DQ * 2 + 16));
    bf16x8 q; if (d0 < 8) q = qr[d0]; else q = *reinterpret_cast<const bf16x8*>(qx + (d0 - 8) * 1024);
    p0 = __builtin_amdgcn_mfma_f32_32x32x16_bf16(b0, q, p0, 0, 0, 0);
    p1 = __builtin_amdgcn_mfma_f32_32x32x16_bf16(b1, q, p1, 0, 0, 0); }
}
__device__ __forceinline__ int v_st(int k, int c) { const int kk = (k & ~0xC) | ((k & 4) << 1) | ((k & 8) >> 1); return ((kk >> 3) * 4 + (c >> 5)) * 512 + ((kk & 7) * 32 + (c & 31)) * 2; }
__device__ __forceinline__ int v_rd_base(int lane) { return ((lane & 3) << 3) | (((lane >> 2) & 3) << 6) | (((lane >> 4) & 1) << 5) | (((lane >> 5) & 1) << 8); }
constexpr int v_rd_off(int d0, int ks, int half) { return d0 * 512 + ks * 4096 + half * 2048; }
template <int OFF> __device__ __forceinline__ s16x4 tr_read(int vb) {
  s16x4 r; asm volatile("ds_read_b64_tr_b16 %0, %1 offset:%2" : "=&v"(r) : "v"(vb), "i"(OFF) : "memory"); return r;
}
template <int D0> __device__ __forceinline__ void pv_one(f32x16& od, int vb, bf16x8 pa0, bf16x8 pa1, bf16x8 pa2, bf16x8 pa3) {
  const s16x4 l0 = tr_read<v_rd_off(D0, 0, 0)>(vb), h0 = tr_read<v_rd_off(D0, 0, 1)>(vb), l1 = tr_read<v_rd_off(D0, 1, 0)>(vb), h1 = tr_read<v_rd_off(D0, 1, 1)>(vb);
  const s16x4 l2 = tr_read<v_rd_off(D0, 2, 0)>(vb), h2 = tr_read<v_rd_off(D0, 2, 1)>(vb), l3 = tr_read<v_rd_off(D0, 3, 0)>(vb), h3 = tr_read<v_rd_off(D0, 3, 1)>(vb);
  asm volatile("s_waitcnt lgkmcnt(0)" ::: "memory"); SBAR();
#define PK(L, H) (bf16x8){L[0], L[1], L[2], L[3], H[0], H[1], H[2], H[3]}
  od = __builtin_amdgcn_mfma_f32_32x32x16_bf16(pa0, PK(l0, h0), od, 0, 0, 0);
  od = __builtin_amdgcn_mfma_f32_32x32x16_bf16(pa1, PK(l1, h1), od, 0, 0, 0);
  od = __builtin_amdgcn_mfma_f32_32x32x16_bf16(pa2, PK(l2, h2), od, 0, 0, 0);
  od = __builtin_amdgcn_mfma_f32_32x32x16_bf16(pa3, PK(l3, h3), od, 0, 0, 0);
#undef PK
}
__device__ __forceinline__ void pv_d0(f32x16* o, int vb, bf16x8 pa0, bf16x8 pa1, bf16x8 pa2, bf16x8 pa3) {
  pv_one<0>(o[0], vb, pa0, pa1, pa2, pa3); pv_one<1>(o[1], vb, pa0, pa1, pa2, pa3); pv_one<2>(o[2], vb, pa0, pa1, pa2, pa3); pv_one<3>(o[3], vb, pa0, pa1, pa2, pa3);
}

template <int DQ, int ldq, int ldk0, int ldk1, int ldv, int ldo>
__device__ __forceinline__ void attn_body(const bf16_t* __restrict__ Qb, const bf16_t* __restrict__ K0, const bf16_t* __restrict__ K1,
                                          const bf16_t* __restrict__ Vh, bf16_t* __restrict__ Ob, int seq, char* lds, bool ropeq, int qpos0, const float2* __restrict__ tabC) {
  constexpr size_t SHM_K = KVBLK * (DQ * 2 + 16);
  int tid_ = threadIdx.x; asm volatile("" : "+v"(tid_));
  const int tid = tid_, wid = tid >> 6, lane = tid & 63, r32 = lane & 31, hi = lane >> 5;
  char* V_lds = lds; char* K_lds = lds + 2 * SHM_V;
  float* ws = (float*)(lds + 2 * SHM_V + 2 * SHM_K) + wid * 64; float* li_l = ws; float* al_l = ws + 32;
  float m_reg = -1e30f, l_reg = 0; f32x16 o[4] = {}; bf16x8 qr[8];
  const bf16_t* Qw = Qb + (long)(wid * QBLK + r32) * ldq + hi * 8;
#pragma unroll
  for (int d0 = 0; d0 < 8; ++d0) qr[d0] = *reinterpret_cast<const bf16x8*>(Qw + d0 * 16);
  char* qx = lds + 2 * SHM_V + 2 * SHM_K + 2048 + wid * 4096 + lane * 16;
  if constexpr (DQ == 192) {
    const int t = qpos0 + wid * QBLK + r32;
#pragma unroll
    for (int ax = 0; ax < 2; ++ax) {
      const int pos = ax ? (t & 63) : (t >> 6); const float2* tb = tabC + pos * 16 + hi * 8;
      bf16x8 a = *reinterpret_cast<const bf16x8*>(Qw + (8 + 2 * ax) * 16), b = *reinterpret_cast<const bf16x8*>(Qw + (9 + 2 * ax) * 16);
      if (ropeq) {
#pragma unroll
        for (int j = 0; j < 8; ++j) { const float2 cs = tb[j]; const float x1 = bf2f_s(a[j]), x2 = bf2f_s(b[j]);
          a[j] = (short)f2bf(x1 * cs.x - x2 * cs.y); b[j] = (short)f2bf(x1 * cs.y + x2 * cs.x); }
      }
      *reinterpret_cast<bf16x8*>(qx + (2 * ax) * 1024) = a; *reinterpret_cast<bf16x8*>(qx + (2 * ax + 1) * 1024) = b;
    }
  }
  const int kb = kswz<DQ>(r32, hi * 16);
  const int sr = tid >> 4, sc = (tid & 15) * 8, vst0 = v_st(sr, sc), vst1 = v_st(32 + sr, sc);
  const int sr2 = tid >> 3, sc2 = (tid & 7) * 8;
  const int vb0 = (int)(uintptr_t)V_lds + v_rd_base(lane);
  struct { bf16x8 vs0, vs1, ks0, ks1, ks2; } sr_[1];
#define SLOAD(i, k0) do { sr_[i].vs0 = *(const bf16x8*)(&Vh[(long)((k0) + sr) * ldv + sc]); sr_[i].vs1 = *(const bf16x8*)(&Vh[(long)((k0) + 32 + sr) * ldv + sc]); \
    sr_[i].ks0 = *(const bf16x8*)(&K0[(long)((k0) + sr) * ldk0 + sc]); sr_[i].ks1 = *(const bf16x8*)(&K0[(long)((k0) + 32 + sr) * ldk0 + sc]); \
    if constexpr (DQ == 192) sr_[i].ks2 = *(const bf16x8*)(&K1[(long)((k0) + sr2) * ldk1 + sc2]); } while (0)
#define SWRITE(b, i) do { *(bf16x8*)(V_lds + (b) * SHM_V + vst0) = sr_[i].vs0;          \
    *(bf16x8*)(V_lds + (b) * SHM_V + vst1) = sr_[i].vs1; int kc = sc * 2;               \
    *(bf16x8*)(K_lds + (b) * SHM_K + kswz<DQ>(sr, kc)) = sr_[i].ks0;                       \
    *(bf16x8*)(K_lds + (b) * SHM_K + kswz<DQ>(32 + sr, kc)) = sr_[i].ks1;                  \
    if constexpr (DQ == 192) *(bf16x8*)(K_lds + (b) * SHM_K + kswz<DQ>(sr2, 256 + sc2 * 2)) = sr_[i].ks2; } while (0)
#define SWAIT() asm volatile("s_waitcnt vmcnt(0)" ::: "memory")
#define RESC(a) do { if (__any((a) < 1.f)) { if (hi == 0) al_l[r32] = (a); asm volatile("s_waitcnt lgkmcnt(0)" ::: "memory"); \
    _Pragma("unroll") for (int d = 0; d < 4; ++d) _Pragma("unroll") for (int r = 0; r < 16; ++r) o[d][r] *= al_l[crow(r, hi)]; } } while (0)
  f32x16 pA0, pA1, pB0, pB1; float mnA, mnB, alA, alB; bf16x8 pa0, pa1, pa2, pa3; const int NT = seq / KVBLK;
  SLOAD(0, 0); SWAIT(); SWRITE(0, 0); __syncthreads();
  qkt<DQ>(pA0, pA1, K_lds, qr, qx, kb); partialSM<DQ>(pA0, pA1, m_reg, mnA, alA);
  SLOAD(0, KVBLK);
  SWAIT(); SWRITE(1, 0); __syncthreads();
  for (int j = 1; j + 1 < NT; j += 2) {
    SBAR(); qkt<DQ>(pB0, pB1, K_lds + SHM_K, qr, qx, kb);
    finishSM(pA0, pA1, alA, l_reg, pa0, pa1, pa2, pa3); SBAR();
    SLOAD(0, (j + 1) * KVBLK); SBAR();
    pv_d0(o, vb0, pa0, pa1, pa2, pa3); partialSM<DQ>(pB0, pB1, m_reg, mnB, alB);
    __syncthreads(); SWAIT(); SWRITE(0, 0);
    RESC(alB); __syncthreads();
    SBAR(); qkt<DQ>(pA0, pA1, K_lds, qr, qx, kb);
    finishSM(pB0, pB1, alB, l_reg, pa0, pa1, pa2, pa3); SBAR();
    SLOAD(0, (j + 2) * KVBLK); SBAR();
    pv_d0(o, vb0 + (int)SHM_V, pa0, pa1, pa2, pa3); partialSM<DQ>(pA0, pA1, m_reg, mnA, alA);
    __syncthreads(); SWAIT(); SWRITE(1, 0);
    RESC(alA); __syncthreads();
  }
  SBAR(); qkt<DQ>(pB0, pB1, K_lds + SHM_K, qr, qx, kb);
  finishSM(pA0, pA1, alA, l_reg, pa0, pa1, pa2, pa3); SBAR();
  pv_d0(o, vb0, pa0, pa1, pa2, pa3); partialSM<DQ>(pB0, pB1, m_reg, mnB, alB);
  __syncthreads(); RESC(alB);
  finishSM(pB0, pB1, alB, l_reg, pa0, pa1, pa2, pa3); SBAR();
  pv_d0(o, vb0 + (int)SHM_V, pa0, pa1, pa2, pa3);
  if (hi == 0) li_l[r32] = l_reg; asm volatile("s_waitcnt lgkmcnt(0)" ::: "memory");
  float rli[16];
#pragma unroll
  for (int r = 0; r < 16; ++r) rli[r] = __builtin_amdgcn_rcpf(li_l[crow(r, hi)]);
  bf16_t* Ow = Ob + (long)(wid * QBLK) * ldo;
#pragma unroll
  for (int r = 0; r < 16; ++r) { int orow = crow(r, hi);
#pragma unroll
    for (int d0 = 0; d0 < 4; ++d0) Ow[(long)orow * ldo + d0 * 32 + r32] = (bf16_t)f2bf(o[d0][r] * rli[r]); }
  __syncthreads();
#undef SLOAD
#undef SWRITE
#undef SWAIT
#undef RESC
}
#undef SBAR
}


#define XB_TMO      128
#define XB_XCNT(j)  (256  + 64 * (j))
#define XB_XSUB(j)  (1280 + 64 * (j))
#define XB_XGEN(j)  (2304 + 64 * (j))
#define XB_TOP      3328
#define XB_TOPGEN   3392
#define XCD_BAR_WORDS 3456
#define XB_SPIN_CAP (1u << 20)
__device__ __forceinline__ unsigned xb_ld(unsigned* p)              { return __hip_atomic_load(p, __ATOMIC_RELAXED, __HIP_MEMORY_SCOPE_AGENT); }
__device__ __forceinline__ unsigned xb_add(unsigned* p, unsigned v) { return __hip_atomic_fetch_add(p, v, __ATOMIC_RELAXED, __HIP_MEMORY_SCOPE_AGENT); }
__device__ __forceinline__ unsigned xb_xcc_id() { return (unsigned)__builtin_amdgcn_s_getreg((3 << 11) | 20) & 0xFu; }
#define XB_SPIN(cond, bar) do { unsigned _sp = 0; while (cond) { __builtin_amdgcn_s_sleep(1); \
    if ((++_sp & 255u) == 0u) { if (xb_ld(&(bar)[XB_TMO])) break; if (_sp > XB_SPIN_CAP) { atomicAdd(&(bar)[XB_TMO], 1u); break; } } } } while (0)
struct XcdBarrier { unsigned* bar; unsigned x; volatile LAS unsigned* st; };
__device__ __forceinline__ XcdBarrier xcd_barrier_post(unsigned* bar, volatile LAS unsigned* st) {
    XcdBarrier b; b.bar = bar; b.x = xb_xcc_id(); b.st = st;
    if (threadIdx.x == 0) (void)xb_add(&bar[XB_XCNT(b.x)], 1u);
    return b;
}
__device__ __forceinline__ void xcd_barrier_complete(unsigned* bar, unsigned x, unsigned& nloc, unsigned& nx) {
    const unsigned G = gridDim.x * gridDim.y * gridDim.z;
    unsigned sum, cnt, mine, sp = 0u;
    for (;;) {
        sum = 0u; cnt = 0u; mine = 0u;
#pragma unroll
        for (unsigned j = 0; j < 16; ++j) { const unsigned c = xb_ld(&bar[XB_XCNT(j)]); sum += c; cnt += (c > 0u) ? 1u : 0u; mine = (j == x) ? c : mine; }
        if (sum == G) break;
        __builtin_amdgcn_s_sleep(1);
        if ((++sp & 255u) == 0u) { if (xb_ld(&bar[XB_TMO])) break; if (sp > XB_SPIN_CAP) { atomicAdd(&bar[XB_TMO], 1u); break; } }
    }
    nloc = mine > 0u ? mine : 1u; nx = cnt > 0u ? cnt : 1u;
}
__device__ __forceinline__ void xcd_barrier(const XcdBarrier& b) {
    asm volatile("s_waitcnt vmcnt(0)" ::: "memory");
    __syncthreads();
    if (threadIdx.x == 0) {
        unsigned* bar = b.bar;
        __builtin_amdgcn_s_waitcnt(0);
        unsigned nloc = b.st[0], nx = b.st[1];
        if (nloc == 0u) { xcd_barrier_complete(bar, b.x, nloc, nx); b.st[0] = nloc; b.st[1] = nx; }
        const unsigned old = xb_add(&bar[XB_XSUB(b.x)], 1u);
        const unsigned gen = old / nloc;
        if (old + 1u == (gen + 1u) * nloc) {
            __builtin_amdgcn_fence(__ATOMIC_RELEASE, "agent");
            asm volatile("s_waitcnt vmcnt(0)" ::: "memory");
            const unsigned og = xb_add(&bar[XB_TOP], 1u);
            const unsigned tg = og / nx;
            if (og + 1u == (tg + 1u) * nx) xb_add(&bar[XB_TOPGEN], 1u);
            else XB_SPIN(xb_ld(&bar[XB_TOPGEN]) == tg, bar);
            __builtin_amdgcn_fence(__ATOMIC_ACQUIRE, "agent");
            xb_add(&bar[XB_XGEN(b.x)], 1u);
            asm volatile("s_waitcnt vmcnt(0)" ::: "memory");
        } else {
            XB_SPIN(xb_ld(&bar[XB_XGEN(b.x)]) == gen, bar);
            __builtin_amdgcn_fence(__ATOMIC_ACQUIRE, "agent");
            asm volatile("s_waitcnt vmcnt(0)" ::: "memory");
        }
    }
    __syncthreads();
}

struct Params { const float* in[26]; float* out; unsigned char* ws; };
enum { I_X = 0, I_C, I_CTX, I_CCTX, I_WADA, I_BADA, I_NMIXG, I_WIN, I_BGATE, I_CONVW, I_QNG, I_KNG, I_MQNG, I_MKVNG, I_WUQ, I_WUKV, I_SLNG, I_SLNB,
       I_SWS, I_SBS, I_WBR, I_WOUT, I_NFFNG, I_WFF1, I_WFF2, I_FNG };

__device__ __forceinline__ void transpose_item(const float* W, int K, int N, bf16_t* WT, bool padmode, LAS float* scr, int item, int lane) {
    const int nblk = N / 64, kb = item / nblk, nb = item % nblk, k0 = 64 * kb, n0 = 64 * nb;
    const int lr = lane >> 4, lc = (lane & 15) * 4;
    f32x4 v[16];
#pragma unroll
    for (int i = 0; i < 16; ++i) v[i] = *(const f32x4*)(W + (size_t)(k0 + 4 * i + lr) * N + n0 + lc);
#pragma unroll
    for (int i = 0; i < 16; ++i) { LAS float* d = scr + (4 * i + lr) * 65 + lc; d[0] = v[i][0]; d[1] = v[i][1]; d[2] = v[i][2]; d[3] = v[i][3]; }
    asm volatile("s_waitcnt lgkmcnt(0)" ::: "memory");
    const int c = lane & 7; const int roff = (padmode && n0 >= 1088) ? 192 : 0;
#pragma unroll
    for (int j = 0; j < 8; ++j) { const int n = (lane >> 3) + 8 * j; const LAS float* s = scr + (8 * c) * 65 + n;
        u32x4 o; o.x = pk2(s[0 * 65], s[1 * 65]); o.y = pk2(s[2 * 65], s[3 * 65]); o.z = pk2(s[4 * 65], s[5 * 65]); o.w = pk2(s[6 * 65], s[7 * 65]);
        *(u32x4*)(WT + (size_t)(roff + n0 + n) * K + k0 + 8 * c) = o; }
    asm volatile("s_waitcnt lgkmcnt(0)" ::: "memory");
}

struct Post1 { const bf16_t* P; bf16_t *KB, *VBC, *CKVN, *KR, *QB, *CQN, *YS; float2* stats; const float2 *tabB, *tabC; };
template <bool FULL> __device__ __forceinline__ void post1_row(const Post1& A, const int t, const int lane, const float (&kn)[4], const float (&qn)[4], const float (&mk)[8], const float (&mq)[8], const float (&cwr)[3][16]) {
    const bf16_t* P = A.P; bf16_t *KB = A.KB, *VBC = A.VBC, *CKVN = A.CKVN, *KR = A.KR, *QB = A.QB, *CQN = A.CQN, *YS = A.YS; float2* stats = A.stats; const float2 *tabB = A.tabB, *tabC = A.tabC;
    const int li = lane & 31, hh = lane >> 5;
                const bool isz = t >= SEQ; const bf16_t* pr = P + (size_t)t * NINP;
                const int tlo = isz ? SEQ : 0, thi = isz ? TALL : SEQ; const bool hp = t > tlo, hn = t + 1 < thi;
                const float2 csr = tabB[(t >> 6) * 32 + li], csc = tabB[(t & 63) * 32 + li];
                const float2 csk = tabC[((lane & 16) ? (t & 63) : (t >> 6)) * 16 + (lane & 15)];
                bf16_t kbv[4], qbv[4][4], krv[2];
#pragma unroll
                for (int j = 0; j < 4; ++j) kbv[j] = pr[P_KB + hh * 128 + 32 * j + li];
                krv[0] = pr[P_KR + (li >> 4) * 32 + (li & 15)]; krv[1] = pr[P_KR + (li >> 4) * 32 + 16 + (li & 15)];
                const u32x2 vbv = *(const u32x2*)(pr + P_VB + lane * 4);
                const bf16x8 ckv = *(const bf16x8*)(pr + P_CKV + lane * 8);
                bf16x8 cqv, gb[2], gc[2], xa[2], gcp[2], xap[2], gcn[2], xan[2], sv[2];
                if constexpr (FULL) {
#pragma unroll
                    for (int it = 0; it < 4; ++it)
#pragma unroll
                        for (int j = 0; j < 4; ++j) qbv[it][j] = pr[P_QB + (it * 2 + hh) * 128 + 32 * j + li];
                    cqv = *(const bf16x8*)(pr + P_CQ + lane * 8);
#pragma unroll
                    for (int q = 0; q < 2; ++q) { const int c = lane * 16 + q * 8;
                        gb[q] = *(const bf16x8*)(pr + P_GB + c); gc[q] = *(const bf16x8*)(pr + P_GC + c); xa[q] = *(const bf16x8*)(pr + P_XA + c);
                        const bf16_t* pp = hp ? pr - NINP : pr; const bf16_t* pn = hn ? pr + NINP : pr;
                        gcp[q] = *(const bf16x8*)(pp + P_GC + c); xap[q] = *(const bf16x8*)(pp + P_XA + c);
                        gcn[q] = *(const bf16x8*)(pn + P_GC + c); xan[q] = *(const bf16x8*)(pn + P_XA + c);
                        sv[q] = *(const bf16x8*)(pr + P_V + c); }
                }
                { float y0 = bf2f(kbv[0]), y1 = bf2f(kbv[1]), y2 = bf2f(kbv[2]), y3 = bf2f(kbv[3]);
                  const float r = rsqrtf(half_sum(y0 * y0 + y1 * y1 + y2 * y2 + y3 * y3) * (1.f / 128.f) + EPS);
                  y0 *= r * kn[0]; y1 *= r * kn[1]; y2 *= r * kn[2]; y3 *= r * kn[3];
                  if (!isz) { const float a0 = y0 * csr.x - y1 * csr.y, a1 = y0 * csr.y + y1 * csr.x, a2 = y2 * csc.x - y3 * csc.y, a3 = y2 * csc.y + y3 * csc.x; y0 = a0; y1 = a1; y2 = a2; y3 = a3; }
                  bf16_t* d = KB + ((size_t)hh * TALL + t) * 128 + li; d[0] = (bf16_t)f2bf(y0); d[32] = (bf16_t)f2bf(y1); d[64] = (bf16_t)f2bf(y2); d[96] = (bf16_t)f2bf(y3); }
                *(u32x2*)(VBC + ((size_t)hh * TALL + t) * 128 + li * 4) = vbv;
                { float f[8], ss = 0.f;
#pragma unroll
                  for (int j = 0; j < 8; ++j) { f[j] = bf2f_s(ckv[j]); ss += f[j] * f[j]; }
                  const float r = rsqrtf(wave_sum(ss) * (1.f / 512.f) + EPS); u32x4 o;
                  o.x = pk2(f[0] * r * mk[0], f[1] * r * mk[1]); o.y = pk2(f[2] * r * mk[2], f[3] * r * mk[3]); o.z = pk2(f[4] * r * mk[4], f[5] * r * mk[5]); o.w = pk2(f[6] * r * mk[6], f[7] * r * mk[7]);
                  *(u32x4*)(CKVN + (size_t)t * 512 + lane * 8) = o; }
                if (lane < 32) { const int ax = lane >> 4, i = lane & 15; float x1 = bf2f(krv[0]), x2 = bf2f(krv[1]);
                  if (!isz) { const float a = x1 * csk.x - x2 * csk.y, b2 = x1 * csk.y + x2 * csk.x; x1 = a; x2 = b2; }
                  bf16_t* d = KR + (size_t)t * 64 + ax * 32 + i; d[0] = (bf16_t)f2bf(x1); d[16] = (bf16_t)f2bf(x2); }
                if constexpr (FULL) {
#pragma unroll
                    for (int it = 0; it < 4; ++it) { const int hd = it * 2 + hh; float y0 = bf2f(qbv[it][0]), y1 = bf2f(qbv[it][1]), y2 = bf2f(qbv[it][2]), y3 = bf2f(qbv[it][3]);
                      const float r = rsqrtf(half_sum(y0 * y0 + y1 * y1 + y2 * y2 + y3 * y3) * (1.f / 128.f) + EPS);
                      y0 *= r * qn[0]; y1 *= r * qn[1]; y2 *= r * qn[2]; y3 *= r * qn[3];
                      if (!isz) { const float a0 = y0 * csr.x - y1 * csr.y, a1 = y0 * csr.y + y1 * csr.x, a2 = y2 * csc.x - y3 * csc.y, a3 = y2 * csc.y + y3 * csc.x; y0 = a0; y1 = a1; y2 = a2; y3 = a3; }
                      bf16_t* d = QB + (size_t)t * 1024 + hd * 128 + li; d[0] = (bf16_t)f2bf(y0); d[32] = (bf16_t)f2bf(y1); d[64] = (bf16_t)f2bf(y2); d[96] = (bf16_t)f2bf(y3); }
                    { float f[8], ss = 0.f;
#pragma unroll
                      for (int j = 0; j < 8; ++j) { f[j] = bf2f_s(cqv[j]); ss += f[j] * f[j]; }
                      const float r = rsqrtf(wave_sum(ss) * (1.f / 512.f) + EPS); u32x4 o;
                      o.x = pk2(f[0] * r * mq[0], f[1] * r * mq[1]); o.y = pk2(f[2] * r * mq[2], f[3] * r * mq[3]); o.z = pk2(f[4] * r * mq[4], f[5] * r * mq[5]); o.w = pk2(f[6] * r * mq[6], f[7] * r * mq[7]);
                      *(u32x4*)(CQN + (size_t)t * 512 + lane * 8) = o; }
#pragma unroll
                    for (int q = 0; q < 2; ++q) { const int c = lane * 16 + q * 8; float y[8];
#pragma unroll
                        for (int j = 0; j < 8; ++j) { const float uc = bf2f_s(gc[q][j]) * bf2f_s(xa[q][j]); const float up = hp ? bf2f_s(gcp[q][j]) * bf2f_s(xap[q][j]) : 0.f; const float un = hn ? bf2f_s(gcn[q][j]) * bf2f_s(xan[q][j]) : 0.f;
                          y[j] = bf2f_s(gb[q][j]) * (cwr[0][q * 8 + j] * up + cwr[1][q * 8 + j] * uc + cwr[2][q * 8 + j] * un); }
                        u32x4 o; o.x = pk2(y[0], y[1]); o.y = pk2(y[2], y[3]); o.z = pk2(y[4], y[5]); o.w = pk2(y[6], y[7]);
                        *(u32x4*)(YS + (size_t)t * 1024 + c) = o; }
                    { float f[16], s = 0.f;
#pragma unroll
                      for (int j = 0; j < 8; ++j) { f[j] = bf2f_s(sv[0][j]); f[8 + j] = bf2f_s(sv[1][j]); s += f[j] + f[8 + j]; }
                      const float mean = wave_sum(s) * (1.f / 1024.f); float qq = 0.f;
#pragma unroll
                      for (int j = 0; j < 16; ++j) { const float d = f[j] - mean; qq += d * d; }
                      const float rstd = rsqrtf(wave_sum(qq) * (1.f / 1024.f) + EPS);
                      if (lane == 0) stats[t] = make_float2(mean, rstd); }
                }
}

typedef const Params __attribute__((address_space(4))) KParams;
constexpr int TR_PER_L = 7968 + 192 + 256 + 2048 + 1024 + 4096 + 4096;
constexpr int TR_FIRST = 7968 + 192 + 256, TR_FF2 = TR_PER_L - 4096;
__device__ __forceinline__ void transpose_layer_item(KParams& p, unsigned char* ws, int l, int r, LAS float* scr, int lane) {
    unsigned char* wl = ws + WS_W0 + l * W_LSTRIDE;
    if (r < 7968) { transpose_item(p.in[I_WIN] + (size_t)l * DM * NIN, DM, NIN, (bf16_t*)(wl + WO_IN), true, scr, r, lane); return; } r -= 7968;
    if (r < 192) { transpose_item(p.in[I_WUQ] + (size_t)l * 512 * 1536, 512, 1536, (bf16_t*)(wl + WO_UQ), false, scr, r, lane); return; } r -= 192;
    if (r < 256) { transpose_item(p.in[I_WUKV] + (size_t)l * 512 * 2048, 512, 2048, (bf16_t*)(wl + WO_UKV), false, scr, r, lane); return; } r -= 256;
    if (r < 2048) { const int br = r >> 9; transpose_item(p.in[I_WBR] + (size_t)(l * 4 + br) * 1024 * DM, 1024, DM, (bf16_t*)(wl + WO_BR) + (size_t)br * DM * 1024, false, scr, r & 511, lane); return; } r -= 2048;
    if (r < 1024) { transpose_item(p.in[I_WOUT] + (size_t)l * DM * DM, DM, DM, (bf16_t*)(wl + WO_OUT), false, scr, r, lane); return; } r -= 1024;
    if (r < 4096) { transpose_item(p.in[I_WFF1] + (size_t)l * DM * DFF, DM, DFF, (bf16_t*)(wl + WO_F1), false, scr, r, lane); return; } r -= 4096;
    transpose_item(p.in[I_WFF2] + (size_t)l * DFF * DM, DFF, DM, (bf16_t*)(wl + WO_F2), false, scr, r, lane);
}
__global__ void __launch_bounds__(NTHR, 2) mega_fwd(Params p_arg) {
    extern __shared__ __attribute__((aligned(16))) unsigned char lds_raw[];
    cg::grid_group grid = cg::this_grid();
    LAS unsigned char* lds = (LAS unsigned char*)lds_raw;
    const int tid0 = threadIdx.x, wave = __builtin_amdgcn_readfirstlane(tid0 >> 6);
    const int G = gridDim.x;
#define PHASE_IDS() int tid = tid0; asm volatile("" : "+v"(tid)); const int lane = tid & 63; (void)lane
    const int NGW = G * NWAVES;
#define WS_PTRS() KParams* pk_ = (KParams*)__builtin_amdgcn_kernarg_segment_ptr(); asm volatile("" : "+s"(pk_)); KParams& p = *pk_;   \
    unsigned char* ws = p.ws; asm volatile("" : "+s"(ws)); int bx_ = blockIdx.x; asm volatile("" : "+s"(bx_)); const int bx = bx_, gw = bx * NWAVES + wave; (void)gw; \
    float* MOD = (float*)(ws + WS_MOD); float2* tabB = (float2*)(ws + WS_TABB); float2* tabC = (float2*)(ws + WS_TABC); float2* stats = (float2*)(ws + WS_STATS); \
    bf16_t* H = (bf16_t*)(ws + WS_H); bf16_t* P = (bf16_t*)(ws + WS_P); bf16_t* U = (bf16_t*)(ws + WS_P); \
    bf16_t* KB = (bf16_t*)(ws + WS_KB); bf16_t* KR = (bf16_t*)(ws + WS_KR); bf16_t* QB = (bf16_t*)(ws + WS_QB); \
    bf16_t* CKVN = (bf16_t*)(ws + WS_CKVN); bf16_t* CQN = (bf16_t*)(ws + WS_CQN); bf16_t* QC = (bf16_t*)(ws + WS_QC); bf16_t* KVU = (bf16_t*)(ws + WS_KVU); \
    bf16_t* YS = (bf16_t*)(ws + WS_YS); float* MRG = (float*)(ws + WS_MRG); bf16_t* MG = (bf16_t*)(ws + WS_MG); float* XS = (float*)(ws + WS_XS); float* ZSLAB = (float*)(ws + WS_ZSLAB); bf16_t* VBC = (bf16_t*)(ws + WS_VBC); (void)VBC; \
    (void)MOD; (void)tabB; (void)tabC; (void)stats; (void)H; (void)P; (void)U; (void)KB; (void)KR; (void)QB; (void)CKVN; (void)CQN; (void)QC; (void)KVU; (void)YS; (void)MRG; (void)MG; (void)XS; (void)ZSLAB
#define LAYER_PTRS() unsigned char* wl = ws + WS_W0 + l * W_LSTRIDE; \
    const bf16_t* Win_t = (const bf16_t*)(wl + WO_IN); const bf16_t* Wuq_t = (const bf16_t*)(wl + WO_UQ); const bf16_t* Wukv_t = (const bf16_t*)(wl + WO_UKV); \
    const bf16_t* Wbr_t = (const bf16_t*)(wl + WO_BR); const bf16_t* Wout_t = (const bf16_t*)(wl + WO_OUT); const bf16_t* W1_t = (const bf16_t*)(wl + WO_F1); \
    const bf16_t* W2_t = (const bf16_t*)(wl + WO_F2); const bf16_t* Wsg = (const bf16_t*)(wl + WO_SG); \
    const float* modx = MOD + (size_t)(l * 2 + 0) * 12288; const float* modz = MOD + (size_t)(l * 2 + 1) * 12288; \
    const float* xsrc = l0 ? p.in[I_X] : XS; const float* zsrc = l0 ? p.in[I_CTX] : XS + (size_t)SEQ * DM; \
    (void)Win_t; (void)Wuq_t; (void)Wukv_t; (void)Wbr_t; (void)Wout_t; (void)W1_t; (void)W2_t; (void)Wsg; (void)modx; (void)modz; (void)xsrc; (void)zsrc

    {
        if (blockIdx.x == 0) for (int i = tid0; i < XCD_BAR_WORDS; i += NTHR) ((unsigned*)(p_arg.ws + WS_BAR))[i] = 0u;
        if (tid0 < 2) ((volatile LAS unsigned*)(lds + LDS_BARST))[tid0] = 0u;
    }
#if (PHM & 1)
    for (int rp0_ = 0; rp0_ < REP_P0; ++rp0_)
    {
        PHASE_IDS(); WS_PTRS();
#if (PHM & 4096)
        LAS float* sl = (LAS float*)lds;
        LAS float* red = (LAS float*)(lds + 16384);
        if (bx < 192) {
            for (int i = tid; i < 4096; i += NTHR) { const int cond = i >> 11, k = i & 2047; const float v = (cond ? p.in[I_CCTX] : p.in[I_C])[k]; sl[i] = v / (1.f + __expf(-v)); }
            __syncthreads();
        }
        for (int item = bx; item < 192; item += G) {
            typedef float f32x2 __attribute__((ext_vector_type(2)));
            const int l = item / 96, n0 = (item % 96) * 128;
            const float* wp = p.in[I_WADA] + (size_t)l * DM * 12288 + n0 + lane * 2;
            f32x2 a0 = (f32x2){0.f, 0.f}, a1 = a0;
#pragma unroll 16
            for (int kk = 0; kk < 256; ++kk) { const int k = wave * 256 + kk; const f32x2 wv = *(const f32x2*)(wp + (size_t)k * 12288); a0 += wv * sl[k]; a1 += wv * sl[2048 + k]; }
            *(LAS f32x2*)(red + (wave * 2 + 0) * 128 + lane * 2) = a0; *(LAS f32x2*)(red + (wave * 2 + 1) * 128 + lane * 2) = a1;
            __syncthreads();
            if (tid < 256) { const int cond = tid >> 7, col = tid & 127; float s = p.in[I_BADA][(size_t)l * 12288 + n0 + col];
#pragma unroll
              for (int w = 0; w < 8; ++w) s += red[(w * 2 + cond) * 128 + col];
              MOD[(size_t)(l * 2 + cond) * 12288 + n0 + col] = s; }
            __syncthreads();
        }
#endif
#if (PHM & 8192)
        for (int idx = bx * NTHR + tid; idx < 128 * 48; idx += G * NTHR) {
            const int pos = idx / 48, j = idx % 48;
            if (j < 32) { const float inv = powf(10000.0f, -(float)(2 * j) / 64.0f); const float ang = (float)pos * inv; tabB[pos * 32 + j] = make_float2(cosf(ang), sinf(ang)); }
            else { const int i = j - 32; const float inv = powf(10000.0f, -(float)(2 * i) / 32.0f); const float ang = (float)pos * inv; tabC[pos * 16 + i] = make_float2(cosf(ang), sinf(ang)); }
        }
#endif
#if (PHM & 16384)
        for (int idx = bx * NTHR + tid; idx < 2 * 131072 / 4; idx += G * NTHR) {
            const int l = idx / 32768, r = idx % 32768; const f32x4 v = *(const f32x4*)(p.in[I_SWS] + (size_t)idx * 4);
            u32x2 o; o.x = pk2(v[0], v[1]); o.y = pk2(v[2], v[3]);
            *(u32x2*)((bf16_t*)(ws + WS_W0 + l * W_LSTRIDE + WO_SG) + (size_t)r * 4) = o;
        }
#endif
        __syncthreads();
#if (PHM & 32768)
        LAS float* scr = (LAS float*)(lds + wave * 16640);
        for (int it = gw; it < TR_FIRST; it += NGW) transpose_layer_item(p, ws, 0, it, scr, lane);
#endif
    }
    #endif
        grid.sync();
        const XcdBarrier xb = xcd_barrier_post((unsigned*)(p_arg.ws + WS_BAR), (volatile LAS unsigned*)(lds + LDS_BARST));

    for (int l = 0; l < 2; ++l) {
        const bool l0 = (l == 0);
        const int TQ = l0 ? TALL : SEQ;
        const int nMq = TQ / 256;

#if (PHM & 2)
        {
        WS_PTRS(); LAYER_PTRS();
        PHASE_IDS();
            const float* gmix = p.in[I_NMIXG] + (size_t)l * DM;
            for (int rew_ = 0; rew_ < REP_EW; ++rew_)
            for (int row = gw; row < TALL; row += NGW) {
                const bool isz = row >= SEQ; const float* src = isz ? zsrc + (size_t)(row - SEQ) * DM : xsrc + (size_t)row * DM; const float* md = isz ? modz : modx;
                f32x4 v[8]; float ss = 0.f;
#pragma unroll
                for (int j = 0; j < 8; ++j) v[j] = *(const f32x4*)(src + (lane + 64 * j) * 4);
                if (isz && !l0) {
                    const float* g2z = MOD + (size_t)12288 + 5 * 2048;
#pragma unroll
                    for (int j = 0; j < 8; ++j) { const int c = (lane + 64 * j) * 4; f32x4 s = (f32x4){0.f, 0.f, 0.f, 0.f};
                        for (int ks = 0; ks < 16; ++ks) s += *(const f32x4*)(ZSLAB + ((size_t)ks * 256 + (row - SEQ)) * DM + c);
                        v[j] += *(const f32x4*)(g2z + c) * s; }
                }
#pragma unroll
                for (int j = 0; j < 8; ++j) ss += v[j][0] * v[j][0] + v[j][1] * v[j][1] + v[j][2] * v[j][2] + v[j][3] * v[j][3];
                const float r = rsqrtf(wave_sum(ss) * (1.f / DM) + EPS);
#pragma unroll
                for (int j = 0; j < 8; ++j) { const int c = (lane + 64 * j) * 4; const f32x4 g = *(const f32x4*)(gmix + c), sh = *(const f32x4*)(md + c), sc = *(const f32x4*)(md + 2048 + c);
                    f32x4 h = (v[j] * r * g) * (sc + 1.f) + sh; u32x2 o; o.x = pk2(h[0], h[1]); o.y = pk2(h[2], h[3]); *(u32x2*)(H + (size_t)row * DM + c) = o; }
            }
        }
        #endif
        for (int rs_ = 0; rs_ < REP_SYNC; ++rs_) xcd_barrier(xb);

#if (PHM & 4)
        {
        WS_PTRS(); LAYER_PTRS();
            pg8::SchedWide S{H, Win_t, DM, nMq, NINP / 256, nMq * (NINP / 256), 32, l0 ? 0 : 5, G, bx};
            pg8::EpiAct E{P, NINP, P, NINP, p.in[I_BGATE] + (size_t)l * 8192, P_G, P_U / 256, P_G / 256, -1};
            int nrep = REP_B; asm volatile("" : "+s"(nrep));
            for (int rep = 0; rep < nrep; ++rep) pg8::gemm_phase<pg8::EpiAct, pg8::SchedWide, true, true>(lds, DM, S, E);
            if (l0 && bx >= 31) {
                PHASE_IDS();
                LAS float* scr = (LAS float*)(lds + wave * 16640);
                for (int it = TR_FIRST + (bx - 31) * NWAVES + wave; it < TR_FF2; it += 225 * NWAVES) transpose_layer_item(p, ws, 0, it, scr, lane);
            }
        }
        #endif
        for (int rs_ = 0; rs_ < REP_SYNC; ++rs_) xcd_barrier(xb);

#if (PHM & 8)
        {
        WS_PTRS(); LAYER_PTRS();
        PHASE_IDS();
            const float* kng = p.in[I_KNG] + l * 128; const float* qng = p.in[I_QNG] + l * 128;
            const float* mqg = p.in[I_MQNG] + l * 512; const float* mkg = p.in[I_MKVNG] + l * 512; const float* cw = p.in[I_CONVW] + (size_t)l * 3 * 1024;
            const int li = lane & 31, hh = lane >> 5;
            float kn[4], qn[4], mk[8], mq[8], cwr[3][16];
#pragma unroll
            for (int j = 0; j < 4; ++j) { kn[j] = kng[32 * j + li]; qn[j] = qng[32 * j + li]; }
#pragma unroll
            for (int j = 0; j < 8; ++j) { mk[j] = mkg[lane * 8 + j]; mq[j] = mqg[lane * 8 + j]; }
#pragma unroll
            for (int tp = 0; tp < 3; ++tp)
#pragma unroll
                for (int j = 0; j < 16; ++j) cwr[tp][j] = cw[tp * 1024 + lane * 16 + j];
            const Post1 A1{P, KB, VBC, CKVN, KR, QB, CQN, YS, stats, tabB, tabC};
            for (int rew_ = 0; rew_ < REP_EW * REP_C; ++rew_) {
                for (int t = gw; t < TQ; t += NGW) post1_row<true>(A1, t, lane, kn, qn, mk, mq, cwr);
                if (!l0) for (int t = SEQ + gw; t < TALL; t += NGW) post1_row<false>(A1, t, lane, kn, qn, mk, mq, cwr);
            }
        }
        #endif
        for (int rs_ = 0; rs_ < REP_SYNC; ++rs_) xcd_barrier(xb);

#if (PHM & 16)
        {
        WS_PTRS(); LAYER_PTRS();
            pg8::SchedDual S{CQN, Wuq_t, CKVN, Wukv_t, 512, nMq, nMq * 6, TALL / 256, (TALL / 256) * 8, G, bx};
            pg8::EpiAct E{QC, 1536, KVU, 0, nullptr, 0, 1 << 30, 1 << 30, 0};
            int nrepd = REP_D; asm volatile("" : "+s"(nrepd));
            for (int rep = 0; rep < nrepd; ++rep) pg8::gemm_phase<pg8::EpiAct, pg8::SchedDual, true, true>(lds, 512, S, E);
            __syncthreads();
        PHASE_IDS();
            const float* lng = p.in[I_SLNG] + l * 1024; const float* lnb = p.in[I_SLNB] + l * 1024; const float* bs = p.in[I_SBS] + l * 1024;
            LAS bf16_t* VnT = (LAS bf16_t*)lds;
            const int r32 = lane & 31, hi = lane >> 5;
            for (int rew_ = 0; rew_ < REP_EW * REP_S; ++rew_)
            for (int item = G - 1 - bx; item < (TQ / 128) * 8; item += G) {
                const int ch = item >> 3, g = item & 7, t0 = ch * 128;
                { const int q = tid >> 2, cs = (tid & 3) * 32; const float2 st = stats[t0 + q]; const bf16_t* src = P + (size_t)(t0 + q) * NINP + P_V + g * 128 + cs;
#pragma unroll
                  for (int k4 = 0; k4 < 4; ++k4) { const bf16x8 v = *(const bf16x8*)(src + k4 * 8);
#pragma unroll
                    for (int j = 0; j < 8; ++j) { const int c = cs + k4 * 8 + j; const float f = (bf2f_s(v[j]) - st.x) * st.y * lng[g * 128 + c] + lnb[g * 128 + c]; VnT[c * 136 + q] = (bf16_t)f2bf(f); } } }
                __syncthreads();
                const int pb = wave >> 1, cb0 = (wave & 1) * 2;
                f32x16 acc0 = {}, acc1 = {};
                const bf16_t* Ap = Wsg + (size_t)g * 16384 + (pb * 32 + r32) * 128 + hi * 8;
#pragma unroll
                for (int ks = 0; ks < 8; ++ks) { const bf16x8 a = *(const bf16x8*)(Ap + ks * 16);
                    const bf16x8 b0 = *(const LAS bf16x8*)(VnT + ((cb0 * 32 + r32) * 136 + ks * 16 + hi * 8)), b1 = *(const LAS bf16x8*)(VnT + (((cb0 + 1) * 32 + r32) * 136 + ks * 16 + hi * 8));
                    acc0 = __builtin_amdgcn_mfma_f32_32x32x16_bf16(a, b0, acc0, 0, 0, 0); acc1 = __builtin_amdgcn_mfma_f32_32x32x16_bf16(a, b1, acc1, 0, 0, 0); }
#pragma unroll
                for (int r = 0; r < 16; ++r) { const int pp = pb * 32 + att::crow(r, hi); const int t = t0 + pp; const float bias = bs[g * 128 + pp];
                    const int c0 = g * 128 + cb0 * 32 + r32; const bf16_t* up = P + (size_t)t * NINP + P_U; bf16_t* yp = YS + 3 * YS_STRIDE + (size_t)t * 1024;
                    yp[c0] = (bf16_t)f2bf(bf2f(up[c0]) * (acc0[r] + bias)); yp[c0 + 32] = (bf16_t)f2bf(bf2f(up[c0 + 32]) * (acc1[r] + bias)); }
                __syncthreads();
            }
        }
        #endif
        for (int rs_ = 0; rs_ < REP_SYNC; ++rs_) xcd_barrier(xb);

#if (PHM & 32)
        {
        WS_PTRS(); LAYER_PTRS();
            const int h = bx & 7, qb = bx >> 3;
            const int nun = 1;
            const bool zmla = l0 && bx < 8, zgqa = l0 && bx >= 8 && bx < 16;
            int nrepF = REP_F; asm volatile("" : "+s"(nrepF));
#if EN192
            for (int ui = 0; ui < (zmla ? 2 : 1) * nrepF; ++ui) {
                const bool zu = zmla && (ui & 1); const size_t r0 = zu ? (size_t)SEQ : (size_t)qb * 256; const size_t k0 = zu ? (size_t)SEQ : 0; const int seq = zu ? CTXL : TALL;
                att::attn_body<192, 1536, 128, 64, 128, 1024>(QC + r0 * 1536 + h * 192, KVU + ((size_t)h * TALL + k0) * 128, KR + k0 * 64, KVU + ((size_t)(8 + h) * TALL + k0) * 128,
                                    YS + 2 * YS_STRIDE + r0 * 1024 + h * 128, seq, (char*)lds_raw, !zu, (int)r0, tabC);
            }
#endif
#if EN128
            for (int ui = 0; ui < (zgqa ? 2 : 1) * nrepF; ++ui) {
                const bool zu = zgqa && (ui & 1); const size_t r0 = zu ? (size_t)SEQ : (size_t)qb * 256; const size_t k0 = zu ? (size_t)SEQ : 0; const int seq = zu ? CTXL : TALL;
                att::attn_body<128, 1024, 128, 64, 128, 1024>(QB + r0 * 1024 + h * 128, KB + ((size_t)(h >> 2) * TALL + k0) * 128, nullptr, VBC + ((size_t)(h >> 2) * TALL + k0) * 128,
                                    YS + 1 * YS_STRIDE + r0 * 1024 + h * 128, seq, (char*)lds_raw, false, 0, tabC);
            }
#endif
        }
        #endif
        for (int rs_ = 0; rs_ < REP_SYNC; ++rs_) xcd_barrier(xb);

#if (PHM & 64)
        {
        WS_PTRS(); LAYER_PTRS();
            pg8::SchedBranch S{YS, Wbr_t, 1024, nMq, nMq * 8, G, bx, YS_STRIDE, (size_t)DM * 1024};
            pg8::EpiGate E{P, MG};
            int nrep = REP_G; asm volatile("" : "+s"(nrep));
            for (int rep = 0; rep < nrep; ++rep) pg8::gemm_phase<pg8::EpiGate, pg8::SchedBranch, true, true>(lds, 1024, S, E);
            if (l0 && bx >= 8) {
                PHASE_IDS();
                LAS float* scr = (LAS float*)(lds + wave * 16640);
                for (int it = (bx - 8) * NWAVES + wave; it < TR_PER_L; it += 248 * NWAVES) transpose_layer_item(p, ws, 1, it, scr, lane);
            }
        }
        #endif
        for (int rs_ = 0; rs_ < REP_SYNC; ++rs_) xcd_barrier(xb);

#if (PHM & 128)
        {
        WS_PTRS(); LAYER_PTRS();
            pg8::SchedNarrowZ S{MG, Wout_t, DM, 32, 256, G, bx, l0 ? 8 * 8 : 0, 256};
            pg8::EpiRes E{xsrc, zsrc, XS, modx + 2 * 2048, modz + 2 * 2048, 32, ZSLAB};
            pg8::gemm_phase<pg8::EpiRes, pg8::SchedNarrowZ, true, true>(lds, DM, S, E);
        }
        #endif
        for (int rs_ = 0; rs_ < REP_SYNC; ++rs_) xcd_barrier(xb);

#if (PHM & 256)
        {
        WS_PTRS(); LAYER_PTRS();
        PHASE_IDS();
            const float* gffn = p.in[I_NFFNG] + (size_t)l * DM;
            for (int rew_ = 0; rew_ < REP_EW; ++rew_)
            for (int row = gw; row < TQ; row += NGW) {
                const bool isz = row >= SEQ; const float* src = isz ? zsrc + (size_t)(row - SEQ) * DM : XS + (size_t)row * DM; const float* md = isz ? modz : modx;
                f32x4 v[8]; float ss = 0.f;
#pragma unroll
                for (int j = 0; j < 8; ++j) v[j] = *(const f32x4*)(src + (lane + 64 * j) * 4);
                if (isz) {
#pragma unroll
                    for (int j = 0; j < 8; ++j) { const int c = (lane + 64 * j) * 4; f32x4 s = (f32x4){0.f, 0.f, 0.f, 0.f};
                        for (int ks = 0; ks < 8; ++ks) s += *(const f32x4*)(ZSLAB + ((size_t)ks * 256 + (row - SEQ)) * DM + c);
                        v[j] += *(const f32x4*)(modz + 2 * 2048 + c) * s; *(f32x4*)(XS + (size_t)row * DM + c) = v[j]; }
                }
#pragma unroll
                for (int j = 0; j < 8; ++j) ss += v[j][0] * v[j][0] + v[j][1] * v[j][1] + v[j][2] * v[j][2] + v[j][3] * v[j][3];
                const float r = rsqrtf(wave_sum(ss) * (1.f / DM) + EPS);
#pragma unroll
                for (int j = 0; j < 8; ++j) { const int c = (lane + 64 * j) * 4; const f32x4 g = *(const f32x4*)(gffn + c), sh = *(const f32x4*)(md + 3 * 2048 + c), sc = *(const f32x4*)(md + 4 * 2048 + c);
                    f32x4 h = (v[j] * r * g) * (sc + 1.f) + sh; u32x2 o; o.x = pk2(h[0], h[1]); o.y = pk2(h[2], h[3]); *(u32x2*)(H + (size_t)row * DM + c) = o; }
            }
        }
        #endif
        for (int rs_ = 0; rs_ < REP_SYNC; ++rs_) xcd_barrier(xb);

#if (PHM & 512)
        {
        WS_PTRS(); LAYER_PTRS();
            pg8::SchedWide S{H, W1_t, DM, nMq, DFF / 256, nMq * (DFF / 256), 0, 0, G, bx};
            pg8::EpiAct E{U, DFF, U, DFF, nullptr, 0, 1 << 30, 1 << 30, 3};
            int nrep = REP_J; asm volatile("" : "+s"(nrep));
            for (int rep = 0; rep < nrep; ++rep) pg8::gemm_phase<pg8::EpiAct, pg8::SchedWide, true, true>(lds, DM, S, E);
            if (l0 && bx >= 32) {
                PHASE_IDS();
                LAS float* scr = (LAS float*)(lds + wave * 16640);
                for (int it = TR_FF2 + (bx - 32) * NWAVES + wave; it < TR_PER_L; it += 224 * NWAVES) transpose_layer_item(p, ws, 0, it, scr, lane);
            }
        }
        #endif
        for (int rs_ = 0; rs_ < REP_SYNC; ++rs_) xcd_barrier(xb);

#if (PHM & 1024)
        {
        WS_PTRS(); LAYER_PTRS();
            pg8::SchedNarrowZ S{U, W2_t, DFF, 32, 256, G, bx, l0 ? 8 * 16 : 0, 512};
            pg8::EpiRes E{XS, XS + (size_t)SEQ * DM, XS, modx + 5 * 2048, modz + 5 * 2048, 32, ZSLAB};
            pg8::gemm_phase<pg8::EpiRes, pg8::SchedNarrowZ, true, true>(lds, DFF, S, E);
        }
        #endif
        for (int rs_ = 0; rs_ < REP_SYNC; ++rs_) xcd_barrier(xb);
    }

    {
        WS_PTRS();
        PHASE_IDS();
        const float* gf = p.in[I_FNG];
        for (int row = gw; row < SEQ; row += NGW) {
            const float* src = XS + (size_t)row * DM; f32x4 v[8]; float ss = 0.f;
#pragma unroll
            for (int j = 0; j < 8; ++j) { v[j] = *(const f32x4*)(src + (lane + 64 * j) * 4); ss += v[j][0] * v[j][0] + v[j][1] * v[j][1] + v[j][2] * v[j][2] + v[j][3] * v[j][3]; }
            const float r = rsqrtf(wave_sum(ss) * (1.f / DM) + EPS);
#pragma unroll
            for (int j = 0; j < 8; ++j) { const int c = (lane + 64 * j) * 4; const f32x4 g = *(const f32x4*)(gf + c); *(f32x4*)(p.out + (size_t)row * DM + c) = v[j] * r * g; }
        }
    }
}

extern "C" void kernel_launch(void* const* d_in, const int* in_sizes, int n_in, void* d_out, int out_size, void* d_ws, size_t ws_size, hipStream_t stream) {
    static int grid = 0;
    if (grid == 0) {
        if (n_in != 26 || out_size != SEQ * DM || ws_size < WS_END) { fprintf(stderr, "kernel_launch: unexpected shapes (n_in %d out %d ws %zu, need ws >= %zu)\n", n_in, out_size, ws_size, (size_t)WS_END); grid = -1; return; }
        int dev = 0, cus = 0, per_cu = 0;
        hipGetDevice(&dev); hipDeviceGetAttribute(&cus, hipDeviceAttributeMultiprocessorCount, dev);
        if (hipFuncSetAttribute((const void*)mega_fwd, hipFuncAttributeMaxDynamicSharedMemorySize, LDS_BYTES) != hipSuccess) { fprintf(stderr, "kernel_launch: hipFuncSetAttribute failed\n"); grid = -1; return; }
        hipOccupancyMaxActiveBlocksPerMultiprocessor(&per_cu, (const void*)mega_fwd, NTHR, LDS_BYTES);
        (void)hipGetLastError();
        if (per_cu < 1) fprintf(stderr, "kernel_launch: occupancy query says %d blocks per CU\n", per_cu);
        grid = 256;
        if (cus != 256) fprintf(stderr, "kernel_launch: device has %d CUs; this kernel is built for a 256-workgroup grid\n", cus);
    }
    if (grid < 0) return;
    Params p{};
    for (int i = 0; i < 26; ++i) p.in[i] = (const float*)d_in[i];
    p.out = (float*)d_out; p.ws = (unsigned char*)d_ws;
    void* args[] = {&p};
    hipError_t e = hipLaunchCooperativeKernel((const void*)mega_fwd, dim3(grid), dim3(NTHR), args, LDS_BYTES, stream);
    if (e != hipSuccess) fprintf(stderr, "kernel_launch: cooperative launch failed: %s\n", hipGetErrorString(e));
}
```

```cpp
#include <hip/hip_runtime.h>
#include <hip/hip_cooperative_groups.h>
#include <cstdio>
#include <cstdint>
namespace cg = cooperative_groups;
#ifndef PHM
#define PHM 0xFFFF
#endif
#ifndef REP_F
#define REP_F 1
#endif
#ifndef REP_B
#define REP_B 1
#endif
#ifndef REP_J
#define REP_J 1
#endif
#ifndef REP_P0
#define REP_P0 1
#endif
#ifndef REP_SYNC
#define REP_SYNC 1
#endif
#ifndef REP_EW
#define REP_EW 1
#endif
#ifndef REP_C
#define REP_C 1
#endif
#ifndef REP_S
#define REP_S 1
#endif
#ifndef REP_G
#define REP_G 1
#endif
#ifndef REP_D
#define REP_D 1
#endif
#ifndef EN192
#define EN192 1
#endif
#ifndef EN128
#define EN128 1
#endif

#define LAS __attribute__((address_space(3)))
typedef unsigned short bf16_t;
typedef short bf16x8 __attribute__((ext_vector_type(8)));
typedef short s16x4 __attribute__((ext_vector_type(4)));
typedef float f32x4 __attribute__((ext_vector_type(4)));
typedef float f32x16 __attribute__((ext_vector_type(16)));
typedef unsigned u32x4 __attribute__((ext_vector_type(4)));
typedef unsigned u32x2 __attribute__((ext_vector_type(2)));

constexpr int DM = 2048, SEQ = 8192, CTXL = 256, TALL = SEQ + CTXL;
constexpr int NIN = 15936, NINP = 16128;
constexpr int P_KB = 0, P_VB = 256, P_CKV = 512, P_KR = 1024, P_QB = 1280, P_CQ = 2304, P_GB = 2816, P_GC = 3840, P_XA = 4864,
              P_U = 5888, P_V = 6912, P_G = 7936;
constexpr int DFF = 8192;
constexpr float EPS = 1e-6f;
constexpr int NWAVES = 8, NTHR = 512;

constexpr size_t MiB = 1u << 20;
constexpr size_t WS_MOD = 0;
constexpr size_t WS_TABB = 256 * 1024;
constexpr size_t WS_TABC = 320 * 1024;
constexpr size_t WS_STATS = 512 * 1024;
constexpr size_t WS_BAR = 768 * 1024;
constexpr int LDS_BARST = 134144;
constexpr size_t WS_W0 = 1 * MiB, W_LSTRIDE = 155 * MiB;
constexpr size_t WO_IN = 0, WO_UQ = 63 * MiB, WO_UKV = WO_UQ + 3 * MiB / 2, WO_BR = WO_UKV + 2 * MiB, WO_OUT = WO_BR + 16 * MiB,
                 WO_F1 = WO_OUT + 8 * MiB, WO_F2 = WO_F1 + 32 * MiB, WO_SG = WO_F2 + 32 * MiB;
constexpr size_t WS_H = 311 * MiB, WS_P = 344 * MiB, WS_KB = 604 * MiB, WS_KR = 609 * MiB, WS_QB = 611 * MiB, WS_CKVN = 628 * MiB,
                 WS_CQN = 637 * MiB, WS_QC = 646 * MiB, WS_KVU = 671 * MiB, WS_YS = 704 * MiB, WS_MRG = 770 * MiB, WS_MG = 836 * MiB,
                 WS_XS = 869 * MiB, WS_ZSLAB = 935 * MiB, WS_VBC = 967 * MiB, WS_END = 972 * MiB;
constexpr size_t YS_STRIDE = (size_t)TALL * 1024;
static_assert(WO_SG + 2 * 8 * 128 * 128 <= W_LSTRIDE, "weights map");

constexpr int LDS_BYTES = 132 * 1024;

__device__ __forceinline__ float bf2f(bf16_t v) { return __uint_as_float(((unsigned)v) << 16); }
__device__ __forceinline__ float bf2f_s(short v) { return __uint_as_float(((unsigned)(unsigned short)v) << 16); }
__device__ __forceinline__ unsigned f2bf(float f) { unsigned u = __float_as_uint(f); return (u + 0x7fffu + ((u >> 16) & 1u)) >> 16; }
__device__ __forceinline__ unsigned pk2(float lo, float hi) { return f2bf(lo) | (f2bf(hi) << 16); }
__device__ __forceinline__ unsigned cvt_pk_bf16(float lo, float hi) { unsigned r; asm volatile("v_cvt_pk_bf16_f32 %0, %1, %2" : "=v"(r) : "v"(lo), "v"(hi)); return r; }
__device__ __forceinline__ float wave_sum(float v) {
#pragma unroll
    for (int o = 1; o < 64; o <<= 1) v += __shfl_xor(v, o);
    return v;
}
__device__ __forceinline__ float half_sum(float v) {
#pragma unroll
    for (int o = 1; o < 32; o <<= 1) v += __shfl_xor(v, o);
    return v;
}

namespace pg8 {
constexpr int BM = 256, BK = 64, HALF = 128, HTB = HALF * BK * 2, STAGE_BYTES = 8 * HTB, NXCD = 8, WGM = 8;
__host__ __device__ __forceinline__ int lds_byte(int r, int c) { const int st = (r >> 4) * 2 + (c >> 5), rr = r & 15, cc = c & 31, ob = rr * 64 + cc * 2; return st * 1024 + (ob ^ (((ob >> 9) & 1) << 5)); }
__host__ __device__ __forceinline__ void stage_rc(int b, int& R, int& C) { const int st = b / 1024, sb = b % 1024, swz = sb ^ (((sb >> 9) & 1) << 5); R = (st >> 1) * 16 + swz / 64; C = (st & 1) * 32 + (swz % 64) / 2; }
__host__ __device__ __forceinline__ int perm32(int rho) { const int n = rho >> 4, i = rho & 15; return 8 * (i >> 2) + 4 * n + (i & 3); }
struct Unit { int pm, pn, z; };

struct SchedWide {
    const bf16_t* A; const bf16_t* Bt; int K, nM, nN, nwg, xpm, xn, G, c;
    __device__ bool next(int i, Unit& u) const {
        long L = (long)i * G + c;
        if (L < nwg) {
            int wgid = (int)L; { const int q = nwg / NXCD, r = nwg % NXCD, xcd = wgid % NXCD, off = wgid / NXCD; wgid = (xcd < r ? xcd * (q + 1) : r * (q + 1) + (xcd - r) * q) + off; }
            const int nig = WGM * nN, gid = wgid / nig, fm = gid * WGM, gsz = (nM - fm) < WGM ? (nM - fm) : WGM;
            u.pm = fm + ((wgid % nig) % gsz); u.pn = (wgid % nig) / gsz; u.z = 0; return true;
        }
        L -= nwg; if (L < xn) { u.pm = xpm; u.pn = (int)L; u.z = 0; return true; }
        return false;
    }
    __device__ __forceinline__ int nt(const Unit&) const { return K / BK; }
    __device__ __forceinline__ const char* aptr(const Unit& u) const { return (const char*)A + (size_t)u.pm * BM * K * 2; }
    __device__ __forceinline__ const char* bptr(const Unit& u) const { return (const char*)Bt + (size_t)u.pn * BM * K * 2; }
};
struct SchedNarrow {
    const bf16_t* A; const bf16_t* Bt; int K, nM, ntiles, G, c;
    __device__ bool next(int i, Unit& u) const { const int t = i * G + c; if (t >= ntiles) return false; u.pm = t % nM; u.pn = t / nM; u.z = 0; return true; }
    __device__ __forceinline__ int nt(const Unit&) const { return K / BK; }
    __device__ __forceinline__ const char* aptr(const Unit& u) const { return (const char*)A + (size_t)u.pm * BM * K * 2; }
    __device__ __forceinline__ const char* bptr(const Unit& u) const { return (const char*)Bt + (size_t)u.pn * BM * K * 2; }
};
struct SchedNarrowZ {
    const bf16_t* A; const bf16_t* Bt; int K, nM, ntiles, G, c, nz, ksl;
    __device__ bool next(int i, Unit& u) const {
        int t = i * G + c;
        if (t < ntiles) { u.pm = t % nM; u.pn = t / nM; u.z = 0; return true; }
        t -= ntiles; if (t >= nz) return false;
        u.pm = 32; u.pn = t & 7; u.z = 1 + (t >> 3); return true;
    }
    __device__ __forceinline__ int nt(const Unit& u) const { return (u.z ? ksl : K) / BK; }
    __device__ __forceinline__ const char* aptr(const Unit& u) const { return (const char*)A + (size_t)u.pm * BM * K * 2 + (u.z ? (size_t)(u.z - 1) * ksl * 2 : (size_t)0); }
    __device__ __forceinline__ const char* bptr(const Unit& u) const { return (const char*)Bt + (size_t)u.pn * BM * K * 2 + (u.z ? (size_t)(u.z - 1) * ksl * 2 : (size_t)0); }
};
struct SchedBranch {
    const bf16_t* A; const bf16_t* Bt; int K, nM, ntiles, G, c; size_t strideA, strideB;
    __device__ bool next(int i, Unit& u) const { const int t = (i >> 2) * G + c; if (t >= ntiles) return false; u.pm = t % nM; u.pn = t / nM; u.z = i & 3; return true; }
    __device__ __forceinline__ int nt(const Unit&) const { return K / BK; }
    __device__ __forceinline__ const char* aptr(const Unit& u) const { return (const char*)(A + (size_t)u.z * strideA) + (size_t)u.pm * BM * K * 2; }
    __device__ __forceinline__ const char* bptr(const Unit& u) const { return (const char*)(Bt + (size_t)u.z * strideB) + (size_t)u.pn * BM * K * 2; }
};
struct SchedDual {
    const bf16_t* A0; const bf16_t* B0; const bf16_t* A1; const bf16_t* B1; int K, nM0, n0, nM1, n1, G, c;
    __device__ bool next(int i, Unit& u) const {
        int L = i * G + c;
        if (L < n0) { u.z = 0; u.pm = L % nM0; u.pn = L / nM0; return true; }
        L -= n0; if (L >= n1) return false;
        u.z = 1; u.pm = L % nM1; u.pn = L / nM1; return true;
    }
    __device__ __forceinline__ int nt(const Unit&) const { return K / BK; }
    __device__ __forceinline__ const char* aptr(const Unit& u) const { return (const char*)(u.z ? A1 : A0) + (size_t)u.pm * BM * K * 2; }
    __device__ __forceinline__ const char* bptr(const Unit& u) const { return (const char*)(u.z ? B1 : B0) + (size_t)u.pn * BM * K * 2; }
};

__device__ __forceinline__ float gelu_tanh(float x) { const float t = 1.5957691216057308f * (x + 0.044715f * x * x * x); return x * __builtin_amdgcn_rcpf(1.f + __expf(-t)); }
__device__ __forceinline__ float sigmoidf(float x) { return __builtin_amdgcn_rcpf(1.f + __expf(-x)); }

struct EpiAct {
    static constexpr bool PERM = true;
    __device__ __forceinline__ bool zero_after(const Unit&) const { return true; }
    bf16_t* O0; int ld0; bf16_t* O1; int ld1; const float* bias; int bias_col0; int gelu_lo, sig_lo; int fixed_act;
    __device__ __forceinline__ void operator()(f32x4 (&acc)[2][2][4][2], const Unit& u, int wr, int wc, int fr, int fq) const {
        bf16_t* base = u.z ? O1 : O0; const int ldc = u.z ? ld1 : ld0;
        const bool hsplit = u.z && ld1 == 0;
        const int act = fixed_act >= 0 ? fixed_act : (u.pn >= sig_lo ? 2 : (u.pn >= gelu_lo ? 1 : 0));
        const int row0 = u.pm * BM + wr * 64 + fr, col0 = u.pn * BM + wc * 32 + 8 * fq;
#pragma unroll
        for (int bj = 0; bj < 2; ++bj) {
            f32x4 b0 = (f32x4){0.f, 0.f, 0.f, 0.f}, b1 = b0;
            if (act == 2) { b0 = *(const f32x4*)(bias + (col0 + bj * HALF - bias_col0)); b1 = *(const f32x4*)(bias + (col0 + bj * HALF - bias_col0 + 4)); }
#pragma unroll
            for (int ai = 0; ai < 2; ++ai)
#pragma unroll
                for (int m = 0; m < 4; ++m) {
                    f32x4 v0 = acc[ai][bj][m][0], v1 = acc[ai][bj][m][1];
                    if (act == 1) {
#pragma unroll
                        for (int j = 0; j < 4; ++j) { v0[j] = gelu_tanh(v0[j]); v1[j] = gelu_tanh(v1[j]); }
                    } else if (act == 2) {
#pragma unroll
                        for (int j = 0; j < 4; ++j) { v0[j] = sigmoidf(v0[j] + b0[j]); v1[j] = sigmoidf(v1[j] + b1[j]); }
                    } else if (act == 3) {
#pragma unroll
                        for (int j = 0; j < 4; ++j) { float a = fmaxf(v0[j], 0.f), b = fmaxf(v1[j], 0.f); v0[j] = a * a; v1[j] = b * b; }
                    }
                    u32x4 w; w.x = cvt_pk_bf16(v0[0], v0[1]); w.y = cvt_pk_bf16(v0[2], v0[3]); w.z = cvt_pk_bf16(v1[0], v1[1]); w.w = cvt_pk_bf16(v1[2], v1[3]);
                    if (hsplit) *(u32x4*)(base + ((size_t)(bj * 8 + u.pn) * TALL + (row0 + ai * HALF + m * 16)) * 128 + wc * 32 + 8 * fq) = w;
                    else *(u32x4*)(base + (size_t)(row0 + ai * HALF + m * 16) * ldc + col0 + bj * HALF) = w;
                }
        }
    }
};
struct EpiGate {
    static constexpr bool PERM = true;
    const bf16_t* P; bf16_t* MG;
    __device__ __forceinline__ bool zero_after(const Unit& u) const { return u.z == 3; }
    __device__ __forceinline__ void operator()(f32x4 (&acc)[2][2][4][2], const Unit& u, int wr, int wc, int fr, int fq) const {
        const int row0 = u.pm * BM + wr * 64 + fr, col0 = u.pn * BM + wc * 32 + 8 * fq; const int z = u.z;
        const bf16_t* gbase = P + (size_t)row0 * NINP + P_G + z * DM + col0;
#pragma unroll
        for (int ai = 0; ai < 2; ++ai) {
            bf16x8 g[4][2], gn[4][2];
#pragma unroll
            for (int m = 0; m < 4; ++m)
#pragma unroll
                for (int bj = 0; bj < 2; ++bj) {
                    const bf16_t* gp = gbase + (size_t)(ai * HALF + m * 16) * NINP + bj * HALF;
                    g[m][bj] = *(const bf16x8*)gp; gn[m][bj] = *(const bf16x8*)(gp + (z < 3 ? DM : 0)); }
            asm volatile("" ::: "memory");
#pragma unroll
            for (int m = 0; m < 4; ++m)
#pragma unroll
                for (int bj = 0; bj < 2; ++bj) {
                    if (z < 3) {
#pragma unroll
                        for (int j = 0; j < 4; ++j) {
                            acc[ai][bj][m][0][j] *= fmaxf(bf2f_s(g[m][bj][j]), 1e-18f) * __builtin_amdgcn_rcpf(fmaxf(bf2f_s(gn[m][bj][j]), 1e-18f));
                            acc[ai][bj][m][1][j] *= fmaxf(bf2f_s(g[m][bj][4 + j]), 1e-18f) * __builtin_amdgcn_rcpf(fmaxf(bf2f_s(gn[m][bj][4 + j]), 1e-18f)); }
                    } else {
                        f32x4 v0 = acc[ai][bj][m][0], v1 = acc[ai][bj][m][1];
#pragma unroll
                        for (int j = 0; j < 4; ++j) { v0[j] *= fmaxf(bf2f_s(g[m][bj][j]), 1e-18f); v1[j] *= fmaxf(bf2f_s(g[m][bj][4 + j]), 1e-18f); }
                        u32x4 w; w.x = cvt_pk_bf16(v0[0], v0[1]); w.y = cvt_pk_bf16(v0[2], v0[3]); w.z = cvt_pk_bf16(v1[0], v1[1]); w.w = cvt_pk_bf16(v1[2], v1[3]);
                        *(u32x4*)(MG + (size_t)(row0 + ai * HALF + m * 16) * DM + col0 + bj * HALF) = w;
                    }
                }
        }
    }
};
struct EpiRes {
    static constexpr bool PERM = false;
    __device__ __forceinline__ bool zero_after(const Unit&) const { return true; }
    const float* basex; const float* basez; float* out; const float* gx; const float* gz; int zpm; float* slab;
    __device__ __forceinline__ void operator()(f32x4 (&acc)[2][2][4][2], const Unit& u, int wr, int wc, int fr, int fq) const {
        if (u.z) {
            float* o = slab + (size_t)(u.z - 1) * BM * DM; const int col0 = u.pn * BM + wc * 32 + 4 * fq;
#pragma unroll
            for (int bj = 0; bj < 2; ++bj)
#pragma unroll
                for (int n = 0; n < 2; ++n)
#pragma unroll
                    for (int ai = 0; ai < 2; ++ai)
#pragma unroll
                        for (int m = 0; m < 4; ++m) *(f32x4*)(o + (size_t)(ai * HALF + wr * 64 + m * 16 + fr) * DM + col0 + bj * HALF + n * 16) = acc[ai][bj][m][n];
            return;
        }
        const bool isz = (u.pm == zpm);
        const float* base = isz ? basez : basex + (size_t)u.pm * BM * DM; const float* gv = isz ? gz : gx;
        float* o = out + (size_t)u.pm * BM * DM;
        const int col0 = u.pn * BM + wc * 32 + 4 * fq;
#pragma unroll
        for (int bj = 0; bj < 2; ++bj)
#pragma unroll
            for (int n = 0; n < 2; ++n) {
                const int col = col0 + bj * HALF + n * 16; const f32x4 g4 = *(const f32x4*)(gv + col);
#pragma unroll
                for (int ai = 0; ai < 2; ++ai)
#pragma unroll
                    for (int m = 0; m < 4; ++m) {
                        const size_t off = (size_t)(ai * HALF + wr * 64 + m * 16 + fr) * DM + col;
                        const f32x4 bs = *(const f32x4*)(base + off);
                        *(f32x4*)(o + off) = bs + g4 * acc[ai][bj][m][n];
                    }
            }
    }
};

template <class Epi, class Sched, bool ALIGN_EPI = false, bool SP2 = false>
__device__ __forceinline__ void gemm_phase(LAS unsigned char* lds, const int K, const Sched& S, const Epi& E) {
    int tid_ = threadIdx.x; asm volatile("" : "+v"(tid_));
    const int tid = tid_, wid = __builtin_amdgcn_readfirstlane(tid >> 6), lane = tid & 63, wr = wid >> 2, wc = wid & 3, fr = lane & 15, fq = lane >> 4;
    unsigned voffA[2], voffB[2];
#pragma unroll
    for (int i = 0; i < 2; ++i) { int R, C; stage_rc(tid * 16 + i * 8192, R, C); const int Rb = Epi::PERM ? ((R & ~31) + perm32(R & 31)) : R;
        voffA[i] = (unsigned)(R * K + C) * 2u; voffB[i] = (unsigned)(Rb * K + C) * 2u; }
    const size_t kstep = (size_t)(BK * 2);
    const size_t hstep = (size_t)HALF * K * 2;
    const unsigned ldsw = (unsigned)wid * 1024u;
    const int aoff = lds_byte(wr * 64 + fr, fq * 8), boff = lds_byte(wc * 32 + fr, fq * 8);
#define PG8_SA(b, h) (((b) * 2 + (h)) * HTB)
#define PG8_SB(b, h) ((4 + (b) * 2 + (h)) * HTB)
#define PG8_STAGE(bufoff, gbase, voff) do { _Pragma("unroll") for (int _i = 0; _i < 2; ++_i) \
        __builtin_amdgcn_global_load_lds((const unsigned*)((const char*)(gbase) + (voff)[_i]), (LAS unsigned*)(lds + (bufoff) + ldsw + _i * 8192), 16, 0, 0); } while (0)
#define PG8_LDA(dst, b, h) do { _Pragma("unroll") for (int m = 0; m < 4; ++m) _Pragma("unroll") for (int k = 0; k < 2; ++k) dst[m][k] = *(const LAS bf16x8*)(lds + PG8_SA(b, h) + aoff + m * 2048 + k * 1024); } while (0)
#define PG8_LDB(dst, b, h) do { _Pragma("unroll") for (int n = 0; n < 2; ++n) _Pragma("unroll") for (int k = 0; k < 2; ++k) dst[n][k] = *(const LAS bf16x8*)(lds + PG8_SB(b, h) + boff + n * 2048 + k * 1024); } while (0)
#define PG8_MMA(ai, bj, At, Bt) do { __builtin_amdgcn_s_setprio(1); _Pragma("unroll") for (int m = 0; m < 4; ++m) _Pragma("unroll") for (int n = 0; n < 2; ++n) _Pragma("unroll") for (int k = 0; k < 2; ++k) \
        acc[ai][bj][m][n] = __builtin_amdgcn_mfma_f32_16x16x32_bf16(Bt[n][k], At[m][k], acc[ai][bj][m][n], 0, 0, 0); __builtin_amdgcn_s_setprio(0); } while (0)
#define PG8_WAIT_V(n) asm volatile("s_waitcnt vmcnt(" #n ")" ::: "memory")
#define PG8_WAIT_L(n) asm volatile("s_waitcnt lgkmcnt(" #n ")" ::: "memory")
#define PG8_BAR __builtin_amdgcn_s_barrier()
#define PG8_SCHED __builtin_amdgcn_sched_barrier(0)
    Unit cur, nxt; int ui = 0;
    if (!S.next(0, cur)) return;
    int nt = S.nt(cur);
    f32x4 acc[2][2][4][2];
#pragma unroll
    for (int a = 0; a < 2; ++a)
#pragma unroll
        for (int b = 0; b < 2; ++b)
#pragma unroll
            for (int m = 0; m < 4; ++m)
#pragma unroll
                for (int n = 0; n < 2; ++n) acc[a][b][m][n] = (f32x4){0.f, 0.f, 0.f, 0.f};
    bf16x8 At[4][2], B0[2][2], B1[2][2];
    const char* cA = S.aptr(cur); const char* cB = S.bptr(cur);
    if constexpr (SP2) {
        PG8_STAGE(PG8_SB(0, 0), cB, voffB); PG8_STAGE(PG8_SB(0, 1), cB + hstep, voffB); PG8_STAGE(PG8_SA(0, 0), cA, voffA); PG8_STAGE(PG8_SA(0, 1), cA + hstep, voffA);
        if (wr == 1) PG8_BAR;
        PG8_WAIT_V(2); PG8_BAR;
        PG8_STAGE(PG8_SB(1, 0), cB + kstep, voffB); PG8_STAGE(PG8_SA(1, 0), cA + kstep, voffA); PG8_STAGE(PG8_SB(1, 1), cB + hstep + kstep, voffB);
        PG8_WAIT_V(6); PG8_BAR;
    } else {
        PG8_STAGE(PG8_SB(0, 0), cB, voffB); PG8_STAGE(PG8_SA(0, 0), cA, voffA); PG8_STAGE(PG8_SB(0, 1), cB + hstep, voffB); PG8_STAGE(PG8_SA(0, 1), cA + hstep, voffA);
        if (wr == 1) PG8_BAR;
        PG8_WAIT_V(4); PG8_BAR;
        PG8_STAGE(PG8_SB(1, 0), cB + kstep, voffB); PG8_STAGE(PG8_SA(1, 0), cA + kstep, voffA); PG8_STAGE(PG8_SB(1, 1), cB + hstep + kstep, voffB);
        PG8_WAIT_V(6); PG8_BAR;
    }
    for (;;) {
        const bool has_next = S.next(ui + 1, nxt);
        const char* nA = has_next ? S.aptr(nxt) : cA; const char* nB = has_next ? S.bptr(nxt) : cB;
        for (int t = 0; t < nt; t += 2) {
            const bool last = (t == nt - 2);
            const char* a1 = cA + (size_t)(t + 1) * kstep;
            const char* a2 = last ? nA : cA + (size_t)(t + 2) * kstep; const char* b2 = last ? nB : cB + (size_t)(t + 2) * kstep;
            const char* a3 = a2 + kstep; const char* b3 = b2 + kstep;
            if constexpr (SP2) {
            PG8_LDB(B0, 0, 0); PG8_LDB(B1, 0, 1); PG8_SCHED; PG8_LDA(At, 0, 0); PG8_STAGE(PG8_SA(1, 1), a1 + hstep, voffA);
            PG8_WAIT_V(8); PG8_WAIT_L(0); PG8_BAR; PG8_MMA(0, 0, At, B0); PG8_MMA(0, 1, At, B1); PG8_BAR; PG8_SCHED;
            PG8_LDA(At, 0, 1); PG8_STAGE(PG8_SB(0, 0), b2, voffB); PG8_STAGE(PG8_SB(0, 1), b2 + hstep, voffB); PG8_STAGE(PG8_SA(0, 0), a2, voffA);
            PG8_WAIT_V(8); PG8_WAIT_L(0); PG8_BAR; PG8_MMA(1, 0, At, B0); PG8_MMA(1, 1, At, B1); PG8_BAR; PG8_SCHED;
            PG8_LDB(B0, 1, 0); PG8_LDB(B1, 1, 1); PG8_SCHED; PG8_LDA(At, 1, 0); PG8_STAGE(PG8_SA(0, 1), a2 + hstep, voffA);
            PG8_WAIT_V(8); PG8_WAIT_L(0); PG8_BAR; PG8_MMA(0, 0, At, B0); PG8_MMA(0, 1, At, B1); PG8_BAR; PG8_SCHED;
            PG8_LDA(At, 1, 1); PG8_STAGE(PG8_SB(1, 0), b3, voffB); PG8_STAGE(PG8_SB(1, 1), b3 + hstep, voffB); PG8_STAGE(PG8_SA(1, 0), a3, voffA);
            PG8_WAIT_V(8); PG8_WAIT_L(0); PG8_BAR; PG8_MMA(1, 0, At, B0); PG8_MMA(1, 1, At, B1); PG8_BAR; PG8_SCHED;
            } else {
            PG8_LDB(B0, 0, 0); PG8_SCHED; PG8_LDA(At, 0, 0); PG8_STAGE(PG8_SA(1, 1), a1 + hstep, voffA);
            PG8_WAIT_L(8); PG8_BAR; PG8_WAIT_L(0); PG8_MMA(0, 0, At, B0); PG8_BAR; PG8_SCHED;
            PG8_LDB(B1, 0, 1); PG8_STAGE(PG8_SB(0, 0), b2, voffB);
            PG8_BAR; PG8_WAIT_L(0); PG8_MMA(0, 1, At, B1); PG8_BAR;
            PG8_LDA(At, 0, 1); PG8_STAGE(PG8_SA(0, 0), a2, voffA);
            PG8_BAR; PG8_WAIT_L(0); PG8_MMA(1, 0, At, B0); PG8_BAR; PG8_SCHED;
            PG8_STAGE(PG8_SB(0, 1), b2 + hstep, voffB);
            PG8_WAIT_V(6); PG8_BAR; PG8_MMA(1, 1, At, B1); PG8_BAR;
            PG8_LDB(B0, 1, 0); PG8_SCHED; PG8_LDA(At, 1, 0); PG8_STAGE(PG8_SA(0, 1), a2 + hstep, voffA);
            PG8_WAIT_L(8); PG8_BAR; PG8_WAIT_L(0); PG8_MMA(0, 0, At, B0); PG8_BAR; PG8_SCHED;
            PG8_LDB(B1, 1, 1); PG8_STAGE(PG8_SB(1, 0), b3, voffB);
            PG8_BAR; PG8_WAIT_L(0); PG8_MMA(0, 1, At, B1); PG8_BAR;
            PG8_LDA(At, 1, 1); PG8_STAGE(PG8_SA(1, 0), a3, voffA);
            PG8_BAR; PG8_WAIT_L(0); PG8_MMA(1, 0, At, B0); PG8_BAR; PG8_SCHED;
            PG8_STAGE(PG8_SB(1, 1), b3 + hstep, voffB);
            PG8_WAIT_V(6); PG8_BAR; PG8_MMA(1, 1, At, B1); PG8_BAR;
            }
        }
        if constexpr (ALIGN_EPI) { if (wr == 0) PG8_BAR; }
        E(acc, cur, wr, wc, fr, fq);
        if (!has_next) break;
        if (E.zero_after(cur)) {
#pragma unroll
        for (int a = 0; a < 2; ++a)
#pragma unroll
            for (int b = 0; b < 2; ++b)
#pragma unroll
                for (int m = 0; m < 4; ++m)
#pragma unroll
                    for (int n = 0; n < 2; ++n) acc[a][b][m][n] = (f32x4){0.f, 0.f, 0.f, 0.f};
        }
        cur = nxt; cA = nA; cB = nB; ++ui; nt = S.nt(cur);
        if constexpr (ALIGN_EPI) { if (wr == 1) PG8_BAR; }
    }
    PG8_WAIT_V(0);
    if constexpr (!ALIGN_EPI) { if (wr == 0) PG8_BAR; }
    PG8_BAR;
#undef PG8_SA
#undef PG8_SB
#undef PG8_STAGE
#undef PG8_LDA
#undef PG8_LDB
#undef PG8_MMA
#undef PG8_WAIT_V
#undef PG8_WAIT_L
#undef PG8_BAR
#undef PG8_SCHED
}
}

namespace att {
constexpr int NW = 8, QBLK = 32, KVBLK = 64;
constexpr float THR = 8.f;
constexpr size_t SHM_V = KVBLK * 128 * 2;
#define SBAR() __builtin_amdgcn_sched_barrier(0)
__device__ __forceinline__ int crow(int r, int hi) { return (r & 3) + 8 * (r >> 2) + 4 * hi; }
__device__ __forceinline__ unsigned cvtpk(float lo, float hi) { unsigned r; asm volatile("v_cvt_pk_bf16_f32 %0, %1, %2" : "=v"(r) : "v"(lo), "v"(hi)); return r; }

template <int DQ> __device__ __forceinline__ void partialSM(f32x16& p0, f32x16& p1, float& m_reg, float& mn, float& alpha) {
  constexpr float SCALE = (DQ == 128) ? 0.088388347648318440f : 0.072168783648703220f;
  constexpr float C = SCALE * 1.4426950408889634f;
  float pmax = p0[0];
#pragma unroll
  for (int r = 1; r < 16; ++r) pmax = fmaxf(pmax, p0[r]);
#pragma unroll
  for (int r = 0; r < 16; ++r) pmax = fmaxf(pmax, p1[r]);
  { auto rr = __builtin_amdgcn_permlane32_swap(__float_as_uint(pmax), __float_as_uint(pmax), false, false);
    pmax = fmaxf(__uint_as_float(rr[0]), __uint_as_float(rr[1])); }
  if (__builtin_expect(__all(pmax - m_reg <= THR / SCALE), 1)) { mn = m_reg; alpha = 1.f; }
  else { mn = fmaxf(m_reg, pmax); alpha = __builtin_amdgcn_exp2f((m_reg - mn) * C); m_reg = mn; }
  float mnC = -mn * C;
#pragma unroll
  for (int r = 0; r < 16; ++r) p0[r] = fmaf(p0[r], C, mnC);
#pragma unroll
  for (int r = 0; r < 16; ++r) p1[r] = fmaf(p1[r], C, mnC);
#pragma unroll
  for (int r = 0; r < 16; ++r) p0[r] = __builtin_amdgcn_exp2f(p0[r]);
}
__device__ __forceinline__ void finishSM(f32x16& p0, f32x16& p1, float alpha, float& l_reg, bf16x8& pa0, bf16x8& pa1, bf16x8& pa2, bf16x8& pa3) {
#pragma unroll
  for (int r = 0; r < 16; ++r) p1[r] = __builtin_amdgcn_exp2f(p1[r]);
  float ps = 0;
#pragma unroll
  for (int r = 0; r < 16; ++r) ps += p0[r];
#pragma unroll
  for (int r = 0; r < 16; ++r) ps += p1[r];
  { auto rr = __builtin_amdgcn_permlane32_swap(__float_as_uint(ps), __float_as_uint(ps), false, false);
    ps = __uint_as_float(rr[0]) + __uint_as_float(rr[1]); }
  l_reg = l_reg * alpha + ps;
#define PK4(P, BASE, OUT) do { unsigned a0 = cvtpk(P[BASE + 0], P[BASE + 1]), a1 = cvtpk(P[BASE + 2], P[BASE + 3]);   \
    unsigned b0 = cvtpk(P[BASE + 4], P[BASE + 5]), b1 = cvtpk(P[BASE + 6], P[BASE + 7]);                              \
    auto r0 = __builtin_amdgcn_permlane32_swap(a0, b0, false, false); auto r1 = __builtin_amdgcn_permlane32_swap(a1, b1, false, false); \
    u32x4 w = {r0[0], r1[0], r0[1], r1[1]}; OUT = *reinterpret_cast<bf16x8*>(&w); } while (0)
  PK4(p0, 0, pa0); PK4(p0, 8, pa1); PK4(p1, 0, pa2); PK4(p1, 8, pa3);
#undef PK4
}
template <int DQ> __device__ __forceinline__ int kswz(int row, int colB) { return row * (DQ * 2 + 16) + colB; }
template <int DQ> __device__ __forceinline__ void qkt(f32x16& p0, f32x16& p1, const char* Ks, const bf16x8* qr, const char* qx, const int kb) {
  p0 = f32x16{}; p1 = f32x16{};
#pragma unroll
  for (int d0 = 0; d0 < DQ / 16; ++d0) {
    bf16x8 b0 = *reinterpret_cast<const bf16x8*>(Ks + kb + d0 * 32);
    bf16x8 b1 = *reinterpret_cast<const bf16x8*>(Ks + kb + d0 * 32 + 32 * (DQ * 2 + 16));
    bf16x8 q; if (d0 < 8) q = qr[d0]; else q = *reinterpret_cast<const bf16x8*>(qx + (d0 - 8) * 1024);
    p0 = __builtin_amdgcn_mfma_f32_32x32x16_bf16(b0, q, p0, 0, 0, 0);
    p1 = __builtin_amdgcn_mfma_f32_32x32x16_bf16(b1, q, p1, 0, 0, 0); }
}
__device__ __forceinline__ int v_st(int k, int c) { const int kk = (k & ~0xC) | ((k & 4) << 1) | ((k & 8) >> 1); return ((kk >> 3) * 4 + (c >> 5)) * 512 + ((kk & 7) * 32 + (c & 31)) * 2; }
__device__ __forceinline__ int v_rd_base(int lane) { return ((lane & 3) << 3) | (((lane >> 2) & 3) << 6) | (((lane >> 4) & 1) << 5) | (((lane >> 5) & 1) << 8); }
constexpr int v_rd_off(int d0, int ks, int half) { return d0 * 512 + ks * 4096 + half * 2048; }
template <int OFF> __device__ __forceinline__ s16x4 tr_read(int vb) {
  s16x4 r; asm volatile("ds_read_b64_tr_b16 %0, %1 offset:%2" : "=&v"(r) : "v"(vb), "i"(OFF) : "memory"); return r;
}
template <int D0> __device__ __forceinline__ void pv_one(f32x16& od, int vb, bf16x8 pa0, bf16x8 pa1, bf16x8 pa2, bf16x8 pa3) {
  const s16x4 l0 = tr_read<v_rd_off(D0, 0, 0)>(vb), h0 = tr_read<v_rd_off(D0, 0, 1)>(vb), l1 = tr_read<v_rd_off(D0, 1, 0)>(vb), h1 = tr_read<v_rd_off(D0, 1, 1)>(vb);
  const s16x4 l2 = tr_read<v_rd_off(D0, 2, 0)>(vb), h2 = tr_read<v_rd_off(D0, 2, 1)>(vb), l3 = tr_read<v_rd_off(D0, 3, 0)>(vb), h3 = tr_read<v_rd_off(D0, 3, 1)>(vb);
  asm volatile("s_waitcnt lgkmcnt(0)" ::: "memory"); SBAR();
#define PK(L, H) (bf16x8){L[0], L[1], L[2], L[3], H[0], H[1], H[2], H[3]}
  od = __builtin_amdgcn_mfma_f32_32x32x16_bf16(pa0, PK(l0, h0), od, 0, 0, 0);
  od = __builtin_amdgcn_mfma_f32_32x32x16_bf16(pa1, PK(l1, h1), od, 0, 0, 0);
  od = __builtin_amdgcn_mfma_f32_32x32x16_bf16(pa2, PK(l2, h2), od, 0, 0, 0);
  od = __builtin_amdgcn_mfma_f32_32x32x16_bf16(pa3, PK(l3, h3), od, 0, 0, 0);
#undef PK
}
__device__ __forceinline__ void pv_d0(f32x16* o, int vb, bf16x8 pa0, bf16x8 pa1, bf16x8 pa2, bf16x8 pa3) {
  pv_one<0>(o[0], vb, pa0, pa1, pa2, pa3); pv_one<1>(o[1], vb, pa0, pa1, pa2, pa3); pv_one<2>(o[2], vb, pa0, pa1, pa2, pa3); pv_one<3>(o[3], vb, pa0, pa1, pa2, pa3);
}

template <int DQ, int ldq, int ldk0, int ldk1, int ldv, int ldo>
__device__ __forceinline__ void attn_body(const bf16_t* __restrict__ Qb, const bf16_t* __restrict__ K0, const bf16_t* __restrict__ K1,
                                          const bf16_t* __restrict__ Vh, bf16_t* __restrict__ Ob, int seq, char* lds, bool ropeq, int qpos0, const float2* __restrict__ tabC) {
  constexpr size_t SHM_K = KVBLK * (DQ * 2 + 16);
  int tid_ = threadIdx.x; asm volatile("" : "+v"(tid_));
  const int tid = tid_, wid = tid >> 6, lane = tid & 63, r32 = lane & 31, hi = lane >> 5;
  char* V_lds = lds; char* K_lds = lds + 2 * SHM_V;
  float* ws = (float*)(lds + 2 * SHM_V + 2 * SHM_K) + wid * 64; float* li_l = ws; float* al_l = ws + 32;
  float m_reg = -1e30f, l_reg = 0; f32x16 o[4] = {}; bf16x8 qr[8];
  const bf16_t* Qw = Qb + (long)(wid * QBLK + r32) * ldq + hi * 8;
#pragma unroll
  for (int d0 = 0; d0 < 8; ++d0) qr[d0] = *reinterpret_cast<const bf16x8*>(Qw + d0 * 16);
  char* qx = lds + 2 * SHM_V + 2 * SHM_K + 2048 + wid * 4096 + lane * 16;
  if constexpr (DQ == 192) {
    const int t = qpos0 + wid * QBLK + r32;
#pragma unroll
    for (int ax = 0; ax < 2; ++ax) {
      const int pos = ax ? (t & 63) : (t >> 6); const float2* tb = tabC + pos * 16 + hi * 8;
      bf16x8 a = *reinterpret_cast<const bf16x8*>(Qw + (8 + 2 * ax) * 16), b = *reinterpret_cast<const bf16x8*>(Qw + (9 + 2 * ax) * 16);
      if (ropeq) {
#pragma unroll
        for (int j = 0; j < 8; ++j) { const float2 cs = tb[j]; const float x1 = bf2f_s(a[j]), x2 = bf2f_s(b[j]);
          a[j] = (short)f2bf(x1 * cs.x - x2 * cs.y); b[j] = (short)f2bf(x1 * cs.y + x2 * cs.x); }
      }
      *reinterpret_cast<bf16x8*>(qx + (2 * ax) * 1024) = a; *reinterpret_cast<bf16x8*>(qx + (2 * ax + 1) * 1024) = b;
    }
  }
  const int kb = kswz<DQ>(r32, hi * 16);
  const int sr = tid >> 4, sc = (tid & 15) * 8, vst0 = v_st(sr, sc), vst1 = v_st(32 + sr, sc);
  const int sr2 = tid >> 3, sc2 = (tid & 7) * 8;
  const int vb0 = (int)(uintptr_t)V_lds + v_rd_base(lane);
  struct { bf16x8 vs0, vs1, ks0, ks1, ks2; } sr_[1];
#define SLOAD(i, k0) do { sr_[i].vs0 = *(const bf16x8*)(&Vh[(long)((k0) + sr) * ldv + sc]); sr_[i].vs1 = *(const bf16x8*)(&Vh[(long)((k0) + 32 + sr) * ldv + sc]); \
    sr_[i].ks0 = *(const bf16x8*)(&K0[(long)((k0) + sr) * ldk0 + sc]); sr_[i].ks1 = *(const bf16x8*)(&K0[(long)((k0) + 32 + sr) * ldk0 + sc]); \
    if constexpr (DQ == 192) sr_[i].ks2 = *(const bf16x8*)(&K1[(long)((k0) + sr2) * ldk1 + sc2]); } while (0)
#define SWRITE(b, i) do { *(bf16x8*)(V_lds + (b) * SHM_V + vst0) = sr_[i].vs0;          \
    *(bf16x8*)(V_lds + (b) * SHM_V + vst1) = sr_[i].vs1; int kc = sc * 2;               \
    *(bf16x8*)(K_lds + (b) * SHM_K + kswz<DQ>(sr, kc)) = sr_[i].ks0;                       \
    *(bf16x8*)(K_lds + (b) * SHM_K + kswz<DQ>(32 + sr, kc)) = sr_[i].ks1;                  \
    if constexpr (DQ == 192) *(bf16x8*)(K_lds + (b) * SHM_K + kswz<DQ>(sr2, 256 + sc2 * 2)) = sr_[i].ks2; } while (0)
#define SWAIT() asm volatile("s_waitcnt vmcnt(0)" ::: "memory")
#define RESC(a) do { if (__any((a) < 1.f)) { if (hi == 0) al_l[r32] = (a); asm volatile("s_waitcnt lgkmcnt(0)" ::: "memory"); \
    _Pragma("unroll") for (int d = 0; d < 4; ++d) _Pragma("unroll") for (int r = 0; r < 16; ++r) o[d][r] *= al_l[crow(r, hi)]; } } while (0)
  f32x16 pA0, pA1, pB0, pB1; float mnA, mnB, alA, alB; bf16x8 pa0, pa1, pa2, pa3; const int NT = seq / KVBLK;
  SLOAD(0, 0); SWAIT(); SWRITE(0, 0); __syncthreads();
  qkt<DQ>(pA0, pA1, K_lds, qr, qx, kb); partialSM<DQ>(pA0, pA1, m_reg, mnA, alA);
  SLOAD(0, KVBLK);
  SWAIT(); SWRITE(1, 0); __syncthreads();
  for (int j = 1; j + 1 < NT; j += 2) {
    SBAR(); qkt<DQ>(pB0, pB1, K_lds + SHM_K, qr, qx, kb);
    finishSM(pA0, pA1, alA, l_reg, pa0, pa1, pa2, pa3); SBAR();
    SLOAD(0, (j + 1) * KVBLK); SBAR();
    pv_d0(o, vb0, pa0, pa1, pa2, pa3); partialSM<DQ>(pB0, pB1, m_reg, mnB, alB);
    __syncthreads(); SWAIT(); SWRITE(0, 0);
    RESC(alB); __syncthreads();
    SBAR(); qkt<DQ>(pA0, pA1, K_lds, qr, qx, kb);
    finishSM(pB0, pB1, alB, l_reg, pa0, pa1, pa2, pa3); SBAR();
    SLOAD(0, (j + 2) * KVBLK); SBAR();
    pv_d0(o, vb0 + (int)SHM_V, pa0, pa1, pa2, pa3); partialSM<DQ>(pA0, pA1, m_reg, mnA, alA);
    __syncthreads(); SWAIT(); SWRITE(1, 0);
    RESC(alA); __syncthreads();
  }
  SBAR(); qkt<DQ>(pB0, pB1, K_lds + SHM_K, qr, qx, kb);
  finishSM(pA0, pA1, alA, l_reg, pa0, pa1, pa2, pa3); SBAR();
  pv_d0(o, vb0, pa0, pa1, pa2, pa3); partialSM<DQ>(pB0, pB1, m_reg, mnB, alB);
  __syncthreads(); RESC(alB);
  finishSM(pB0, pB1, alB, l_reg, pa0, pa1, pa2, pa3); SBAR();
  pv_d0(o, vb0 + (int)SHM_V, pa0, pa1, pa2, pa3);
  if (hi == 0) li_l[r32] = l_reg; asm volatile("s_waitcnt lgkmcnt(0)" ::: "memory");
  float rli[16];
#pragma unroll
  for (int r = 0; r < 16; ++r) rli[r] = __builtin_amdgcn_rcpf(li_l[crow(r, hi)]);
  bf16_t* Ow = Ob + (long)(wid * QBLK) * ldo;
#pragma unroll
  for (int r = 0; r < 16; ++r) { int orow = crow(r, hi);
#pragma unroll
    for (int d0 = 0; d0 < 4; ++d0) Ow[(long)orow * ldo + d0 * 32 + r32] = (bf16_t)f2bf(o[d0][r] * rli[r]); }
  __syncthreads();
#undef SLOAD
#undef SWRITE
#undef SWAIT
#undef RESC
}
#undef SBAR
}


#define XB_TMO      128
#define XB_XCNT(j)  (256  + 64 * (j))
#define XB_XSUB(j)  (1280 + 64 * (j))
#define XB_XGEN(j)  (2304 + 64 * (j))
#define XB_TOP      3328
#define XB_TOPGEN   3392
#define XCD_BAR_WORDS 3456
#define XB_SPIN_CAP (1u << 20)
__device__ __forceinline__ unsigned xb_ld(unsigned* p)              { return __hip_atomic_load(p, __ATOMIC_RELAXED, __HIP_MEMORY_SCOPE_AGENT); }
__device__ __forceinline__ unsigned xb_add(unsigned* p, unsigned v) { return __hip_atomic_fetch_add(p, v, __ATOMIC_RELAXED, __HIP_MEMORY_SCOPE_AGENT); }
__device__ __forceinline__ unsigned xb_xcc_id() { return (unsigned)__builtin_amdgcn_s_getreg((3 << 11) | 20) & 0xFu; }
#define XB_SPIN(cond, bar) do { unsigned _sp = 0; while (cond) { __builtin_amdgcn_s_sleep(1); \
    if ((++_sp & 255u) == 0u) { if (xb_ld(&(bar)[XB_TMO])) break; if (_sp > XB_SPIN_CAP) { atomicAdd(&(bar)[XB_TMO], 1u); break; } } } } while (0)
struct XcdBarrier { unsigned* bar; unsigned x; volatile LAS unsigned* st; };
__device__ __forceinline__ XcdBarrier xcd_barrier_post(unsigned* bar, volatile LAS unsigned* st) {
    XcdBarrier b; b.bar = bar; b.x = xb_xcc_id(); b.st = st;
    if (threadIdx.x == 0) (void)xb_add(&bar[XB_XCNT(b.x)], 1u);
    return b;
}
__device__ __forceinline__ void xcd_barrier_complete(unsigned* bar, unsigned x, unsigned& nloc, unsigned& nx) {
    const unsigned G = gridDim.x * gridDim.y * gridDim.z;
    unsigned sum, cnt, mine, sp = 0u;
    for (;;) {
        sum = 0u; cnt = 0u; mine = 0u;
#pragma unroll
        for (unsigned j = 0; j < 16; ++j) { const unsigned c = xb_ld(&bar[XB_XCNT(j)]); sum += c; cnt += (c > 0u) ? 1u : 0u; mine = (j == x) ? c : mine; }
        if (sum == G) break;
        __builtin_amdgcn_s_sleep(1);
        if ((++sp & 255u) == 0u) { if (xb_ld(&bar[XB_TMO])) break; if (sp > XB_SPIN_CAP) { atomicAdd(&bar[XB_TMO], 1u); break; } }
    }
    nloc = mine > 0u ? mine : 1u; nx = cnt > 0u ? cnt : 1u;
}
__device__ __forceinline__ void xcd_barrier(const XcdBarrier& b) {
    asm volatile("s_waitcnt vmcnt(0)" ::: "memory");
    __syncthreads();
    if (threadIdx.x == 0) {
        unsigned* bar = b.bar;
        __builtin_amdgcn_s_waitcnt(0);
        unsigned nloc = b.st[0], nx = b.st[1];
        if (nloc == 0u) { xcd_barrier_complete(bar, b.x, nloc, nx); b.st[0] = nloc; b.st[1] = nx; }
        const unsigned old = xb_add(&bar[XB_XSUB(b.x)], 1u);
        const unsigned gen = old / nloc;
        if (old + 1u == (gen + 1u) * nloc) {
            __builtin_amdgcn_fence(__ATOMIC_RELEASE, "agent");
            asm volatile("s_waitcnt vmcnt(0)" ::: "memory");
            const unsigned og = xb_add(&bar[XB_TOP], 1u);
            const unsigned tg = og / nx;
            if (og + 1u == (tg + 1u) * nx) xb_add(&bar[XB_TOPGEN], 1u);
            else XB_SPIN(xb_ld(&bar[XB_TOPGEN]) == tg, bar);
            __builtin_amdgcn_fence(__ATOMIC_ACQUIRE, "agent");
            xb_add(&bar[XB_XGEN(b.x)], 1u);
            asm volatile("s_waitcnt vmcnt(0)" ::: "memory");
        } else {
            XB_SPIN(xb_ld(&bar[XB_XGEN(b.x)]) == gen, bar);
            __builtin_amdgcn_fence(__ATOMIC_ACQUIRE, "agent");
            asm volatile("s_waitcnt vmcnt(0)" ::: "memory");
        }
    }
    __syncthreads();
}

struct Params { const float* in[26]; float* out; unsigned char* ws; };
enum { I_X = 0, I_C, I_CTX, I_CCTX, I_WADA, I_BADA, I_NMIXG, I_WIN, I_BGATE, I_CONVW, I_QNG, I_KNG, I_MQNG, I_MKVNG, I_WUQ, I_WUKV, I_SLNG, I_SLNB,
       I_SWS, I_SBS, I_WBR, I_WOUT, I_NFFNG, I_WFF1, I_WFF2, I_FNG };

__device__ __forceinline__ void transpose_item(const float* W, int K, int N, bf16_t* WT, bool padmode, LAS float* scr, int item, int lane) {
    const int nblk = N / 64, kb = item / nblk, nb = item % nblk, k0 = 64 * kb, n0 = 64 * nb;
    const int lr = lane >> 4, lc = (lane & 15) * 4;
    f32x4 v[16];
#pragma unroll
    for (int i = 0; i < 16; ++i) v[i] = *(const f32x4*)(W + (size_t)(k0 + 4 * i + lr) * N + n0 + lc);
#pragma unroll
    for (int i = 0; i < 16; ++i) { LAS float* d = scr + (4 * i + lr) * 65 + lc; d[0] = v[i][0]; d[1] = v[i][1]; d[2] = v[i][2]; d[3] = v[i][3]; }
    asm volatile("s_waitcnt lgkmcnt(0)" ::: "memory");
    const int c = lane & 7; const int roff = (padmode && n0 >= 1088) ? 192 : 0;
#pragma unroll
    for (int j = 0; j < 8; ++j) { const int n = (lane >> 3) + 8 * j; const LAS float* s = scr + (8 * c) * 65 + n;
        u32x4 o; o.x = pk2(s[0 * 65], s[1 * 65]); o.y = pk2(s[2 * 65], s[3 * 65]); o.z = pk2(s[4 * 65], s[5 * 65]); o.w = pk2(s[6 * 65], s[7 * 65]);
        *(u32x4*)(WT + (size_t)(roff + n0 + n) * K + k0 + 8 * c) = o; }
    asm volatile("s_waitcnt lgkmcnt(0)" ::: "memory");
}

struct Post1 { const bf16_t* P; bf16_t *KB, *VBC, *CKVN, *KR, *QB, *CQN, *YS; float2* stats; const float2 *tabB, *tabC; };
template <bool FULL> __device__ __forceinline__ void post1_row(const Post1& A, const int t, const int lane, const float (&kn)[4], const float (&qn)[4], const float (&mk)[8], const float (&mq)[8], const float (&cwr)[3][16]) {
    const bf16_t* P = A.P; bf16_t *KB = A.KB, *VBC = A.VBC, *CKVN = A.CKVN, *KR = A.KR, *QB = A.QB, *CQN = A.CQN, *YS = A.YS; float2* stats = A.stats; const float2 *tabB = A.tabB, *tabC = A.tabC;
    const int li = lane & 31, hh = lane >> 5;
                const bool isz = t >= SEQ; const bf16_t* pr = P + (size_t)t * NINP;
                const int tlo = isz ? SEQ : 0, thi = isz ? TALL : SEQ; const bool hp = t > tlo, hn = t + 1 < thi;
                const float2 csr = tabB[(t >> 6) * 32 + li], csc = tabB[(t & 63) * 32 + li];
                const float2 csk = tabC[((lane & 16) ? (t & 63) : (t >> 6)) * 16 + (lane & 15)];
                bf16_t kbv[4], qbv[4][4], krv[2];
#pragma unroll
                for (int j = 0; j < 4; ++j) kbv[j] = pr[P_KB + hh * 128 + 32 * j + li];
                krv[0] = pr[P_KR + (li >> 4) * 32 + (li & 15)]; krv[1] = pr[P_KR + (li >> 4) * 32 + 16 + (li & 15)];
                const u32x2 vbv = *(const u32x2*)(pr + P_VB + lane * 4);
                const bf16x8 ckv = *(const bf16x8*)(pr + P_CKV + lane * 8);
                bf16x8 cqv, gb[2], gc[2], xa[2], gcp[2], xap[2], gcn[2], xan[2], sv[2];
                if constexpr (FULL) {
#pragma unroll
                    for (int it = 0; it < 4; ++it)
#pragma unroll
                        for (int j = 0; j < 4; ++j) qbv[it][j] = pr[P_QB + (it * 2 + hh) * 128 + 32 * j + li];
                    cqv = *(const bf16x8*)(pr + P_CQ + lane * 8);
#pragma unroll
                    for (int q = 0; q < 2; ++q) { const int c = lane * 16 + q * 8;
                        gb[q] = *(const bf16x8*)(pr + P_GB + c); gc[q] = *(const bf16x8*)(pr + P_GC + c); xa[q] = *(const bf16x8*)(pr + P_XA + c);
                        const bf16_t* pp = hp ? pr - NINP : pr; const bf16_t* pn = hn ? pr + NINP : pr;
                        gcp[q] = *(const bf16x8*)(pp + P_GC + c); xap[q] = *(const bf16x8*)(pp + P_XA + c);
                        gcn[q] = *(const bf16x8*)(pn + P_GC + c); xan[q] = *(const bf16x8*)(pn + P_XA + c);
                        sv[q] = *(const bf16x8*)(pr + P_V + c); }
                }
                { float y0 = bf2f(kbv[0]), y1 = bf2f(kbv[1]), y2 = bf2f(kbv[2]), y3 = bf2f(kbv[3]);
                  const float r = rsqrtf(half_sum(y0 * y0 + y1 * y1 + y2 * y2 + y3 * y3) * (1.f / 128.f) + EPS);
                  y0 *= r * kn[0]; y1 *= r * kn[1]; y2 *= r * kn[2]; y3 *= r * kn[3];
                  if (!isz) { const float a0 = y0 * csr.x - y1 * csr.y, a1 = y0 * csr.y + y1 * csr.x, a2 = y2 * csc.x - y3 * csc.y, a3 = y2 * csc.y + y3 * csc.x; y0 = a0; y1 = a1; y2 = a2; y3 = a3; }
                  bf16_t* d = KB + ((size_t)hh * TALL + t) * 128 + li; d[0] = (bf16_t)f2bf(y0); d[32] = (bf16_t)f2bf(y1); d[64] = (bf16_t)f2bf(y2); d[96] = (bf16_t)f2bf(y3); }
                *(u32x2*)(VBC + ((size_t)hh * TALL + t) * 128 + li * 4) = vbv;
                { float f[8], ss = 0.f;
#pragma unroll
                  for (int j = 0; j < 8; ++j) { f[j] = bf2f_s(ckv[j]); ss += f[j] * f[j]; }
                  const float r = rsqrtf(wave_sum(ss) * (1.f / 512.f) + EPS); u32x4 o;
                  o.x = pk2(f[0] * r * mk[0], f[1] * r * mk[1]); o.y = pk2(f[2] * r * mk[2], f[3] * r * mk[3]); o.z = pk2(f[4] * r * mk[4], f[5] * r * mk[5]); o.w = pk2(f[6] * r * mk[6], f[7] * r * mk[7]);
                  *(u32x4*)(CKVN + (size_t)t * 512 + lane * 8) = o; }
                if (lane < 32) { const int ax = lane >> 4, i = lane & 15; float x1 = bf2f(krv[0]), x2 = bf2f(krv[1]);
                  if (!isz) { const float a = x1 * csk.x - x2 * csk.y, b2 = x1 * csk.y + x2 * csk.x; x1 = a; x2 = b2; }
                  bf16_t* d = KR + (size_t)t * 64 + ax * 32 + i; d[0] = (bf16_t)f2bf(x1); d[16] = (bf16_t)f2bf(x2); }
                if constexpr (FULL) {
#pragma unroll
                    for (int it = 0; it < 4; ++it) { const int hd = it * 2 + hh; float y0 = bf2f(qbv[it][0]), y1 = bf2f(qbv[it][1]), y2 = bf2f(qbv[it][2]), y3 = bf2f(qbv[it][3]);
                      const float r = rsqrtf(half_sum(y0 * y0 + y1 * y1 + y2 * y2 + y3 * y3) * (1.f / 128.f) + EPS);
                      y0 *= r * qn[0]; y1 *= r * qn[1]; y2 *= r * qn[2]; y3 *= r * qn[3];
                      if (!isz) { const float a0 = y0 * csr.x - y1 * csr.y, a1 = y0 * csr.y + y1 * csr.x, a2 = y2 * csc.x - y3 * csc.y, a3 = y2 * csc.y + y3 * csc.x; y0 = a0; y1 = a1; y2 = a2; y3 = a3; }
                      bf16_t* d = QB + (size_t)t * 1024 + hd * 128 + li; d[0] = (bf16_t)f2bf(y0); d[32] = (bf16_t)f2bf(y1); d[64] = (bf16_t)f2bf(y2); d[96] = (bf16_t)f2bf(y3); }
                    { float f[8], ss = 0.f;
#pragma unroll
                      for (int j = 0; j < 8; ++j) { f[j] = bf2f_s(cqv[j]); ss += f[j] * f[j]; }
                      const float r = rsqrtf(wave_sum(ss) * (1.f / 512.f) + EPS); u32x4 o;
                      o.x = pk2(f[0] * r * mq[0], f[1] * r * mq[1]); o.y = pk2(f[2] * r * mq[2], f[3] * r * mq[3]); o.z = pk2(f[4] * r * mq[4], f[5] * r * mq[5]); o.w = pk2(f[6] * r * mq[6], f[7] * r * mq[7]);
                      *(u32x4*)(CQN + (size_t)t * 512 + lane * 8) = o; }
#pragma unroll
                    for (int q = 0; q < 2; ++q) { const int c = lane * 16 + q * 8; float y[8];
#pragma unroll
                        for (int j = 0; j < 8; ++j) { const float uc = bf2f_s(gc[q][j]) * bf2f_s(xa[q][j]); const float up = hp ? bf2f_s(gcp[q][j]) * bf2f_s(xap[q][j]) : 0.f; const float un = hn ? bf2f_s(gcn[q][j]) * bf2f_s(xan[q][j]) : 0.f;
                          y[j] = bf2f_s(gb[q][j]) * (cwr[0][q * 8 + j] * up + cwr[1][q * 8 + j] * uc + cwr[2][q * 8 + j] * un); }
                        u32x4 o; o.x = pk2(y[0], y[1]); o.y = pk2(y[2], y[3]); o.z = pk2(y[4], y[5]); o.w = pk2(y[6], y[7]);
                        *(u32x4*)(YS + (size_t)t * 1024 + c) = o; }
                    { float f[16], s = 0.f;
#pragma unroll
                      for (int j = 0; j < 8; ++j) { f[j] = bf2f_s(sv[0][j]); f[8 + j] = bf2f_s(sv[1][j]); s += f[j] + f[8 + j]; }
                      const float mean = wave_sum(s) * (1.f / 1024.f); float qq = 0.f;
#pragma unroll
                      for (int j = 0; j < 16; ++j) { const float d = f[j] - mean; qq += d * d; }
                      const float rstd = rsqrtf(wave_sum(qq) * (1.f / 1024.f) + EPS);
                      if (lane == 0) stats[t] = make_float2(mean, rstd); }
                }
}

#define GAS __attribute__((address_space(1)))
struct ParamsG { const float GAS* in[26]; float GAS* out; unsigned char GAS* ws; };
static_assert(sizeof(ParamsG) == sizeof(Params), "argument layout");
typedef const ParamsG __attribute__((address_space(4))) KParams;
#define PIN(i) ((const float*)p.in[i])
constexpr int TR_PER_L = 7968 + 192 + 256 + 2048 + 1024 + 4096 + 4096;
constexpr int TR_FIRST = 7968 + 192 + 256, TR_FF2 = TR_PER_L - 4096;
__device__ __forceinline__ void transpose_layer_item(KParams& p, unsigned char* ws, int l, int r, LAS float* scr, int lane) {
    unsigned char* wl = ws + WS_W0 + l * W_LSTRIDE;
    if (r < 7968) { transpose_item(PIN(I_WIN) + (size_t)l * DM * NIN, DM, NIN, (bf16_t*)(wl + WO_IN), true, scr, r, lane); return; } r -= 7968;
    if (r < 192) { transpose_item(PIN(I_WUQ) + (size_t)l * 512 * 1536, 512, 1536, (bf16_t*)(wl + WO_UQ), false, scr, r, lane); return; } r -= 192;
    if (r < 256) { transpose_item(PIN(I_WUKV) + (size_t)l * 512 * 2048, 512, 2048, (bf16_t*)(wl + WO_UKV), false, scr, r, lane); return; } r -= 256;
    if (r < 2048) { const int br = r >> 9; transpose_item(PIN(I_WBR) + (size_t)(l * 4 + br) * 1024 * DM, 1024, DM, (bf16_t*)(wl + WO_BR) + (size_t)br * DM * 1024, false, scr, r & 511, lane); return; } r -= 2048;
    if (r < 1024) { transpose_item(PIN(I_WOUT) + (size_t)l * DM * DM, DM, DM, (bf16_t*)(wl + WO_OUT), false, scr, r, lane); return; } r -= 1024;
    if (r < 4096) { transpose_item(PIN(I_WFF1) + (size_t)l * DM * DFF, DM, DFF, (bf16_t*)(wl + WO_F1), false, scr, r, lane); return; } r -= 4096;
    transpose_item(PIN(I_WFF2) + (size_t)l * DFF * DM, DFF, DM, (bf16_t*)(wl + WO_F2), false, scr, r, lane);
}
__global__ void __launch_bounds__(NTHR, 2) mega_fwd(Params p_arg) {
    extern __shared__ __attribute__((aligned(16))) unsigned char lds_raw[];
    cg::grid_group grid = cg::this_grid();
    LAS unsigned char* lds = (LAS unsigned char*)lds_raw;
    const int tid0 = threadIdx.x, wave = __builtin_amdgcn_readfirstlane(tid0 >> 6);
    const int G = gridDim.x;
#define PHASE_IDS() int tid = tid0; asm volatile("" : "+v"(tid)); const int lane = tid & 63; (void)lane
    const int NGW = G * NWAVES;
#define WS_PTRS() KParams* pk_ = (KParams*)__builtin_amdgcn_kernarg_segment_ptr(); asm volatile("" : "+s"(pk_)); KParams& p = *pk_;   \
    GAS unsigned char* wsg_ = p.ws; asm volatile("" : "+s"(wsg_)); unsigned char* ws = (unsigned char*)wsg_; int bx_ = blockIdx.x; asm volatile("" : "+s"(bx_)); const int bx = bx_, gw = bx * NWAVES + wave; (void)gw; \
    float* MOD = (float*)(ws + WS_MOD); float2* tabB = (float2*)(ws + WS_TABB); float2* tabC = (float2*)(ws + WS_TABC); float2* stats = (float2*)(ws + WS_STATS); \
    bf16_t* H = (bf16_t*)(ws + WS_H); bf16_t* P = (bf16_t*)(ws + WS_P); bf16_t* U = (bf16_t*)(ws + WS_P); \
    bf16_t* KB = (bf16_t*)(ws + WS_KB); bf16_t* KR = (bf16_t*)(ws + WS_KR); bf16_t* QB = (bf16_t*)(ws + WS_QB); \
    bf16_t* CKVN = (bf16_t*)(ws + WS_CKVN); bf16_t* CQN = (bf16_t*)(ws + WS_CQN); bf16_t* QC = (bf16_t*)(ws + WS_QC); bf16_t* KVU = (bf16_t*)(ws + WS_KVU); \
    bf16_t* YS = (bf16_t*)(ws + WS_YS); float* MRG = (float*)(ws + WS_MRG); bf16_t* MG = (bf16_t*)(ws + WS_MG); float* XS = (float*)(ws + WS_XS); float* ZSLAB = (float*)(ws + WS_ZSLAB); bf16_t* VBC = (bf16_t*)(ws + WS_VBC); (void)VBC; \
    (void)MOD; (void)tabB; (void)tabC; (void)stats; (void)H; (void)P; (void)U; (void)KB; (void)KR; (void)QB; (void)CKVN; (void)CQN; (void)QC; (void)KVU; (void)YS; (void)MRG; (void)MG; (void)XS; (void)ZSLAB
#define LAYER_PTRS() unsigned char* wl = ws + WS_W0 + l * W_LSTRIDE; \
    const bf16_t* Win_t = (const bf16_t*)(wl + WO_IN); const bf16_t* Wuq_t = (const bf16_t*)(wl + WO_UQ); const bf16_t* Wukv_t = (const bf16_t*)(wl + WO_UKV); \
    const bf16_t* Wbr_t = (const bf16_t*)(wl + WO_BR); const bf16_t* Wout_t = (const bf16_t*)(wl + WO_OUT); const bf16_t* W1_t = (const bf16_t*)(wl + WO_F1); \
    const bf16_t* W2_t = (const bf16_t*)(wl + WO_F2); const bf16_t* Wsg = (const bf16_t*)(wl + WO_SG); \
    const float* modx = MOD + (size_t)(l * 2 + 0) * 12288; const float* modz = MOD + (size_t)(l * 2 + 1) * 12288; \
    const float* xsrc = l0 ? PIN(I_X) : XS; const float* zsrc = l0 ? PIN(I_CTX) : XS + (size_t)SEQ * DM; \
    (void)Win_t; (void)Wuq_t; (void)Wukv_t; (void)Wbr_t; (void)Wout_t; (void)W1_t; (void)W2_t; (void)Wsg; (void)modx; (void)modz; (void)xsrc; (void)zsrc

    {
        if (blockIdx.x == 0) for (int i = tid0; i < XCD_BAR_WORDS; i += NTHR) ((unsigned*)(p_arg.ws + WS_BAR))[i] = 0u;
        if (tid0 < 2) ((volatile LAS unsigned*)(lds + LDS_BARST))[tid0] = 0u;
    }
#if (PHM & 1)
    for (int rp0_ = 0; rp0_ < REP_P0; ++rp0_)
    {
        PHASE_IDS(); WS_PTRS();
#if (PHM & 4096)
        LAS float* sl = (LAS float*)lds;
        LAS float* red = (LAS float*)(lds + 16384);
        if (bx < 192) {
            for (int i = tid; i < 4096; i += NTHR) { const int cond = i >> 11, k = i & 2047; const float v = (cond ? PIN(I_CCTX) : PIN(I_C))[k]; sl[i] = v / (1.f + __expf(-v)); }
            __syncthreads();
        }
        for (int item = bx; item < 192; item += G) {
            typedef float f32x2 __attribute__((ext_vector_type(2)));
            const int l = item / 96, n0 = (item % 96) * 128;
            const float* wp = PIN(I_WADA) + (size_t)l * DM * 12288 + n0 + lane * 2;
            f32x2 a0 = (f32x2){0.f, 0.f}, a1 = a0;
#pragma unroll 16
            for (int kk = 0; kk < 256; ++kk) { const int k = wave * 256 + kk; const f32x2 wv = *(const f32x2*)(wp + (size_t)k * 12288); a0 += wv * sl[k]; a1 += wv * sl[2048 + k]; }
            *(LAS f32x2*)(red + (wave * 2 + 0) * 128 + lane * 2) = a0; *(LAS f32x2*)(red + (wave * 2 + 1) * 128 + lane * 2) = a1;
            __syncthreads();
            if (tid < 256) { const int cond = tid >> 7, col = tid & 127; float s = PIN(I_BADA)[(size_t)l * 12288 + n0 + col];
#pragma unroll
              for (int w = 0; w < 8; ++w) s += red[(w * 2 + cond) * 128 + col];
              MOD[(size_t)(l * 2 + cond) * 12288 + n0 + col] = s; }
            __syncthreads();
        }
#endif
#if (PHM & 8192)
        for (int idx = bx * NTHR + tid; idx < 128 * 48; idx += G * NTHR) {
            const int pos = idx / 48, j = idx % 48;
            if (j < 32) { const float inv = powf(10000.0f, -(float)(2 * j) / 64.0f); const float ang = (float)pos * inv; tabB[pos * 32 + j] = make_float2(cosf(ang), sinf(ang)); }
            else { const int i = j - 32; const float inv = powf(10000.0f, -(float)(2 * i) / 32.0f); const float ang = (float)pos * inv; tabC[pos * 16 + i] = make_float2(cosf(ang), sinf(ang)); }
        }
#endif
#if (PHM & 16384)
        for (int idx = bx * NTHR + tid; idx < 2 * 131072 / 4; idx += G * NTHR) {
            const int l = idx / 32768, r = idx % 32768; const f32x4 v = *(const f32x4*)(PIN(I_SWS) + (size_t)idx * 4);
            u32x2 o; o.x = pk2(v[0], v[1]); o.y = pk2(v[2], v[3]);
            *(u32x2*)((bf16_t*)(ws + WS_W0 + l * W_LSTRIDE + WO_SG) + (size_t)r * 4) = o;
        }
#endif
        __syncthreads();
#if (PHM & 32768)
        LAS float* scr = (LAS float*)(lds + wave * 16640);
        for (int it = gw; it < TR_FIRST; it += NGW) transpose_layer_item(p, ws, 0, it, scr, lane);
#endif
    }
    #endif
        grid.sync();
        const XcdBarrier xb = xcd_barrier_post((unsigned*)(p_arg.ws + WS_BAR), (volatile LAS unsigned*)(lds + LDS_BARST));

    for (int l = 0; l < 2; ++l) {
        const bool l0 = (l == 0);
        const int TQ = l0 ? TALL : SEQ;
        const int nMq = TQ / 256;

#if (PHM & 2)
        {
        WS_PTRS(); LAYER_PTRS();
        PHASE_IDS();
            const float* gmix = PIN(I_NMIXG) + (size_t)l * DM;
            for (int rew_ = 0; rew_ < REP_EW; ++rew_)
            for (int row = gw; row < TALL; row += NGW) {
                const bool isz = row >= SEQ; const float* src = isz ? zsrc + (size_t)(row - SEQ) * DM : xsrc + (size_t)row * DM; const float* md = isz ? modz : modx;
                f32x4 v[8]; float ss = 0.f;
#pragma unroll
                for (int j = 0; j < 8; ++j) v[j] = *(const f32x4*)(src + (lane + 64 * j) * 4);
                if (isz && !l0) {
                    const float* g2z = MOD + (size_t)12288 + 5 * 2048;
#pragma unroll
                    for (int j = 0; j < 8; ++j) { const int c = (lane + 64 * j) * 4; f32x4 s = (f32x4){0.f, 0.f, 0.f, 0.f};
                        for (int ks = 0; ks < 16; ++ks) s += *(const f32x4*)(ZSLAB + ((size_t)ks * 256 + (row - SEQ)) * DM + c);
                        v[j] += *(const f32x4*)(g2z + c) * s; }
                }
#pragma unroll
                for (int j = 0; j < 8; ++j) ss += v[j][0] * v[j][0] + v[j][1] * v[j][1] + v[j][2] * v[j][2] + v[j][3] * v[j][3];
                const float r = rsqrtf(wave_sum(ss) * (1.f / DM) + EPS);
#pragma unroll
                for (int j = 0; j < 8; ++j) { const int c = (lane + 64 * j) * 4; const f32x4 g = *(const f32x4*)(gmix + c), sh = *(const f32x4*)(md + c), sc = *(const f32x4*)(md + 2048 + c);
                    f32x4 h = (v[j] * r * g) * (sc + 1.f) + sh; u32x2 o; o.x = pk2(h[0], h[1]); o.y = pk2(h[2], h[3]); *(u32x2*)(H + (size_t)row * DM + c) = o; }
            }
        }
        #endif
        for (int rs_ = 0; rs_ < REP_SYNC; ++rs_) xcd_barrier(xb);

#if (PHM & 4)
        {
        WS_PTRS(); LAYER_PTRS();
            pg8::SchedWide S{H, Win_t, DM, nMq, NINP / 256, nMq * (NINP / 256), 32, l0 ? 0 : 5, G, bx};
            pg8::EpiAct E{P, NINP, P, NINP, PIN(I_BGATE) + (size_t)l * 8192, P_G, P_U / 256, P_G / 256, -1};
            int nrep = REP_B; asm volatile("" : "+s"(nrep));
            for (int rep = 0; rep < nrep; ++rep) pg8::gemm_phase<pg8::EpiAct, pg8::SchedWide, true, true>(lds, DM, S, E);
            if (l0 && bx >= 31) {
                PHASE_IDS();
                LAS float* scr = (LAS float*)(lds + wave * 16640);
                for (int it = TR_FIRST + (bx - 31) * NWAVES + wave; it < TR_FF2; it += 225 * NWAVES) transpose_layer_item(p, ws, 0, it, scr, lane);
            }
        }
        #endif
        for (int rs_ = 0; rs_ < REP_SYNC; ++rs_) xcd_barrier(xb);

#if (PHM & 8)
        {
        WS_PTRS(); LAYER_PTRS();
        PHASE_IDS();
            const float* kng = PIN(I_KNG) + l * 128; const float* qng = PIN(I_QNG) + l * 128;
            const float* mqg = PIN(I_MQNG) + l * 512; const float* mkg = PIN(I_MKVNG) + l * 512; const float* cw = PIN(I_CONVW) + (size_t)l * 3 * 1024;
            const int li = lane & 31, hh = lane >> 5;
            float kn[4], qn[4], mk[8], mq[8], cwr[3][16];
#pragma unroll
            for (int j = 0; j < 4; ++j) { kn[j] = kng[32 * j + li]; qn[j] = qng[32 * j + li]; }
#pragma unroll
            for (int j = 0; j < 8; ++j) { mk[j] = mkg[lane * 8 + j]; mq[j] = mqg[lane * 8 + j]; }
#pragma unroll
            for (int tp = 0; tp < 3; ++tp)
#pragma unroll
                for (int j = 0; j < 16; ++j) cwr[tp][j] = cw[tp * 1024 + lane * 16 + j];
            const Post1 A1{P, KB, VBC, CKVN, KR, QB, CQN, YS, stats, tabB, tabC};
            for (int rew_ = 0; rew_ < REP_EW * REP_C; ++rew_) {
                for (int t = gw; t < TQ; t += NGW) post1_row<true>(A1, t, lane, kn, qn, mk, mq, cwr);
                if (!l0) for (int t = SEQ + gw; t < TALL; t += NGW) post1_row<false>(A1, t, lane, kn, qn, mk, mq, cwr);
            }
        }
        #endif
        for (int rs_ = 0; rs_ < REP_SYNC; ++rs_) xcd_barrier(xb);

#if (PHM & 16)
        {
        WS_PTRS(); LAYER_PTRS();
            pg8::SchedDual S{CQN, Wuq_t, CKVN, Wukv_t, 512, nMq, nMq * 6, TALL / 256, (TALL / 256) * 8, G, bx};
            pg8::EpiAct E{QC, 1536, KVU, 0, nullptr, 0, 1 << 30, 1 << 30, 0};
            int nrepd = REP_D; asm volatile("" : "+s"(nrepd));
            for (int rep = 0; rep < nrepd; ++rep) pg8::gemm_phase<pg8::EpiAct, pg8::SchedDual, true, true>(lds, 512, S, E);
            __syncthreads();
        PHASE_IDS();
            const float* lng = PIN(I_SLNG) + l * 1024; const float* lnb = PIN(I_SLNB) + l * 1024; const float* bs = PIN(I_SBS) + l * 1024;
            LAS bf16_t* VnT = (LAS bf16_t*)lds;
            const int r32 = lane & 31, hi = lane >> 5;
            for (int rew_ = 0; rew_ < REP_EW * REP_S; ++rew_)
            for (int item = G - 1 - bx; item < (TQ / 128) * 8; item += G) {
                const int ch = item >> 3, g = item & 7, t0 = ch * 128;
                { const int q = tid >> 2, cs = (tid & 3) * 32; const float2 st = stats[t0 + q]; const bf16_t* src = P + (size_t)(t0 + q) * NINP + P_V + g * 128 + cs;
#pragma unroll
                  for (int k4 = 0; k4 < 4; ++k4) { const bf16x8 v = *(const bf16x8*)(src + k4 * 8);
#pragma unroll
                    for (int j = 0; j < 8; ++j) { const int c = cs + k4 * 8 + j; const float f = (bf2f_s(v[j]) - st.x) * st.y * lng[g * 128 + c] + lnb[g * 128 + c]; VnT[c * 136 + q] = (bf16_t)f2bf(f); } } }
                __syncthreads();
                const int pb = wave >> 1, cb0 = (wave & 1) * 2;
                f32x16 acc0 = {}, acc1 = {};
                const bf16_t* Ap = Wsg + (size_t)g * 16384 + (pb * 32 + r32) * 128 + hi * 8;
#pragma unroll
                for (int ks = 0; ks < 8; ++ks) { const bf16x8 a = *(const bf16x8*)(Ap + ks * 16);
                    const bf16x8 b0 = *(const LAS bf16x8*)(VnT + ((cb0 * 32 + r32) * 136 + ks * 16 + hi * 8)), b1 = *(const LAS bf16x8*)(VnT + (((cb0 + 1) * 32 + r32) * 136 + ks * 16 + hi * 8));
                    acc0 = __builtin_amdgcn_mfma_f32_32x32x16_bf16(a, b0, acc0, 0, 0, 0); acc1 = __builtin_amdgcn_mfma_f32_32x32x16_bf16(a, b1, acc1, 0, 0, 0); }
#pragma unroll
                for (int r = 0; r < 16; ++r) { const int pp = pb * 32 + att::crow(r, hi); const int t = t0 + pp; const float bias = bs[g * 128 + pp];
                    const int c0 = g * 128 + cb0 * 32 + r32; const bf16_t* up = P + (size_t)t * NINP + P_U; bf16_t* yp = YS + 3 * YS_STRIDE + (size_t)t * 1024;
                    yp[c0] = (bf16_t)f2bf(bf2f(up[c0]) * (acc0[r] + bias)); yp[c0 + 32] = (bf16_t)f2bf(bf2f(up[c0 + 32]) * (acc1[r] + bias)); }
                __syncthreads();
            }
        }
        #endif
        for (int rs_ = 0; rs_ < REP_SYNC; ++rs_) xcd_barrier(xb);

#if (PHM & 32)
        {
        WS_PTRS(); LAYER_PTRS();
            const int h = bx & 7, qb = bx >> 3;
            const int nun = 1;
            const bool zmla = l0 && bx < 8, zgqa = l0 && bx >= 8 && bx < 16;
            int nrepF = REP_F; asm volatile("" : "+s"(nrepF));
#if EN192
            for (int ui = 0; ui < (zmla ? 2 : 1) * nrepF; ++ui) {
                const bool zu = zmla && (ui & 1); const size_t r0 = zu ? (size_t)SEQ : (size_t)qb * 256; const size_t k0 = zu ? (size_t)SEQ : 0; const int seq = zu ? CTXL : TALL;
                att::attn_body<192, 1536, 128, 64, 128, 1024>(QC + r0 * 1536 + h * 192, KVU + ((size_t)h * TALL + k0) * 128, KR + k0 * 64, KVU + ((size_t)(8 + h) * TALL + k0) * 128,
                                    YS + 2 * YS_STRIDE + r0 * 1024 + h * 128, seq, (char*)lds_raw, !zu, (int)r0, tabC);
            }
#endif
#if EN128
            for (int ui = 0; ui < (zgqa ? 2 : 1) * nrepF; ++ui) {
                const bool zu = zgqa && (ui & 1); const size_t r0 = zu ? (size_t)SEQ : (size_t)qb * 256; const size_t k0 = zu ? (size_t)SEQ : 0; const int seq = zu ? CTXL : TALL;
                att::attn_body<128, 1024, 128, 64, 128, 1024>(QB + r0 * 1024 + h * 128, KB + ((size_t)(h >> 2) * TALL + k0) * 128, nullptr, VBC + ((size_t)(h >> 2) * TALL + k0) * 128,
                                    YS + 1 * YS_STRIDE + r0 * 1024 + h * 128, seq, (char*)lds_raw, false, 0, tabC);
            }
#endif
        }
        #endif
        for (int rs_ = 0; rs_ < REP_SYNC; ++rs_) xcd_barrier(xb);

#if (PHM & 64)
        {
        WS_PTRS(); LAYER_PTRS();
            pg8::SchedBranch S{YS, Wbr_t, 1024, nMq, nMq * 8, G, bx, YS_STRIDE, (size_t)DM * 1024};
            pg8::EpiGate E{P, MG};
            int nrep = REP_G; asm volatile("" : "+s"(nrep));
            for (int rep = 0; rep < nrep; ++rep) pg8::gemm_phase<pg8::EpiGate, pg8::SchedBranch, true, true>(lds, 1024, S, E);
            if (l0 && bx >= 8) {
                PHASE_IDS();
                LAS float* scr = (LAS float*)(lds + wave * 16640);
                for (int it = (bx - 8) * NWAVES + wave; it < TR_PER_L; it += 248 * NWAVES) transpose_layer_item(p, ws, 1, it, scr, lane);
            }
        }
        #endif
        for (int rs_ = 0; rs_ < REP_SYNC; ++rs_) xcd_barrier(xb);

#if (PHM & 128)
        {
        WS_PTRS(); LAYER_PTRS();
            pg8::SchedNarrowZ S{MG, Wout_t, DM, 32, 256, G, bx, l0 ? 8 * 8 : 0, 256};
            pg8::EpiRes E{xsrc, zsrc, XS, modx + 2 * 2048, modz + 2 * 2048, 32, ZSLAB};
            pg8::gemm_phase<pg8::EpiRes, pg8::SchedNarrowZ, true, true>(lds, DM, S, E);
        }
        #endif
        for (int rs_ = 0; rs_ < REP_SYNC; ++rs_) xcd_barrier(xb);

#if (PHM & 256)
        {
        WS_PTRS(); LAYER_PTRS();
        PHASE_IDS();
            const float* gffn = PIN(I_NFFNG) + (size_t)l * DM;
            for (int rew_ = 0; rew_ < REP_EW; ++rew_)
            for (int row = gw; row < TQ; row += NGW) {
                const bool isz = row >= SEQ; const float* src = isz ? zsrc + (size_t)(row - SEQ) * DM : XS + (size_t)row * DM; const float* md = isz ? modz : modx;
                f32x4 v[8]; float ss = 0.f;
#pragma unroll
                for (int j = 0; j < 8; ++j) v[j] = *(const f32x4*)(src + (lane + 64 * j) * 4);
                if (isz) {
#pragma unroll
                    for (int j = 0; j < 8; ++j) { const int c = (lane + 64 * j) * 4; f32x4 s = (f32x4){0.f, 0.f, 0.f, 0.f};
                        for (int ks = 0; ks < 8; ++ks) s += *(const f32x4*)(ZSLAB + ((size_t)ks * 256 + (row - SEQ)) * DM + c);
                        v[j] += *(const f32x4*)(modz + 2 * 2048 + c) * s; *(f32x4*)(XS + (size_t)row * DM + c) = v[j]; }
                }
#pragma unroll
                for (int j = 0; j < 8; ++j) ss += v[j][0] * v[j][0] + v[j][1] * v[j][1] + v[j][2] * v[j][2] + v[j][3] * v[j][3];
                const float r = rsqrtf(wave_sum(ss) * (1.f / DM) + EPS);
#pragma unroll
                for (int j = 0; j < 8; ++j) { const int c = (lane + 64 * j) * 4; const f32x4 g = *(const f32x4*)(gffn + c), sh = *(const f32x4*)(md + 3 * 2048 + c), sc = *(const f32x4*)(md + 4 * 2048 + c);
                    f32x4 h = (v[j] * r * g) * (sc + 1.f) + sh; u32x2 o; o.x = pk2(h[0], h[1]); o.y = pk2(h[2], h[3]); *(u32x2*)(H + (size_t)row * DM + c) = o; }
            }
        }
        #endif
        for (int rs_ = 0; rs_ < REP_SYNC; ++rs_) xcd_barrier(xb);

#if (PHM & 512)
        {
        WS_PTRS(); LAYER_PTRS();
            pg8::SchedWide S{H, W1_t, DM, nMq, DFF / 256, nMq * (DFF / 256), 0, 0, G, bx};
            pg8::EpiAct E{U, DFF, U, DFF, nullptr, 0, 1 << 30, 1 << 30, 3};
            int nrep = REP_J; asm volatile("" : "+s"(nrep));
            for (int rep = 0; rep < nrep; ++rep) pg8::gemm_phase<pg8::EpiAct, pg8::SchedWide, true, true>(lds, DM, S, E);
            if (l0 && bx >= 32) {
                PHASE_IDS();
                LAS float* scr = (LAS float*)(lds + wave * 16640);
                for (int it = TR_FF2 + (bx - 32) * NWAVES + wave; it < TR_PER_L; it += 224 * NWAVES) transpose_layer_item(p, ws, 0, it, scr, lane);
            }
        }
        #endif
        for (int rs_ = 0; rs_ < REP_SYNC; ++rs_) xcd_barrier(xb);

#if (PHM & 1024)
        {
        WS_PTRS(); LAYER_PTRS();
            pg8::SchedNarrowZ S{U, W2_t, DFF, 32, 256, G, bx, l0 ? 8 * 16 : 0, 512};
            pg8::EpiRes E{XS, XS + (size_t)SEQ * DM, XS, modx + 5 * 2048, modz + 5 * 2048, 32, ZSLAB};
            pg8::gemm_phase<pg8::EpiRes, pg8::SchedNarrowZ, true, true>(lds, DFF, S, E);
        }
        #endif
        for (int rs_ = 0; rs_ < REP_SYNC; ++rs_) xcd_barrier(xb);
    }

    {
        WS_PTRS();
        PHASE_IDS();
        const float* gf = PIN(I_FNG);
        for (int row = gw; row < SEQ; row += NGW) {
            const float* src = XS + (size_t)row * DM; f32x4 v[8]; float ss = 0.f;
#pragma unroll
            for (int j = 0; j < 8; ++j) { v[j] = *(const f32x4*)(src + (lane + 64 * j) * 4); ss += v[j][0] * v[j][0] + v[j][1] * v[j][1] + v[j][2] * v[j][2] + v[j][3] * v[j][3]; }
            const float r = rsqrtf(wave_sum(ss) * (1.f / DM) + EPS);
#pragma unroll
            for (int j = 0; j < 8; ++j) { const int c = (lane + 64 * j) * 4; const f32x4 g = *(const f32x4*)(gf + c); *(f32x4*)((float*)p.out + (size_t)row * DM + c) = v[j] * r * g; }
        }
    }
}

extern "C" void kernel_launch(void* const* d_in, const int* in_sizes, int n_in, void* d_out, int out_size, void* d_ws, size_t ws_size, hipStream_t stream) {
    static int grid = 0;
    if (grid == 0) {
        if (n_in != 26 || out_size != SEQ * DM || ws_size < WS_END) { fprintf(stderr, "kernel_launch: unexpected shapes (n_in %d out %d ws %zu, need ws >= %zu)\n", n_in, out_size, ws_size, (size_t)WS_END); grid = -1; return; }
        int dev = 0, cus = 0, per_cu = 0;
        hipGetDevice(&dev); hipDeviceGetAttribute(&cus, hipDeviceAttributeMultiprocessorCount, dev);
        if (hipFuncSetAttribute((const void*)mega_fwd, hipFuncAttributeMaxDynamicSharedMemorySize, LDS_BYTES) != hipSuccess) { fprintf(stderr, "kernel_launch: hipFuncSetAttribute failed\n"); grid = -1; return; }
        hipOccupancyMaxActiveBlocksPerMultiprocessor(&per_cu, (const void*)mega_fwd, NTHR, LDS_BYTES);
        (void)hipGetLastError();
        if (per_cu < 1) fprintf(stderr, "kernel_launch: occupancy query says %d blocks per CU\n", per_cu);
        grid = 256;
        if (cus != 256) fprintf(stderr, "kernel_launch: device has %d CUs; this kernel is built for a 256-workgroup grid\n", cus);
    }
    if (grid < 0) return;
    Params p{};
    for (int i = 0; i < 26; ++i) p.in[i] = (const float*)d_in[i];
    p.out = (float*)d_out; p.ws = (unsigned char*)d_ws;
    void* args[] = {&p};
    hipError_t e = hipLaunchCooperativeKernel((const void*)mega_fwd, dim3(grid), dim3(NTHR), args, LDS_BYTES, stream);
    if (e != hipSuccess) fprintf(stderr, "kernel_launch: cooperative launch failed: %s\n", hipGetErrorString(e));
}
```
